# Optimizing an MI355X kernel written in HIP

```python
import jax, jax.numpy as jnp
from jax import lax
import numpy as np

D_MODEL = 2048
BATCH = 1
SEQ = 16384
DEPTH = 1
DEC_BATCH = 128
DEC_SEQ = 4
PAST_LEN = 16384
PAGE_SIZE = 128

MIX_WIDTH = D_MODEL
HEAD_DIM = 64
RWKV_WIDTH = MIX_WIDTH // 2
RWKV_HEADS = RWKV_WIDTH // HEAD_DIM
SWA_WIDTH = MIX_WIDTH - RWKV_WIDTH
SWA_HEADS = SWA_WIDTH // HEAD_DIM
SWA_KV_HEADS = 4
SWA_GROUP = SWA_HEADS // SWA_KV_HEADS
KV_WIDTH = SWA_KV_HEADS * HEAD_DIM
WINDOW = 128
BLOCK = 128
DECAY_LORA = 64
AAA_LORA = 64
GATE_LORA = 160
RWKV_COLS = 3 * RWKV_WIDTH + DECAY_LORA + AAA_LORA + GATE_LORA
SWA_COLS = SWA_WIDTH + 2 * KV_WIDTH
IN_COLS = RWKV_COLS + SWA_COLS
D_FF = ((8 * D_MODEL + 3 * 256 - 1) // (3 * 256)) * 256
RMS_EPS = 1e-5
GN_EPS = 64e-5

kernel_name = 'hymba_rwkv7_swa_sink_decode_step'


def rmsnorm(x, g):
    xf = x.astype(jnp.float32)
    y = xf * lax.rsqrt(jnp.mean(xf * xf, axis=-1, keepdims=True) + RMS_EPS)
    return (y * g.astype(jnp.float32)).astype(x.dtype)


def alibi_slopes():
    return jnp.asarray([2.0 ** (-8.0 * (i + 1) / SWA_HEADS) for i in range(SWA_HEADS)], dtype=jnp.float32)


def rwkv7_time_mix(p, shift_prev, state0, mu, w0, w2, a0, a2, g2, k_k, k_a, r_k, ln_w, ln_b):
    B, T, _ = p.shape
    f32 = jnp.float32
    C, H, N = RWKV_WIDTH, RWKV_HEADS, HEAD_DIM
    pf = p.astype(f32)
    prev = jnp.concatenate([shift_prev.astype(f32)[:, None], pf[:, :-1]], axis=1)
    xs = pf + mu.astype(f32) * (prev - pf)
    r = xs[..., :C]
    k = xs[..., C:2 * C]
    v = xs[..., 2 * C:3 * C]
    o = 3 * C
    xw = xs[..., o:o + DECAY_LORA]
    o += DECAY_LORA
    xa = xs[..., o:o + AAA_LORA]
    o += AAA_LORA
    xg = xs[..., o:o + GATE_LORA]
    w = -jax.nn.softplus(-(w0.astype(f32) + jnp.tanh(xw) @ w2.astype(f32))) - 0.5
    decay = jnp.exp(-jnp.exp(w))
    a = jax.nn.sigmoid(a0.astype(f32) + xa @ a2.astype(f32))
    g = jax.nn.sigmoid(xg) @ g2.astype(f32)
    kk = (k * k_k.astype(f32)).reshape(B, T, H, N)
    kk = kk / jnp.maximum(jnp.sqrt(jnp.sum(kk * kk, axis=-1, keepdims=True)), 1e-12)
    k = k * (1.0 + (a - 1.0) * k_a.astype(f32))
    r_h = r.reshape(B, T, H, N)
    k_h = k.reshape(B, T, H, N)
    v_h = v.reshape(B, T, H, N)
    w_h = decay.reshape(B, T, H, N)
    b_h = kk * a.reshape(B, T, H, N)

    def step(S, inp):
        r_t, w_t, k_t, v_t, kk_t, b_t = inp
        sa = jnp.einsum('bhij,bhj->bhi', S, -kk_t)
        S = S * w_t[:, :, None, :] + sa[..., None] * b_t[:, :, None, :] + v_t[..., None] * k_t[:, :, None, :]
        return S, jnp.einsum('bhij,bhj->bhi', S, r_t)

    seq = (jnp.moveaxis(r_h, 1, 0), jnp.moveaxis(w_h, 1, 0), jnp.moveaxis(k_h, 1, 0),
           jnp.moveaxis(v_h, 1, 0), jnp.moveaxis(kk, 1, 0), jnp.moveaxis(b_h, 1, 0))
    S_fin, out = lax.scan(step, state0.astype(f32), seq)
    out = jnp.moveaxis(out, 0, 1)
    mean = jnp.mean(out, axis=-1, keepdims=True)
    var = jnp.mean(jnp.square(out - mean), axis=-1, keepdims=True)
    out = ((out - mean) * lax.rsqrt(var + GN_EPS)).reshape(B, T, C) * ln_w.astype(f32) + ln_b.astype(f32)
    bonus = (jnp.sum(r_h * k_h * r_k.astype(f32), axis=-1, keepdims=True) * v_h).reshape(B, T, C)
    return (out + bonus) * g, S_fin, p[:, -1]


def swa_sink_attention(q, k, v, k_past, v_past, p0, sinks):
    B, T = q.shape[0], q.shape[1]
    qb = min(BLOCK, T)
    nblk = T // qb
    span = WINDOW + qb
    k_cat = jnp.concatenate([k_past.astype(k.dtype), k], axis=1)
    v_cat = jnp.concatenate([v_past.astype(v.dtype), v], axis=1)
    idx = (np.arange(nblk) * qb)[:, None] + np.arange(span)[None, :]
    kb = k_cat[:, idx]
    vb = v_cat[:, idx]
    qr = q.reshape(B, nblk, qb, SWA_KV_HEADS, SWA_GROUP, HEAD_DIM)
    s = jnp.einsum('bnqkgd,bnskd->bnkgqs', qr, kb).astype(jnp.float32) * (HEAD_DIM ** -0.5)
    t_pos = p0 + np.arange(T).reshape(nblk, qb)
    s_pos = p0 - WINDOW + idx
    dist = t_pos[:, :, None] - s_pos[:, None, :]
    valid = (s_pos[:, None, :] >= 0) & (dist >= 0) & (dist < WINDOW)
    slopes = alibi_slopes().reshape(SWA_KV_HEADS, SWA_GROUP)
    s = s - slopes[None, None, :, :, None, None] * jnp.asarray(dist, jnp.float32)[None, :, None, None, :, :]
    s = jnp.where(jnp.asarray(valid)[None, :, None, None, :, :], s, -jnp.inf)
    sink = sinks.astype(jnp.float32).reshape(SWA_KV_HEADS, SWA_GROUP)[None, None, :, :, None, None]
    m = jnp.maximum(jnp.max(s, axis=-1, keepdims=True), sink)
    e = jnp.exp(s - m)
    pr = e / (jnp.sum(e, axis=-1, keepdims=True) + jnp.exp(sink - m))
    o = jnp.einsum('bnkgqs,bnskd->bnqkgd', pr.astype(v.dtype), vb).reshape(B, T, SWA_WIDTH)
    return o, k_cat[:, -WINDOW:], v_cat[:, -WINDOW:]


def hybrid_layer(x, shift_prev, rwkv_state, k_past, v_past, p0, norm_attn, w_in, mu_shift, w0, w2, a0, a2,
                 g2, k_k, k_a, r_k, ln_x_w, ln_x_b, sinks, w_out, norm_ffn, w_gate, w_up, w_down):
    B, T, _ = x.shape
    h = rmsnorm(x, norm_attn)
    proj = h @ w_in
    p_rwkv = proj[..., :RWKV_COLS]
    p_swa = proj[..., RWKV_COLS:]
    q = p_swa[..., :SWA_WIDTH].reshape(B, T, SWA_HEADS, HEAD_DIM)
    k = p_swa[..., SWA_WIDTH:SWA_WIDTH + KV_WIDTH].reshape(B, T, SWA_KV_HEADS, HEAD_DIM)
    v = p_swa[..., SWA_WIDTH + KV_WIDTH:].reshape(B, T, SWA_KV_HEADS, HEAD_DIM)
    o_rwkv, new_state, new_shift = rwkv7_time_mix(p_rwkv, shift_prev, rwkv_state, mu_shift, w0, w2, a0, a2,
                                                  g2, k_k, k_a, r_k, ln_x_w, ln_x_b)
    o_swa, new_k, new_v = swa_sink_attention(q, k, v, k_past, v_past, p0, sinks)
    mixed = jnp.concatenate([o_rwkv.astype(x.dtype), o_swa.astype(x.dtype)], axis=-1)
    x = x + mixed @ w_out
    h2 = rmsnorm(x, norm_ffn)
    x = x + (jax.nn.silu(h2 @ w_gate) * (h2 @ w_up)) @ w_down
    return x, new_state, new_shift, new_k, new_v


def setup_inputs(seed: int = 0) -> dict:
    key = jax.random.key(seed)
    ks = jax.random.split(key, 32)
    nrm = jax.random.normal
    f32 = jnp.float32
    L, C = DEPTH, RWKV_WIDTH
    return {
        'x_prompt': nrm(ks[0], (BATCH, SEQ, D_MODEL), f32),
        'x_sample': nrm(ks[1], (DEC_BATCH, DEC_SEQ, D_MODEL), f32),
        'state_rwkv': 0.2 * nrm(ks[2], (L, DEC_BATCH, RWKV_HEADS, HEAD_DIM, HEAD_DIM), f32),
        'state_shift': nrm(ks[3], (L, DEC_BATCH, RWKV_COLS), f32),
        'cache_swa_k': nrm(ks[4], (L, DEC_BATCH, WINDOW, SWA_KV_HEADS, HEAD_DIM), f32),
        'cache_swa_v': nrm(ks[5], (L, DEC_BATCH, WINDOW, SWA_KV_HEADS, HEAD_DIM), f32),
        'norm_attn': 1.0 + 0.02 * nrm(ks[6], (L, D_MODEL), f32),
        'w_in': nrm(ks[7], (L, D_MODEL, IN_COLS), f32) * D_MODEL ** -0.5,
        'mu_shift': jax.random.uniform(ks[8], (L, RWKV_COLS), f32),
        'w0': jax.random.uniform(ks[9], (L, C), f32, -6.0, -1.0),
        'w2': 0.5 * nrm(ks[10], (L, DECAY_LORA, C), f32) * DECAY_LORA ** -0.5,
        'a0': 0.1 * nrm(ks[11], (L, C), f32),
        'a2': nrm(ks[12], (L, AAA_LORA, C), f32) * AAA_LORA ** -0.5,
        'g2': nrm(ks[13], (L, GATE_LORA, C), f32) * GATE_LORA ** -0.5,
        'k_k': 1.0 + 0.1 * nrm(ks[14], (L, C), f32),
        'k_a': 1.0 + 0.1 * nrm(ks[15], (L, C), f32),
        'r_k': 0.1 * nrm(ks[16], (L, RWKV_HEADS, HEAD_DIM), f32),
        'ln_x_w': 1.0 + 0.02 * nrm(ks[17], (L, C), f32),
        'ln_x_b': 0.02 * nrm(ks[18], (L, C), f32),
        'sinks': 0.5 * nrm(ks[19], (L, SWA_HEADS), f32),
        'w_out': nrm(ks[20], (L, MIX_WIDTH, D_MODEL), f32) * MIX_WIDTH ** -0.5,
        'norm_ffn': 1.0 + 0.02 * nrm(ks[21], (L, D_MODEL), f32),
        'w_gate': nrm(ks[22], (L, D_MODEL, D_FF), f32) * D_MODEL ** -0.5,
        'w_up': nrm(ks[23], (L, D_MODEL, D_FF), f32) * D_MODEL ** -0.5,
        'w_down': nrm(ks[24], (L, D_FF, D_MODEL), f32) * D_FF ** -0.5,
        'norm_final': 1.0 + 0.02 * nrm(ks[25], (D_MODEL,), f32),
    }


def reference(x_prompt, x_sample, state_rwkv, state_shift, cache_swa_k, cache_swa_v, norm_attn, w_in,
              mu_shift, w0, w2, a0, a2, g2, k_k, k_a, r_k, ln_x_w, ln_x_b, sinks, w_out, norm_ffn,
              w_gate, w_up, w_down, norm_final):
    B = x_prompt.shape[0]
    yp, ys = x_prompt, x_sample
    p_state, p_shift, p_k, p_v = [], [], [], []
    s_state, s_shift, s_k, s_v = [], [], [], []
    for l in range(DEPTH):
        lw = (norm_attn[l], w_in[l], mu_shift[l], w0[l], w2[l], a0[l], a2[l], g2[l], k_k[l], k_a[l], r_k[l],
              ln_x_w[l], ln_x_b[l], sinks[l], w_out[l], norm_ffn[l], w_gate[l], w_up[l], w_down[l])
        zero_kv = jnp.zeros((B, WINDOW, SWA_KV_HEADS, HEAD_DIM), x_prompt.dtype)
        yp, st, sh, nk, nv = hybrid_layer(
            yp, jnp.zeros((B, RWKV_COLS), x_prompt.dtype),
            jnp.zeros((B, RWKV_HEADS, HEAD_DIM, HEAD_DIM), jnp.float32), zero_kv, zero_kv, 0, *lw)
        p_state.append(st); p_shift.append(sh); p_k.append(nk); p_v.append(nv)
        ys, st, sh, nk, nv = hybrid_layer(
            ys, state_shift[l], state_rwkv[l], cache_swa_k[l], cache_swa_v[l], PAST_LEN, *lw)
        s_state.append(st); s_shift.append(sh); s_k.append(nk); s_v.append(nv)
    y_prompt = rmsnorm(yp, norm_final)
    y_sample = rmsnorm(ys, norm_final)
    return (y_prompt, y_sample,
            jnp.stack(p_state), jnp.stack(p_shift), jnp.stack(p_k), jnp.stack(p_v),
            jnp.stack(s_state), jnp.stack(s_shift), jnp.stack(s_k), jnp.stack(s_v))
```

```cpp
#define MK_ONE_LAUNCH 1
#define REP_PRO 1
#define REP_GIN 1
#define REP_L1 1
#define REP_L3 1
#define REP_GGU 1
#define REP_L1A 1
#define REP_L1B 1
#define REP_L1C 1
#define REP_L3A 1
#define REP_L3B 1
#define REP_PREP 1
#define REP_STA 1
#define REP_STBC 1
#define LATE_WEIGHTS 1
#include <hip/hip_runtime.h>
#include <cstdio>
#include <cstdint>
namespace pg8 {
#define PG8_LAS __attribute__((address_space(3)))
typedef unsigned short bf16_t;
typedef short bf16x8 __attribute__((ext_vector_type(8)));
typedef float f32x4 __attribute__((ext_vector_type(4)));
typedef unsigned u32x4 __attribute__((ext_vector_type(4)));
constexpr int BM = 256, BK = 64, HALF = 128, HTB = HALF * BK * 2  , STAGE_BYTES = 8 * HTB, NXCD = 8, WGM = 8;

__host__ __device__ __forceinline__ int lds_byte(int r, int c) { const int st = (r >> 4) * 2 + (c >> 5), rr = r & 15, cc = c & 31, ob = rr * 64 + cc * 2; return st * 1024 + (ob ^ (((ob >> 9) & 1) << 5)); }
__host__ __device__ __forceinline__ void stage_rc(int b, int& R, int& C) { const int st = b / 1024, sb = b % 1024, swz = sb ^ (((sb >> 9) & 1) << 5); R = (st >> 1) * 16 + swz / 64; C = (st & 1) * 32 + (swz % 64) / 2; }
__host__ __device__ __forceinline__ int perm32(int rho) { const int n = rho >> 4, i = rho & 15; return 8 * (i >> 2) + 4 * n + (i & 3); }

struct Unit { int pm, pn, ks; };
struct Gemm { const bf16_t* A; const bf16_t* Bt; int M, N, K, ld; };

struct StaticOrder {
    int nM, nN, nwg, G, c, lim;
    __host__ __device__ void init(int M, int N, int G_, int c_) { nM = M / BM; nN = N / BM; nwg = nM * nN; G = G_; c = c_; lim = nwg; }
    __host__ __device__ void unit_of(int L, Unit& u) const {
        int wgid = L; { const int q = nwg / NXCD, r = nwg % NXCD, xcd = wgid % NXCD, off = wgid / NXCD; wgid = (xcd < r ? xcd * (q + 1) : r * (q + 1) + (xcd - r) * q) + off; }
        const int nig = WGM * nN, gid = wgid / nig, fm = gid * WGM, gsz = (nM - fm) < WGM ? (nM - fm) : WGM;
        u.pm = fm + ((wgid % nig) % gsz); u.pn = (wgid % nig) / gsz; u.ks = 0;
    }
    __host__ __device__ bool next(int i, Unit& u) const {
        const long L = (long)i * G + c; if (L >= lim) return false;
        u.ks = 0;
        int wgid = (int)L; { const int q = nwg / NXCD, r = nwg % NXCD, xcd = wgid % NXCD, off = wgid / NXCD; wgid = (xcd < r ? xcd * (q + 1) : r * (q + 1) + (xcd - r) * q) + off; }
        const int nig = WGM * nN, gid = wgid / nig, fm = gid * WGM, gsz = (nM - fm) < WGM ? (nM - fm) : WGM;
        u.pm = fm + ((wgid % nig) % gsz); u.pn = (wgid % nig) / gsz; return true;
    }
    __device__ __forceinline__ void a_ready(const Unit&) const {}
    __device__ __forceinline__ void done(const Unit&) const {}
};
struct ColumnOrder {
    int first, stride, nM, pn;
    __host__ __device__ bool next(int i, Unit& u) const { if (first < 0) return false; const int k = first + i * stride; if (k >= nM) return false; u.pm = k; u.pn = pn; u.ks = 0; return true; }
    __device__ __forceinline__ void a_ready(const Unit&) const {}
    __device__ __forceinline__ void done(const Unit&) const {}
};
struct SplitOrder {
    StaticOrder so; int base, nsl;
    __host__ __device__ bool next(int i, Unit& u) const {
        const long q = (long)i * so.G + so.c; if (q >= (long)(so.nwg - base) * nsl) return false;
        so.unit_of(base + (int)(q / nsl), u); u.ks = (int)(q % nsl); return true;
    }
    __device__ __forceinline__ void a_ready(const Unit&) const {}
    __device__ __forceinline__ void done(const Unit&) const {}
};

typedef __bf16 bf16x2_t __attribute__((ext_vector_type(2)));
typedef float f32x2_t __attribute__((ext_vector_type(2)));
__device__ __forceinline__ unsigned cvt_pk_bf16(float lo, float hi) { const f32x2_t v = {lo, hi}; return __builtin_bit_cast(unsigned, __builtin_convertvector(v, bf16x2_t)); }
typedef unsigned u32x2 __attribute__((ext_vector_type(2)));

struct EpiP {
    static constexpr bool PERM = true, AFTER_DRAIN = false;
    bf16_t* O; int ldc;
    __device__ __forceinline__ void operator()(const f32x4 (&acc)[2][2][4][2], const Unit& u, int wr, int wc, int fr, int fq) const {
        const int row0 = u.pm * BM + wr * 64 + fr, col0 = u.pn * BM + wc * 32 + 8 * fq;
#pragma unroll
        for (int ai = 0; ai < 2; ++ai)
#pragma unroll
            for (int m = 0; m < 4; ++m) { bf16_t* rowp = O + (size_t)(row0 + ai * HALF + m * 16) * ldc + col0;
#pragma unroll
                for (int bj = 0; bj < 2; ++bj) { const f32x4 v0 = acc[ai][bj][m][0], v1 = acc[ai][bj][m][1];
                    u32x4 w; w.x = cvt_pk_bf16(v0[0], v0[1]); w.y = cvt_pk_bf16(v0[2], v0[3]); w.z = cvt_pk_bf16(v1[0], v1[1]); w.w = cvt_pk_bf16(v1[2], v1[3]);
                    *(u32x4*)(rowp + bj * HALF) = w; } }
    }
};
struct EpiOut {
    static constexpr bool PERM = true, AFTER_DRAIN = false;
    const float* base0; const float* base1; int split; bf16_t* xb; float* ss; int ldc;
    __device__ __forceinline__ void operator()(const f32x4 (&acc)[2][2][4][2], const Unit& u, int wr, int wc, int fr, int fq) const {
        const int row0 = u.pm * BM + wr * 64 + fr, col0 = u.pn * BM + wc * 32 + 8 * fq;
#pragma unroll
        for (int ai = 0; ai < 2; ++ai)
#pragma unroll
            for (int m = 0; m < 4; ++m) {
                const int row = row0 + ai * HALF + m * 16;
                const float* bp = (row < split ? base0 + (size_t)row * ldc : base1 + (size_t)(row - split) * ldc) + col0;
                float s = 0.f;
#pragma unroll
                for (int bj = 0; bj < 2; ++bj) {
                    const f32x4 o0 = *(const f32x4*)(bp + bj * HALF) + acc[ai][bj][m][0], o1 = *(const f32x4*)(bp + bj * HALF + 4) + acc[ai][bj][m][1];
                    s += ((o0[0] * o0[0] + o0[1] * o0[1]) + (o0[2] * o0[2] + o0[3] * o0[3])) + ((o1[0] * o1[0] + o1[1] * o1[1]) + (o1[2] * o1[2] + o1[3] * o1[3]));
                    u32x4 w; w.x = cvt_pk_bf16(o0[0], o0[1]); w.y = cvt_pk_bf16(o0[2], o0[3]); w.z = cvt_pk_bf16(o1[0], o1[1]); w.w = cvt_pk_bf16(o1[2], o1[3]);
                    *(u32x4*)(xb + (size_t)row * ldc + col0 + bj * HALF) = w;
                }
                s += __shfl_xor(s, 16); s += __shfl_xor(s, 32);
                if (fq == 0) atomicAdd(ss + row, s);
            }
    }
};
struct EpiDown {
    static constexpr bool PERM = true, AFTER_DRAIN = false;
    bf16_t* xb; int ldc;
    __device__ __forceinline__ void operator()(const f32x4 (&acc)[2][2][4][2], const Unit& u, int wr, int wc, int fr, int fq) const {
        const int row0 = u.pm * BM + wr * 64 + fr, col0 = u.pn * BM + wc * 32 + 8 * fq;
#pragma unroll
        for (int ai = 0; ai < 2; ++ai)
#pragma unroll
            for (int m = 0; m < 4; ++m) {
                bf16_t* rp = xb + (size_t)(row0 + ai * HALF + m * 16) * ldc + col0;
#pragma unroll
                for (int bj = 0; bj < 2; ++bj) {
                    const u32x4 b = *(const u32x4*)(rp + bj * HALF);
                    const f32x4 v0 = acc[ai][bj][m][0], v1 = acc[ai][bj][m][1];
                    u32x4 w;
                    w.x = cvt_pk_bf16(__builtin_bit_cast(float, b.x << 16) + v0[0], __builtin_bit_cast(float, b.x & 0xffff0000u) + v0[1]);
                    w.y = cvt_pk_bf16(__builtin_bit_cast(float, b.y << 16) + v0[2], __builtin_bit_cast(float, b.y & 0xffff0000u) + v0[3]);
                    w.z = cvt_pk_bf16(__builtin_bit_cast(float, b.z << 16) + v1[0], __builtin_bit_cast(float, b.z & 0xffff0000u) + v1[1]);
                    w.w = cvt_pk_bf16(__builtin_bit_cast(float, b.w << 16) + v1[2], __builtin_bit_cast(float, b.w & 0xffff0000u) + v1[3]);
                    *(u32x4*)(rp + bj * HALF) = w;
                }
            }
    }
};
struct EpiGU {
    static constexpr bool PERM = true, AFTER_DRAIN = false;
    bf16_t* H; int ldh; const float* ss; float inv_n, eps;
    __device__ __forceinline__ void operator()(const f32x4 (&acc)[2][2][4][2], const Unit& u, int wr, int wc, int fr, int fq) const {
        const int row0 = u.pm * BM + wr * 64 + fr, col0 = u.pn * HALF + wc * 32 + 8 * fq;
#pragma unroll
        for (int ai = 0; ai < 2; ++ai)
#pragma unroll
            for (int m = 0; m < 4; ++m) {
                const int row = row0 + ai * HALF + m * 16;
                const float rs = __builtin_amdgcn_rsqf(ss[row] * inv_n + eps);
                float h[8];
#pragma unroll
                for (int n = 0; n < 2; ++n)
#pragma unroll
                    for (int j = 0; j < 4; ++j) {
                        const float g = acc[ai][0][m][n][j] * rs, up = acc[ai][1][m][n][j] * rs;
                        const float sg = __builtin_amdgcn_rcpf(1.0f + __expf(-g));
                        h[n * 4 + j] = g * sg * up;
                    }
                u32x4 w; w.x = cvt_pk_bf16(h[0], h[1]); w.y = cvt_pk_bf16(h[2], h[3]); w.z = cvt_pk_bf16(h[4], h[5]); w.w = cvt_pk_bf16(h[6], h[7]);
                *(u32x4*)(H + (size_t)row * ldh + col0) = w;
            }
    }
};

struct EpiSlab {
    static constexpr bool PERM = false, AFTER_DRAIN = false;
    float* slab; const StaticOrder* so_unused; int base, nsl, nN, nM, nwg;
    __device__ __forceinline__ void operator()(const f32x4 (&acc)[2][2][4][2], const Unit& u, int wr, int wc, int fr, int fq) const {
        float* sp = slab + ((size_t)(tail_index(u) * nsl + u.ks) << 16);
        const int r0 = wr * 64 + fr, c0 = wc * 32 + 4 * fq;
#pragma unroll
        for (int ai = 0; ai < 2; ++ai)
#pragma unroll
            for (int m = 0; m < 4; ++m)
#pragma unroll
                for (int bj = 0; bj < 2; ++bj)
#pragma unroll
                    for (int n = 0; n < 2; ++n) *(f32x4*)(sp + (size_t)(r0 + ai * HALF + m * 16) * 256 + c0 + bj * HALF + n * 16) = acc[ai][bj][m][n];
    }
    __device__ __forceinline__ int tail_index(const Unit& u) const {
        StaticOrder so; so.nM = nM; so.nN = nN; so.nwg = nwg; so.G = 0; so.c = 0; so.lim = nwg;
        int t = 0;
        for (int L = base; L < nwg; ++L) { Unit v; so.unit_of(L, v); if (v.pm == u.pm && v.pn == u.pn) t = L - base; }
        return t;
    }
};
template <class Epi, class Sched, bool ALIGN_EPI = false, bool SP2 = false, bool NARROW = false>
__device__ __forceinline__ void gemm_phase(PG8_LAS unsigned char* lds, const Gemm g, const Sched& S, const Epi& E) {
    const int tid = threadIdx.x, wid = __builtin_amdgcn_readfirstlane(tid >> 6), lane = tid & 63, wr = wid >> 2, wc = wid & 3, fr = lane & 15, fq = lane >> 4;
    const int K = g.K, nt = K / BK;
    unsigned voffA[2], voffB[2];
#pragma unroll
    for (int i = 0; i < 2; ++i) { int R, C; stage_rc(tid * 16 + i * 8192, R, C); const int Rb = Epi::PERM ? ((R & ~31) + perm32(R & 31)) : R;
        voffA[i] = (unsigned)(R * g.ld + C) * 2u; voffB[i] = (unsigned)(Rb * g.ld + C) * 2u; }
    const size_t kstep = (size_t)(BK * 2);
    const size_t hstep = (size_t)HALF * g.ld * 2;
    const size_t tstep = 2 * hstep;
    const unsigned ldsw = (unsigned)wid * 1024u;
    const int aoff = lds_byte(wr * 64 + fr, fq * 8), boff = lds_byte(wc * 32 + fr, fq * 8);
#define PG8_SA(b, h) (((b) * 2 + (h)) * HTB)
#define PG8_SB(b, h) ((4 + (b) * 2 + (h)) * HTB)
#define PG8_STAGE(bufoff, gbase, voff) do { _Pragma("unroll") for (int _i = 0; _i < 2; ++_i) \
        __builtin_amdgcn_global_load_lds((const unsigned*)((const char*)(gbase) + (voff)[_i]), (PG8_LAS unsigned*)(lds + (bufoff) + ldsw + _i * 8192), 16, 0, 0); } while (0)
#define PG8_LDA(dst, b, h) do { _Pragma("unroll") for (int m = 0; m < 4; ++m) _Pragma("unroll") for (int k = 0; k < 2; ++k) dst[m][k] = *(const PG8_LAS bf16x8*)(lds + PG8_SA(b, h) + aoff + m * 2048 + k * 1024); } while (0)
#define PG8_LDB(dst, b, h) do { _Pragma("unroll") for (int n = 0; n < 2; ++n) _Pragma("unroll") for (int k = 0; k < 2; ++k) dst[n][k] = *(const PG8_LAS bf16x8*)(lds + PG8_SB(b, h) + boff + n * 2048 + k * 1024); } while (0)
#define PG8_MMA(ai, bj, At, Bt) do { if (NARROW && !((bj) == 0 && wc == 0)) break; __builtin_amdgcn_s_setprio(1); _Pragma("unroll") for (int m = 0; m < 4; ++m) _Pragma("unroll") for (int n = 0; n < 2; ++n) _Pragma("unroll") for (int k = 0; k < 2; ++k) \
        acc[ai][bj][m][n] = __builtin_amdgcn_mfma_f32_16x16x32_bf16(Bt[n][k], At[m][k], acc[ai][bj][m][n], 0, 0, 0); __builtin_amdgcn_s_setprio(0); } while (0)
#define PG8_WAIT_V(n) asm volatile("s_waitcnt vmcnt(" #n ")" ::: "memory")
#define PG8_WAIT_L(n) asm volatile("s_waitcnt lgkmcnt(" #n ")" ::: "memory")
#define PG8_BAR __builtin_amdgcn_s_barrier()
#define PG8_SCHED __builtin_amdgcn_sched_barrier(0)
    Unit cur, nxt; int ui = 0;
    if (!S.next(0, cur)) return;
    f32x4 acc[2][2][4][2];
#pragma unroll
    for (int a = 0; a < 2; ++a)
#pragma unroll
        for (int b = 0; b < 2; ++b)
#pragma unroll
            for (int m = 0; m < 4; ++m)
#pragma unroll
                for (int n = 0; n < 2; ++n) acc[a][b][m][n] = (f32x4){0.f, 0.f, 0.f, 0.f};
    bf16x8 At[4][2], B0[2][2], B1[2][2];
    const size_t sstep = (size_t)K * 2;
    const char* cA = (const char*)g.A + (size_t)cur.pm * tstep + (size_t)cur.ks * sstep; const char* cB = (const char*)g.Bt + (size_t)cur.pn * tstep + (size_t)cur.ks * sstep;
    S.a_ready(cur);
    if constexpr (SP2) {
        PG8_STAGE(PG8_SB(0, 0), cB, voffB); PG8_STAGE(PG8_SB(0, 1), cB + hstep, voffB); PG8_STAGE(PG8_SA(0, 0), cA, voffA); PG8_STAGE(PG8_SA(0, 1), cA + hstep, voffA);
        if (wr == 1) PG8_BAR;
        PG8_WAIT_V(2); PG8_BAR;
        PG8_STAGE(PG8_SB(1, 0), cB + kstep, voffB); PG8_STAGE(PG8_SA(1, 0), cA + kstep, voffA); PG8_STAGE(PG8_SB(1, 1), cB + hstep + kstep, voffB);
        PG8_WAIT_V(6); PG8_BAR;
    } else {
        PG8_STAGE(PG8_SB(0, 0), cB, voffB); PG8_STAGE(PG8_SA(0, 0), cA, voffA); PG8_STAGE(PG8_SB(0, 1), cB + hstep, voffB); PG8_STAGE(PG8_SA(0, 1), cA + hstep, voffA);
        if (wr == 1) PG8_BAR;
        PG8_WAIT_V(4); PG8_BAR;
        PG8_STAGE(PG8_SB(1, 0), cB + kstep, voffB); PG8_STAGE(PG8_SA(1, 0), cA + kstep, voffA); PG8_STAGE(PG8_SB(1, 1), cB + hstep + kstep, voffB);
        PG8_WAIT_V(6); PG8_BAR;
    }
    for (;;) {
        const bool has_next = S.next(ui + 1, nxt);
        const char* nA = has_next ? (const char*)g.A + (size_t)nxt.pm * tstep + (size_t)nxt.ks * sstep : cA; const char* nB = has_next ? (const char*)g.Bt + (size_t)nxt.pn * tstep + (size_t)nxt.ks * sstep : cB;
        for (int t = 0; t < nt; t += 2) {
            const bool last = (t == nt - 2);
            const char* a1 = cA + (size_t)(t + 1) * kstep;
            const char* a2 = last ? nA : cA + (size_t)(t + 2) * kstep; const char* b2 = last ? nB : cB + (size_t)(t + 2) * kstep;
            const char* a3 = a2 + kstep; const char* b3 = b2 + kstep;
            if (last && has_next) S.a_ready(nxt);
            if constexpr (SP2) {
            PG8_LDB(B0, 0, 0); PG8_LDB(B1, 0, 1); PG8_SCHED; PG8_LDA(At, 0, 0); PG8_STAGE(PG8_SA(1, 1), a1 + hstep, voffA);
            PG8_WAIT_V(8); PG8_WAIT_L(0); PG8_BAR; PG8_MMA(0, 0, At, B0); PG8_MMA(0, 1, At, B1); PG8_BAR; PG8_SCHED;
            PG8_LDA(At, 0, 1); PG8_STAGE(PG8_SB(0, 0), b2, voffB); PG8_STAGE(PG8_SB(0, 1), b2 + hstep, voffB); PG8_STAGE(PG8_SA(0, 0), a2, voffA);
            PG8_WAIT_V(8); PG8_WAIT_L(0); PG8_BAR; PG8_MMA(1, 0, At, B0); PG8_MMA(1, 1, At, B1); PG8_BAR; PG8_SCHED;
            PG8_LDB(B0, 1, 0); PG8_LDB(B1, 1, 1); PG8_SCHED; PG8_LDA(At, 1, 0); PG8_STAGE(PG8_SA(0, 1), a2 + hstep, voffA);
            PG8_WAIT_V(8); PG8_WAIT_L(0); PG8_BAR; PG8_MMA(0, 0, At, B0); PG8_MMA(0, 1, At, B1); PG8_BAR; PG8_SCHED;
            PG8_LDA(At, 1, 1); PG8_STAGE(PG8_SB(1, 0), b3, voffB); PG8_STAGE(PG8_SB(1, 1), b3 + hstep, voffB); PG8_STAGE(PG8_SA(1, 0), a3, voffA);
            PG8_WAIT_V(8); PG8_WAIT_L(0); PG8_BAR; PG8_MMA(1, 0, At, B0); PG8_MMA(1, 1, At, B1); PG8_BAR; PG8_SCHED;
            } else {
            PG8_LDB(B0, 0, 0); PG8_SCHED; PG8_LDA(At, 0, 0); PG8_STAGE(PG8_SA(1, 1), a1 + hstep, voffA);
            PG8_WAIT_L(8); PG8_BAR; PG8_WAIT_L(0); PG8_MMA(0, 0, At, B0); PG8_BAR; PG8_SCHED;
            PG8_LDB(B1, 0, 1); PG8_STAGE(PG8_SB(0, 0), b2, voffB);
            PG8_BAR; PG8_WAIT_L(0); PG8_MMA(0, 1, At, B1); PG8_BAR;
            PG8_LDA(At, 0, 1); PG8_STAGE(PG8_SA(0, 0), a2, voffA);
            PG8_BAR; PG8_WAIT_L(0); PG8_MMA(1, 0, At, B0); PG8_BAR; PG8_SCHED;
            PG8_STAGE(PG8_SB(0, 1), b2 + hstep, voffB);
            PG8_WAIT_V(6); PG8_BAR; PG8_MMA(1, 1, At, B1); PG8_BAR;
            PG8_LDB(B0, 1, 0); PG8_SCHED; PG8_LDA(At, 1, 0); PG8_STAGE(PG8_SA(0, 1), a2 + hstep, voffA);
            PG8_WAIT_L(8); PG8_BAR; PG8_WAIT_L(0); PG8_MMA(0, 0, At, B0); PG8_BAR; PG8_SCHED;
            PG8_LDB(B1, 1, 1); PG8_STAGE(PG8_SB(1, 0), b3, voffB);
            PG8_BAR; PG8_WAIT_L(0); PG8_MMA(0, 1, At, B1); PG8_BAR;
            PG8_LDA(At, 1, 1); PG8_STAGE(PG8_SA(1, 0), a3, voffA);
            PG8_BAR; PG8_WAIT_L(0); PG8_MMA(1, 0, At, B0); PG8_BAR; PG8_SCHED;
            PG8_STAGE(PG8_SB(1, 1), b3 + hstep, voffB);
            PG8_WAIT_V(6); PG8_BAR; PG8_MMA(1, 1, At, B1); PG8_BAR;
            }
        }
        if constexpr (ALIGN_EPI) { if (wr == 0) PG8_BAR; }
        if constexpr (!Epi::AFTER_DRAIN) { E(acc, cur, wr, wc, fr, fq); S.done(cur); }
        if (!has_next) break;
#pragma unroll
        for (int a = 0; a < 2; ++a)
#pragma unroll
            for (int b = 0; b < 2; ++b)
#pragma unroll
                for (int m = 0; m < 4; ++m)
#pragma unroll
                    for (int n = 0; n < 2; ++n) acc[a][b][m][n] = (f32x4){0.f, 0.f, 0.f, 0.f};
        cur = nxt; cA = nA; cB = nB; ++ui;
        if constexpr (ALIGN_EPI) { if (wr == 1) PG8_BAR; }
    }
    PG8_WAIT_V(0);
    if constexpr (!ALIGN_EPI) { if (wr == 0) PG8_BAR; }
    PG8_BAR;
    if constexpr (Epi::AFTER_DRAIN) { E.fused(acc, cur, wr, wc, fr, fq, lds, wid, lane); S.done(cur); }
#undef PG8_SA
#undef PG8_SB
#undef PG8_STAGE
#undef PG8_LDA
#undef PG8_LDB
#undef PG8_MMA
#undef PG8_WAIT_V
#undef PG8_WAIT_L
#undef PG8_BAR
#undef PG8_SCHED
}
}

constexpr int NWAVES = 8;
constexpr int DM = 2048, TP = 16384, NB = 128, TS = 4, MS = NB * TS, M = TP + MS;
constexpr int HD = 64, NH = 16, CW = 1024;
constexpr int RCOLS = 3360, INC = 4896, PPITCH = 5120;
constexpr int C_R = 0, C_K = 1024, C_V = 2048, C_XW = 3072, C_XA = 3136, C_XG = 3200, C_Q = 3360, C_SK = 4384, C_SV = 4640;
constexpr int KVH = 4, WIN = 128, KVW = KVH * HD;
constexpr int DFF = 5632;
constexpr float RMS_EPS = 1e-5f, GN_EPS = 64e-5f;
constexpr size_t O_YP = 0, O_YS = 33554432, O_PST = 34603008, O_PSH = 34668544, O_PCK = 34671904, O_PCV = 34704672,
                 O_SST = 34737440, O_SSH = 43126048, O_SCK = 43556128, O_SCV = 47750432, O_END = 51944736;
constexpr size_t MiB = 1u << 20;
constexpr size_t WS_CTL = 0, CTL_ZERO_BYTES = 64 * 1024;
constexpr size_t WS_SS1 = 1 * MiB, WS_SS2 = 1 * MiB + 128 * 1024;
constexpr size_t WS_W2T = 2 * MiB, WS_A2T = 2 * MiB + 128 * 1024, WS_G2T = 2 * MiB + 256 * 1024;
constexpr size_t WS_WIN = 4 * MiB, WS_WOUT = 24 * MiB, WS_WGU = 32 * MiB, WS_WDN = 76 * MiB;
constexpr size_t WS_XN = 98 * MiB, WS_MIX = 164 * MiB, WS_P = 230 * MiB, WS_H = 230 * MiB, WS_SEG = 412 * MiB, WS_SST = 420 * MiB, WS_TL = 424 * MiB, WS_END = 640 * MiB;
constexpr size_t TL_REC = 41472;
static_assert(WS_TL + (size_t)16 * 256 * TL_REC <= WS_END, "ws map (operand records)");
static_assert(WS_WIN + (size_t)PPITCH * DM * 2 <= WS_WOUT && WS_WOUT + (size_t)DM * DM * 2 <= WS_WGU && WS_WGU + (size_t)2 * DFF * DM * 2 <= WS_WDN && WS_WDN + (size_t)DM * DFF * 2 <= WS_XN, "ws map (weights)");
static_assert(WS_XN + (size_t)M * DM * 2 <= WS_MIX && WS_MIX + (size_t)M * DM * 2 <= WS_P && WS_P + (size_t)M * PPITCH * 2 <= WS_SEG && WS_H + (size_t)M * DFF * 2 <= WS_SEG, "ws map (activations)");
constexpr int CW_BAR = 4096, CW_OUTTAIL = 2048;
constexpr int NGIN = 4864;
constexpr int GDN_FULL = 512, GDN_NSL = 11;
constexpr size_t WS_SLAB = 592 * MiB;
static_assert(DFF % (GDN_NSL * 128) == 0, "slab map");
constexpr int RING_BYTES = 131072, LDS_BYTES = 163840, MISC_OFF = LDS_BYTES - 256;

#define GAS __attribute__((address_space(1)))
#define LAS __attribute__((address_space(3)))
typedef unsigned short bf16;
typedef unsigned v4u __attribute__((ext_vector_type(4)));
typedef float f32x4 __attribute__((ext_vector_type(4)));
typedef short bf16x8 __attribute__((ext_vector_type(8)));
#define LDS_WAIT() asm volatile("s_waitcnt lgkmcnt(0)" ::: "memory")
#define VM_WAIT() asm volatile("s_waitcnt vmcnt(0)" ::: "memory")
__device__ __forceinline__ unsigned f2bf(float f) { unsigned u = __builtin_bit_cast(unsigned, f); return (u + 0x7fffu + ((u >> 16) & 1u)) >> 16; }
__device__ __forceinline__ unsigned pk2(float lo, float hi) { return pg8::cvt_pk_bf16(lo, hi); }
__device__ __forceinline__ float bf2f(unsigned short b) { return __builtin_bit_cast(float, (unsigned)b << 16); }
__device__ __forceinline__ float bflo(unsigned w) { return __builtin_bit_cast(float, w << 16); }
__device__ __forceinline__ float bfhi(unsigned w) { return __builtin_bit_cast(float, w & 0xffff0000u); }
__device__ __forceinline__ float sigmoidf_(float x) { return 1.0f / (1.0f + __expf(-x)); }
__device__ __forceinline__ float wave_sum(float v) {
#pragma unroll
    for (int o = 1; o < 64; o <<= 1) v += __shfl_xor(v, o);
    return v;
}
__device__ __forceinline__ float wave_max(float v) {
#pragma unroll
    for (int o = 1; o < 64; o <<= 1) v = fmaxf(v, __shfl_xor(v, o));
    return v;
}

#define XB_TMO      128
#define XB_XCNT(j)  (256  + 64 * (j))
#define XB_XSUB(j)  (1280 + 64 * (j))
#define XB_XGEN(j)  (2304 + 64 * (j))
#define XB_TOP      3328
#define XB_TOPGEN   3392
#define XCD_BAR_WORDS 3456
#define XB_SPIN_CAP (1u << 18)
__device__ __forceinline__ unsigned xb_ld(unsigned* p)              { return __hip_atomic_load(p, __ATOMIC_RELAXED, __HIP_MEMORY_SCOPE_AGENT); }
__device__ __forceinline__ unsigned xb_add(unsigned* p, unsigned v) { return __hip_atomic_fetch_add(p, v, __ATOMIC_RELAXED, __HIP_MEMORY_SCOPE_AGENT); }
__device__ __forceinline__ unsigned xb_xcc_id() { return (unsigned)__builtin_amdgcn_s_getreg((3 << 11) | 20) & 0xFu; }
#define XB_SPIN(cond, bar) do { unsigned _sp = 0; while (cond) { __builtin_amdgcn_s_sleep(1); \
    if ((++_sp & 255u) == 0u) { if (xb_ld(&(bar)[XB_TMO])) break; if (_sp > XB_SPIN_CAP) { atomicAdd(&(bar)[XB_TMO], 1u); break; } } } } while (0)
struct XcdBarrier { unsigned* bar; unsigned x; volatile LAS unsigned* st; };
__device__ __forceinline__ XcdBarrier xcd_barrier_post(unsigned* bar, volatile LAS unsigned* st) {
    XcdBarrier b; b.bar = bar; b.x = xb_xcc_id(); b.st = st;
    if (threadIdx.x == 0) (void)xb_add(&bar[XB_XCNT(b.x)], 1u);
    return b;
}
__device__ __forceinline__ void xcd_barrier_complete(unsigned* bar, unsigned x, unsigned& nloc, unsigned& nx) {
    const unsigned G = gridDim.x * gridDim.y * gridDim.z;
    unsigned sum, cnt, mine, sp = 0u;
    for (;;) {
        sum = 0u; cnt = 0u; mine = 0u;
#pragma unroll
        for (unsigned j = 0; j < 16; ++j) { const unsigned c = xb_ld(&bar[XB_XCNT(j)]); sum += c; cnt += (c > 0u) ? 1u : 0u; mine = (j == x) ? c : mine; }
        if (sum == G) break;
        __builtin_amdgcn_s_sleep(1);
        if ((++sp & 255u) == 0u) { if (xb_ld(&bar[XB_TMO])) break; if (sp > XB_SPIN_CAP) { atomicAdd(&bar[XB_TMO], 1u); break; } }
    }
    nloc = mine > 0u ? mine : 1u; nx = cnt > 0u ? cnt : 1u;
}
__device__ __forceinline__ void xcd_barrier(const XcdBarrier& b) {
    asm volatile("s_waitcnt vmcnt(0)" ::: "memory");
    __syncthreads();
    if (threadIdx.x == 0) {
        unsigned* bar = b.bar;
        __builtin_amdgcn_s_waitcnt(0);
        unsigned nloc = b.st[0], nx = b.st[1];
        if (nloc == 0u) { xcd_barrier_complete(bar, b.x, nloc, nx); b.st[0] = nloc; b.st[1] = nx; }
        const unsigned old = xb_add(&bar[XB_XSUB(b.x)], 1u);
        const unsigned gen = old / nloc;
        if (old + 1u == (gen + 1u) * nloc) {
            __builtin_amdgcn_fence(__ATOMIC_RELEASE, "agent");
            asm volatile("s_waitcnt vmcnt(0)" ::: "memory");
            const unsigned og = xb_add(&bar[XB_TOP], 1u);
            const unsigned tg = og / nx;
            if (og + 1u == (tg + 1u) * nx) xb_add(&bar[XB_TOPGEN], 1u);
            else XB_SPIN(xb_ld(&bar[XB_TOPGEN]) == tg, bar);
            __builtin_amdgcn_fence(__ATOMIC_ACQUIRE, "agent");
            xb_add(&bar[XB_XGEN(b.x)], 1u);
            asm volatile("s_waitcnt vmcnt(0)" ::: "memory");
        } else {
            XB_SPIN(xb_ld(&bar[XB_XGEN(b.x)]) == gen, bar);
            __builtin_amdgcn_fence(__ATOMIC_ACQUIRE, "agent");
            asm volatile("s_waitcnt vmcnt(0)" ::: "memory");
        }
    }
    __syncthreads();
}

struct Args { const float* in[26]; float* out; unsigned char* ws; int ph_lo, ph_hi; };
enum { I_XP = 0, I_XS, I_STATE, I_SHIFT, I_CK, I_CV, I_NATT, I_WIN, I_MU, I_W0, I_W2, I_A0, I_A2, I_G2, I_KK, I_KA, I_RK, I_LNW, I_LNB, I_SINK, I_WOUT, I_NFFN, I_WG, I_WU, I_WD, I_NFIN };

__device__ __forceinline__ void p0_transpose_item(const float* W, int N, bf16* WT, int ldk, int k0, int n0, int row0, int ncols, const float* ksc, LAS float* scr, int lane) {
    const int n4 = lane & 15, kl = lane >> 4;
    f32x4 v[16];
#pragma unroll
    for (int i = 0; i < 16; ++i) { v[i] = (f32x4){0.f, 0.f, 0.f, 0.f}; if (4 * n4 < ncols) v[i] = *(const f32x4*)(W + (size_t)(k0 + 4 * i + kl) * N + n0 + 4 * n4); }
#pragma unroll
    for (int i = 0; i < 16; ++i) { const int k = 4 * i + kl; const float sc = ksc ? ksc[k0 + k] : 1.0f; LAS float* d = scr + k * 65 + 4 * n4;
        d[0] = v[i].x * sc; d[1] = v[i].y * sc; d[2] = v[i].z * sc; d[3] = v[i].w * sc; }
    LDS_WAIT(); asm volatile("" ::: "memory");
    const int c = lane & 7;
#pragma unroll
    for (int j = 0; j < 8; ++j) { const int n = (lane >> 3) + 8 * j; const LAS float* s = scr + (8 * c) * 65 + n;
        v4u o; o.x = pk2(s[0 * 65], s[1 * 65]); o.y = pk2(s[2 * 65], s[3 * 65]); o.z = pk2(s[4 * 65], s[5 * 65]); o.w = pk2(s[6 * 65], s[7 * 65]);
        if (n < ncols) *(GAS v4u*)(WT + (size_t)(row0 + n) * ldk + k0 + 8 * c) = o; }
    LDS_WAIT(); asm volatile("" ::: "memory");
}
__device__ __forceinline__ void convert_late_weights(const Args& a, LAS unsigned char* lds, int gw, int NGW, int wave, int lane, int part) {
    unsigned char* ws = a.ws;
    LAS float* scr = (LAS float*)(lds + wave * 16640);
    constexpr int I_OUT = (DM / 64) * (DM / 64), I_GU = (DM / 64) * (DFF / 64), I_DN = (DFF / 64) * (DM / 64);
    bf16* Wout = (bf16*)(ws + WS_WOUT); bf16* Wgu = (bf16*)(ws + WS_WGU); bf16* Wdn = (bf16*)(ws + WS_WDN);
    const int lo = part == 1 ? I_OUT + 2 * I_GU : 0, hi = part == 0 ? I_OUT + 2 * I_GU : I_OUT + 2 * I_GU + I_DN;
    for (int it = lo + gw; it < hi; it += NGW) {
        int r = it;
        if (r < I_OUT) { const int nblk = DM / 64, kb = r / nblk, nb = r % nblk; p0_transpose_item(a.in[I_WOUT], DM, Wout, DM, 64 * kb, 64 * nb, 64 * nb, 64, nullptr, scr, lane); continue; } r -= I_OUT;
        if (r < 2 * I_GU) { const int s = r / I_GU; r -= s * I_GU; const int nblk = DFF / 64, kb = r / nblk, nb = r % nblk, f0 = 64 * nb;
            p0_transpose_item(a.in[s ? I_WU : I_WG], DFF, Wgu, DM, 64 * kb, f0, 256 * (f0 >> 7) + 128 * s + (f0 & 127), 64, a.in[I_NFFN], scr, lane); continue; } r -= 2 * I_GU;
        { const int nblk = DM / 64, kb = r / nblk, nb = r % nblk; p0_transpose_item(a.in[I_WD], DM, Wdn, DFF, 64 * kb, 64 * nb, 64 * nb, 64, nullptr, scr, lane); }
    }
}
__device__ __forceinline__ void rms_row_to_bf16(const float* xrow, const float* g, bf16* orow, int lane) {
    const GAS f32x4* xr = (const GAS f32x4*)xrow + lane;
    f32x4 v[8]; float s = 0.f;
#pragma unroll
    for (int j = 0; j < 8; ++j) { v[j] = xr[64 * j]; s += (v[j].x * v[j].x + v[j].y * v[j].y) + (v[j].z * v[j].z + v[j].w * v[j].w); }
    const float rs = 1.0f / sqrtf(wave_sum(s) * (1.f / DM) + RMS_EPS);
    GAS unsigned long long* o8 = (GAS unsigned long long*)orow + lane;
#pragma unroll
    for (int j = 0; j < 8; ++j) { const f32x4 gg = *((const f32x4*)g + lane + 64 * j);
        o8[64 * j] = (unsigned long long)pk2(v[j].x * rs * gg.x, v[j].y * rs * gg.y) | ((unsigned long long)pk2(v[j].z * rs * gg.z, v[j].w * rs * gg.w) << 32); }
}

__device__ __forceinline__ void p0_prologue(const Args& a, LAS unsigned char* lds, int vcu, int G, int wave, int lane) {
    unsigned char* ws = a.ws;
    LAS float* scr = (LAS float*)(lds + wave * 16640);
    const int gw = vcu * NWAVES + wave, NGW = G * NWAVES;
    constexpr int NBI = (INC + 63) / 64, I_IN = (DM / 64) * NBI;
    bf16* Win = (bf16*)(ws + WS_WIN);
    for (int it = gw; it < I_IN; it += NGW) { const int kb = it / NBI, nb = it % NBI; p0_transpose_item(a.in[I_WIN], INC, Win, DM, 64 * kb, 64 * nb, 64 * nb, (INC - 64 * nb) < 64 ? (INC - 64 * nb) : 64, nullptr, scr, lane); }
#if !LATE_WEIGHTS
    convert_late_weights(a, lds, gw, NGW, wave, lane, 2);
#endif
    { GAS v4u* z = (GAS v4u*)(Win + (size_t)INC * DM); const int n16 = (PPITCH - INC) * DM * 2 / 16;
      for (int i = gw * 64 + lane; i < n16; i += NGW * 64) z[i] = (v4u){0u, 0u, 0u, 0u}; }
    { float* s1 = (float*)(ws + WS_SS1); float* s2 = (float*)(ws + WS_SS2);
      for (int i = gw * 64 + lane; i < M; i += NGW * 64) { s1[i] = 0.f; s2[i] = 0.f; } }
    { bf16* w2t = (bf16*)(ws + WS_W2T); bf16* a2t = (bf16*)(ws + WS_A2T); bf16* g2t = (bf16*)(ws + WS_G2T);
      for (int i = gw * 64 + lane; i < CW * 64; i += NGW * 64) { const int c = i >> 6, k = i & 63; w2t[i] = (bf16)f2bf(a.in[I_W2][(size_t)k * CW + c]); a2t[i] = (bf16)f2bf(a.in[I_A2][(size_t)k * CW + c]); }
      for (int i = gw * 64 + lane; i < CW * 160; i += NGW * 64) { const int c = i / 160, k = i % 160; g2t[i] = (bf16)f2bf(a.in[I_G2][(size_t)k * CW + c]); } }
    bf16* XN = (bf16*)(ws + WS_XN);
    for (int m = gw; m < M; m += NGW) {
        const float* xr = m < TP ? a.in[I_XP] + (size_t)m * DM : a.in[I_XS] + (size_t)(m - TP) * DM;
        rms_row_to_bf16(xr, a.in[I_NATT], XN + (size_t)m * DM, lane);
    }
}

__device__ __forceinline__ void final_norm(const Args& a, int vcu, int G, int wave, int lane) {
    const int gw = vcu * NWAVES + wave, NGW = G * NWAVES;
    const f32x4* gf = (const f32x4*)a.in[I_NFIN];
    const float* slab = (const float*)(a.ws + WS_SLAB);
    const bf16* XB = (const bf16*)(a.ws + WS_XN);
    pg8::StaticOrder so; so.init(M, DM, G, 0);
    for (int m = gw; m < M; m += NGW) {
        const pg8::u32x2* xr = (const pg8::u32x2*)(XB + (size_t)m * DM) + lane;
        f32x4 v[8];
#pragma unroll
        for (int j = 0; j < 8; ++j) { const pg8::u32x2 w = xr[64 * j]; v[j] = (f32x4){bflo(w.x), bfhi(w.x), bflo(w.y), bfhi(w.y)}; }
        const int pm = m >> 8, rl = m & 255;
        for (int t = 0; t < so.nwg - GDN_FULL; ++t) {
            pg8::Unit u; so.unit_of(GDN_FULL + t, u);
            if (u.pm == pm) {
                f32x4 s = {0.f, 0.f, 0.f, 0.f};
                for (int ks = 0; ks < GDN_NSL; ++ks) s += *(const f32x4*)(slab + ((size_t)(t * GDN_NSL + ks) << 16) + (size_t)rl * 256 + 4 * lane);
#pragma unroll
                for (int j = 0; j < 8; ++j) if (j == u.pn) v[j] += s;
            }
        }
        float ss = 0.f;
#pragma unroll
        for (int j = 0; j < 8; ++j) ss += (v[j].x * v[j].x + v[j].y * v[j].y) + (v[j].z * v[j].z + v[j].w * v[j].w);
        const float rs = 1.0f / sqrtf(wave_sum(ss) * (1.f / DM) + RMS_EPS);
        GAS f32x4* yr = (GAS f32x4*)(a.out + (size_t)m * DM) + lane;
#pragma unroll
        for (int j = 0; j < 8; ++j) { const f32x4 g = gf[lane + 64 * j]; yr[64 * j] = v[j] * rs * g; }
    }
}

namespace rw {
constexpr int SEGS = 16, SEGLEN = TP / SEGS, BLK = 64, NBLK = SEGLEN / BLK;
constexpr int T_R = 0, T_W = 16384, T_K = 32768, T_V = 49152, T_NKK = 65536, T_B = 81920, T_G = 98304, T_OUT = 114688;
constexpr int TWP = 72, SGP = 168;
constexpr int ST_TW = 114688, ST_XA = ST_TW + 64 * TWP * 2, ST_SG = ST_XA + 64 * TWP * 2, T_BONUS = ST_SG + 64 * SGP * 2, T_END = T_BONUS + 256;
constexpr int T_UO = 114688;
constexpr int T_TOT = 147456;
constexpr int T_ULOC = 131072, T_PSEQ = T_NKK, T_UF = T_W, T_GL = T_BONUS + 256, T_S0 = T_GL + 256, T_SST = T_B;
static_assert(T_S0 + 8192 <= 163840 - 256 && T_TOT + 2048 <= ST_SG + 64 * SGP * 2 && T_ULOC + 16384 <= T_TOT, "rwkv LDS map (L3)");
constexpr int SL_OFF = 0, SLP = 68, PM_OFF = 32768;
static_assert(T_END <= 163840 - 512, "rwkv LDS map");

__device__ __forceinline__ float dpp_add(float x, const int ctrl_sel) {
    int y;
    switch (ctrl_sel) {
        case 0: y = __builtin_amdgcn_update_dpp(0, __builtin_bit_cast(int, x), 0xB1, 0xF, 0xF, true); break;
        case 1: y = __builtin_amdgcn_update_dpp(0, __builtin_bit_cast(int, x), 0x4E, 0xF, 0xF, true); break;
        case 2: y = __builtin_amdgcn_update_dpp(0, __builtin_bit_cast(int, x), 0x141, 0xF, 0xF, true); break;
        default: y = __builtin_amdgcn_update_dpp(0, __builtin_bit_cast(int, x), 0x140, 0xF, 0xF, true); break;
    }
    return x + __builtin_bit_cast(float, y);
}
__device__ __forceinline__ float allreduce16(float x) { x = dpp_add(x, 0); x = dpp_add(x, 1); x = dpp_add(x, 2); x = dpp_add(x, 3); return x; }
__device__ __forceinline__ float allreduce8(float x) { x = dpp_add(x, 0); x = dpp_add(x, 1); x = dpp_add(x, 2); return x; }
__device__ __forceinline__ float dot4(const f32x4 a, const f32x4 b) { return (a.x * b.x + a.y * b.y) + (a.z * b.z + a.w * b.w); }
__device__ __forceinline__ void ld8bf(const bf16* p, float (&o)[8]) { const v4u w = *(const v4u*)p; o[0] = bflo(w.x); o[1] = bfhi(w.x); o[2] = bflo(w.y); o[3] = bfhi(w.y); o[4] = bflo(w.z); o[5] = bfhi(w.z); o[6] = bflo(w.w); o[7] = bfhi(w.w); }
__device__ __forceinline__ void ld8f(const float* p, float (&o)[8]) { const f32x4 a = *(const f32x4*)p, b = *(const f32x4*)(p + 4); o[0] = a.x; o[1] = a.y; o[2] = a.z; o[3] = a.w; o[4] = b.x; o[5] = b.y; o[6] = b.z; o[7] = b.w; }
__device__ __forceinline__ float fast_tanh(float x) { return 1.0f - 2.0f * __builtin_amdgcn_rcpf(1.0f + __expf(2.0f * x)); }
__device__ __forceinline__ float fast_sigmoid(float x) { return __builtin_amdgcn_rcpf(1.0f + __expf(-x)); }

struct SlotSrc { const bf16* cur; const bf16* prevb; const float* prevf; };

__device__ __forceinline__ void shift8(const SlotSrc& s, const float* mu, int col, float (&xs)[8]) {
    float x[8], p[8], m[8];
    ld8bf(s.cur + col, x); ld8f(mu + col, m);
    if (s.prevb) ld8bf(s.prevb + col, p);
    else if (s.prevf) ld8f(s.prevf + col, p);
    else {
#pragma unroll
        for (int j = 0; j < 8; ++j) p[j] = 0.f; }
#pragma unroll
    for (int j = 0; j < 8; ++j) xs[j] = x[j] + m[j] * (p[j] - x[j]);
}
__device__ __forceinline__ void st8(LAS unsigned char* lds, int off, const float (&v)[8]) {
    *(LAS f32x4*)(lds + off) = (f32x4){v[0], v[1], v[2], v[3]}; *(LAS f32x4*)(lds + off + 16) = (f32x4){v[4], v[5], v[6], v[7]};
}
__device__ __forceinline__ void ld8l(LAS unsigned char* lds, int off, float (&v)[8]) {
    const f32x4 a = *(LAS f32x4*)(lds + off), b = *(LAS f32x4*)(lds + off + 16); v[0] = a.x; v[1] = a.y; v[2] = a.z; v[3] = a.w; v[4] = b.x; v[5] = b.y; v[6] = b.z; v[7] = b.w;
}

struct PrepRegs { v4u cur[8], prv[8]; };
template <bool FULL, class SrcFn>
__device__ __forceinline__ void prep_issue(int h, const SrcFn& srcfn, int tid, PrepRegs& R) {
    const int slot = tid >> 3, part = tid & 7, c8 = h * HD + part * 8;
    const SlotSrc s = srcfn(slot);
#pragma unroll
    for (int q = 0; q < 8; ++q) {
        const int col = q == 0 ? C_R + c8 : q == 1 ? C_K + c8 : q == 2 ? C_V + c8 : C_XW + 8 * (part + 8 * (q - 3));
        const bool on = q == 0 ? FULL : q < 3 ? true : (part + 8 * (q - 3)) < (FULL ? 36 : 16);
        R.cur[q] = (v4u){0u, 0u, 0u, 0u}; R.prv[q] = (v4u){0u, 0u, 0u, 0u};
        if (on) { R.cur[q] = *(const v4u*)(s.cur + col); if (s.prevb) R.prv[q] = *(const v4u*)(s.prevb + col);
            else if (s.prevf) { const f32x4 p0 = *(const f32x4*)(s.prevf + col), p1 = *(const f32x4*)(s.prevf + col + 4);
                R.prv[q] = (v4u){pg8::cvt_pk_bf16(p0[0], p0[1]), pg8::cvt_pk_bf16(p0[2], p0[3]), pg8::cvt_pk_bf16(p1[0], p1[1]), pg8::cvt_pk_bf16(p1[2], p1[3])}; } }
    }
}
constexpr int L_XO = 16384, L_XR = 69632;
constexpr int T_TOT2 = 11264;
constexpr int L_ABF = 0, L_DINV = 9216, L_BBF = 32768, L_KBF = 41984, L_VBF = 51200, L_RBF = 60416, L_PCT = 83968, L_NL = 93184, L_ML = 102400, L_RB = 111616, L_RK = 120832, L_ND = 130048, L_XROW = 134144, L_XP = 272;
constexpr int T_CMU = T_S0, T_CKK = T_CMU + 2048, T_CKA = T_CKK + 256, T_CRK = T_CKA + 256, T_CW0 = T_CRK + 256, T_CA0 = T_CW0 + 256;
__device__ __forceinline__ void prep_consts_fill(const Args& a, LAS unsigned char* lds, int h, int tid) {
    { const int q = tid >> 6, part = (tid >> 3) & 7, e = tid & 7;
      const int col = q == 0 ? C_R + h * HD + part * 8 : q == 1 ? C_K + h * HD + part * 8 : q == 2 ? C_V + h * HD + part * 8 : C_XW + 8 * (part + 8 * (q - 3));
      const bool on = q < 3 ? true : (part + 8 * (q - 3)) < 36;
      *(LAS float*)(lds + T_CMU + tid * 4) = on ? a.in[I_MU][col + e] : 0.f; }
    if (tid < 320) { const int arr = tid >> 6, ch = tid & 63; const int idx = arr == 0 ? I_KK : arr == 1 ? I_KA : arr == 2 ? I_RK : arr == 3 ? I_W0 : I_A0;
      *(LAS float*)(lds + T_CKK + tid * 4) = a.in[idx][h * HD + ch]; }
}
struct LoraFrags { bf16x8 bw[2], ba[2], bg[5]; };
template <bool FULL>
__device__ __forceinline__ void lora_frags_load(const Args& a, int h, int tid, LoraFrags& F) {
    const int lane = tid & 63, wave = tid >> 6, fr = lane & 15, fq = lane >> 4, ct = wave & 3;
    const bf16* w2t = (const bf16*)(a.ws + WS_W2T); const bf16* a2t = (const bf16*)(a.ws + WS_A2T); const bf16* g2t = (const bf16*)(a.ws + WS_G2T);
    const int c = h * HD + 16 * ct + fr;
#pragma unroll
    for (int ks = 0; ks < 2; ++ks) { F.bw[ks] = *(const bf16x8*)(w2t + (size_t)c * 64 + ks * 32 + 8 * fq); F.ba[ks] = *(const bf16x8*)(a2t + (size_t)c * 64 + ks * 32 + 8 * fq); }
    if (FULL) {
#pragma unroll
        for (int ks = 0; ks < 5; ++ks) F.bg[ks] = *(const bf16x8*)(g2t + (size_t)c * 160 + ks * 32 + 8 * fq); }
}
template <bool FULL, bool PREVF, int RP, bool PRE, bool STORE, bool HOISTF, bool L1M, class SrcFn>
__device__ __forceinline__ void prep_block(const Args& a, LAS unsigned char* lds, int h, const SrcFn& srcfn, int tid, const PrepRegs& R, unsigned char* rec, LoraFrags& F) {
    const int lane = tid & 63, wave = __builtin_amdgcn_readfirstlane(tid >> 6);
    const float* mu = a.in[I_MU];
    const int fr = lane & 15, fq = lane >> 4;
    float keep_r[8], keep_k[8], keep_kk[8], keep_v[8];
    {
        const int slot = tid >> 3, part = tid & 7, ch8 = part * 8, c8 = h * HD + ch8;
        const SlotSrc s = srcfn(slot);
        constexpr int NV = 8;
        int col[NV]; bool on[NV];
        col[0] = C_R + c8; on[0] = FULL; col[1] = C_K + c8; on[1] = true; col[2] = C_V + c8; on[2] = true;
#pragma unroll
        for (int q = 0; q < 5; ++q) { const int ci = part + 8 * q; col[3 + q] = C_XW + 8 * ci; on[3 + q] = ci < (FULL ? 36 : 16); }
        float kkc[8]; if (HOISTF) ld8l(lds, T_CKK + ch8 * 4, kkc); else ld8f(a.in[I_KK] + c8, kkc);
        const int toff = slot * 256 + ch8 * 4;
        constexpr int GS = PREVF ? 2 : 4;
#pragma unroll
        for (int g0 = 0; g0 < NV; g0 += GS) {
            v4u cur[GS], prv[GS]; f32x4 pf[GS][2], mv[GS][2];
#pragma unroll
            for (int qq = 0; qq < GS; ++qq) { const int q = g0 + qq; if (on[q]) { if (PRE) cur[qq] = R.cur[q]; else cur[qq] = *(const v4u*)(s.cur + col[q]); } }
#pragma unroll
            for (int qq = 0; qq < GS; ++qq) { const int q = g0 + qq; if (on[q]) {
                prv[qq] = (v4u){0u, 0u, 0u, 0u};
                if (PRE) prv[qq] = R.prv[q]; else if (s.prevb) prv[qq] = *(const v4u*)(s.prevb + col[q]);
                if (PREVF) { if (s.prevf) { pf[qq][0] = *(const f32x4*)(s.prevf + col[q]); pf[qq][1] = *(const f32x4*)(s.prevf + col[q] + 4); } }
            } }
#pragma unroll
            for (int qq = 0; qq < GS; ++qq) { const int q = g0 + qq; if (on[q]) {
                if (HOISTF) { mv[qq][0] = *(LAS f32x4*)(lds + T_CMU + (q * 8 + part) * 32); mv[qq][1] = *(LAS f32x4*)(lds + T_CMU + (q * 8 + part) * 32 + 16); }
                else { mv[qq][0] = *(const f32x4*)(mu + col[q]); mv[qq][1] = *(const f32x4*)(mu + col[q] + 4); } } }
#pragma unroll
            for (int qq = 0; qq < GS; ++qq) { const int q = g0 + qq; if (on[q]) {
                float x[8], p[8], xs[8];
                x[0] = bflo(cur[qq].x); x[1] = bfhi(cur[qq].x); x[2] = bflo(cur[qq].y); x[3] = bfhi(cur[qq].y); x[4] = bflo(cur[qq].z); x[5] = bfhi(cur[qq].z); x[6] = bflo(cur[qq].w); x[7] = bfhi(cur[qq].w);
                p[0] = bflo(prv[qq].x); p[1] = bfhi(prv[qq].x); p[2] = bflo(prv[qq].y); p[3] = bfhi(prv[qq].y); p[4] = bflo(prv[qq].z); p[5] = bfhi(prv[qq].z); p[6] = bflo(prv[qq].w); p[7] = bfhi(prv[qq].w);
                if (PREVF) { if (s.prevf) { p[0] = pf[qq][0].x; p[1] = pf[qq][0].y; p[2] = pf[qq][0].z; p[3] = pf[qq][0].w; p[4] = pf[qq][1].x; p[5] = pf[qq][1].y; p[6] = pf[qq][1].z; p[7] = pf[qq][1].w; } }
                const float m8[8] = {mv[qq][0].x, mv[qq][0].y, mv[qq][0].z, mv[qq][0].w, mv[qq][1].x, mv[qq][1].y, mv[qq][1].z, mv[qq][1].w};
#pragma unroll
                for (int e = 0; e < 8; ++e) xs[e] = x[e] + m8[e] * (p[e] - x[e]);
                if (q == 0) { if (L1M) {
#pragma unroll
                        for (int e = 0; e < 8; ++e) keep_r[e] = xs[e]; } else st8(lds, T_R + toff, xs); }
                else if (q == 1) { if (L1M) {
#pragma unroll
                        for (int e = 0; e < 8; ++e) { keep_k[e] = xs[e]; keep_kk[e] = xs[e] * kkc[e]; } }
                    else { st8(lds, T_K + toff, xs);
#pragma unroll
                        for (int e = 0; e < 8; ++e) xs[e] *= kkc[e];
                        st8(lds, T_NKK + toff, xs); } }
                else if (q == 2) { if (L1M) {
#pragma unroll
                        for (int e = 0; e < 8; ++e) keep_v[e] = xs[e]; } else st8(lds, T_V + toff, xs); }
                else {
                    const int ci = part + 8 * (q - 3); int off;
                    if (ci < 8) { off = ST_TW + slot * (TWP * 2) + ci * 16;
#pragma unroll
                        for (int e = 0; e < 8; ++e) xs[e] = fast_tanh(xs[e]); }
                    else if (ci < 16) off = ST_XA + slot * (TWP * 2) + (ci - 8) * 16;
                    else { off = ST_SG + slot * (SGP * 2) + (ci - 16) * 16;
#pragma unroll
                        for (int e = 0; e < 8; ++e) xs[e] = fast_sigmoid(xs[e]); }
                    v4u o; o.x = pk2(xs[0], xs[1]); o.y = pk2(xs[2], xs[3]); o.z = pk2(xs[4], xs[5]); o.w = pk2(xs[6], xs[7]);
                    *(LAS v4u*)(lds + off) = o;
                }
            } }
        }
    }
    if (!HOISTF) lora_frags_load<FULL>(a, h, tid, F);
    __syncthreads();
    {
        const int ct = wave & 3, rth = wave >> 2;
        const int ch = 16 * ct + fr, c = h * HD + ch;
        const float w0 = HOISTF ? *(LAS float*)(lds + T_CW0 + ch * 4) : a.in[I_W0][c], a0 = HOISTF ? *(LAS float*)(lds + T_CA0 + ch * 4) : a.in[I_A0][c];
        float wl[2][4];
#pragma unroll
        for (int rt2 = 0; rt2 < 2; ++rt2) {
            const int rt = 2 * rth + rt2;
            bf16x8 atw[2], axa[2], asg[5];
#pragma unroll
            for (int ks = 0; ks < 2; ++ks) {
                atw[ks] = *(LAS bf16x8*)(lds + ST_TW + (16 * rt + fr) * (TWP * 2) + (ks * 32 + 8 * fq) * 2);
                axa[ks] = *(LAS bf16x8*)(lds + ST_XA + (16 * rt + fr) * (TWP * 2) + (ks * 32 + 8 * fq) * 2);
            }
            if (FULL) {
#pragma unroll
                for (int ks = 0; ks < 5; ++ks) asg[ks] = *(LAS bf16x8*)(lds + ST_SG + (16 * rt + fr) * (SGP * 2) + (ks * 32 + 8 * fq) * 2);
            }
            f32x4 accW = {0.f, 0.f, 0.f, 0.f}, accA = {0.f, 0.f, 0.f, 0.f}, accG = {0.f, 0.f, 0.f, 0.f};
#pragma unroll
            for (int ks = 0; ks < 2; ++ks) {
                accW = __builtin_amdgcn_mfma_f32_16x16x32_bf16(atw[ks], F.bw[ks], accW, 0, 0, 0);
                accA = __builtin_amdgcn_mfma_f32_16x16x32_bf16(axa[ks], F.ba[ks], accA, 0, 0, 0);
            }
            if (FULL) {
#pragma unroll
                for (int ks = 0; ks < 5; ++ks) accG = __builtin_amdgcn_mfma_f32_16x16x32_bf16(asg[ks], F.bg[ks], accG, 0, 0, 0);
            }
#pragma unroll
            for (int rg = 0; rg < 4; ++rg) {
                const int slot = 16 * rt + 4 * fq + rg, off = slot * 256 + ch * 4;
                wl[rt2][rg] = -0.60653065971f * fast_sigmoid(w0 + accW[rg]);
                if (!L1M) *(LAS float*)(lds + T_W + off) = wl[rt2][rg];
                *(LAS float*)(lds + T_B + off) = fast_sigmoid(a0 + accA[rg]);
                if (FULL) *(LAS float*)(lds + T_G + off) = accG[rg];
            }
        }
        if (L1M) {
#pragma unroll
            for (int rt2 = 0; rt2 < 2; ++rt2) { wl[rt2][1] += wl[rt2][0]; wl[rt2][2] += wl[rt2][1]; wl[rt2][3] += wl[rt2][2]; }
            const float g0 = wl[0][3], g1 = wl[1][3];
            float s0 = g0, s1 = g1;
            { const float t0 = __shfl_up(s0, 16), t1 = __shfl_up(s1, 16); if (fq >= 1) { s0 += t0; s1 += t1; } }
            { const float t0 = __shfl_up(s0, 32), t1 = __shfl_up(s1, 32); if (fq >= 2) { s0 += t0; s1 += t1; } }
            const float tot0 = __shfl(s0, 48 + fr);
            const float e0 = s0 - g0, e1 = s1 - g1 + tot0;
#pragma unroll
            for (int rg = 0; rg < 4; ++rg) { wl[0][rg] += e0; wl[1][rg] += e1; }
            if (rth == 0 && fq == 3) *(LAS float*)(lds + T_TOT2 + ch * 4) = __expf(wl[1][3]);
#pragma unroll
            for (int rt2 = 0; rt2 < 2; ++rt2)
#pragma unroll
                for (int rg = 0; rg < 4; ++rg) *(LAS float*)(lds + T_W + (16 * (2 * rth + rt2) + 4 * fq + rg) * 256 + ch * 4) = __expf(wl[rt2][rg]);
        }
    }
    __syncthreads();
    if (!L1M) {
        const int ch = tid & 63, so = tid >> 6;
        float c[8]; float run = 0.f;
#pragma unroll
        for (int i2 = 0; i2 < 8; ++i2) { const int slot = 8 * so + i2; if ((slot % RP) == 0) run = 0.f; run += *(LAS float*)(lds + T_W + slot * 256 + ch * 4); c[i2] = run; }
        if (RP > 8) {
            *(LAS float*)(lds + T_TOT + (so * 64 + ch) * 4) = run;
            __syncthreads();
            float pre = 0.f;
#pragma unroll
            for (int q = 0; q < RP / 8 - 1; ++q) { const int so2 = (so / (RP / 8)) * (RP / 8) + q; if (so2 < so) pre += *(LAS float*)(lds + T_TOT + (so2 * 64 + ch) * 4); }
#pragma unroll
            for (int i2 = 0; i2 < 8; ++i2) c[i2] += pre;
        }
#pragma unroll
        for (int i2 = 0; i2 < 8; ++i2) *(LAS float*)(lds + T_W + (8 * so + i2) * 256 + ch * 4) = c[i2];
        __syncthreads();
    }
    {
        const int slot = tid >> 3, part = tid & 7, ch8 = part * 8, c8 = h * HD + ch8, toff = slot * 256 + ch8 * 4;
        float kkr[8], av[8], k[8], ka[8], cu[8], cp[8];
        if (L1M) {
#pragma unroll
            for (int j2 = 0; j2 < 8; ++j2) { kkr[j2] = keep_kk[j2]; k[j2] = keep_k[j2]; } }
        else { ld8l(lds, T_NKK + toff, kkr); ld8l(lds, T_K + toff, k); }
        ld8l(lds, T_B + toff, av); if (HOISTF) ld8l(lds, T_CKA + ch8 * 4, ka); else ld8f(a.in[I_KA] + c8, ka); ld8l(lds, T_W + toff, cu);
        if ((slot % RP) != 0) ld8l(lds, T_W + toff - 256, cp);
        else {
#pragma unroll
            for (int j2 = 0; j2 < 8; ++j2) cp[j2] = L1M ? 1.f : 0.f; }
        if (L1M && slot >= 32) { float t8[8]; ld8l(lds, T_TOT2 + ch8 * 4, t8);
#pragma unroll
            for (int j2 = 0; j2 < 8; ++j2) { cu[j2] *= t8[j2]; if (slot > 32) cp[j2] *= t8[j2]; } }
        float ssq = 0.f;
#pragma unroll
        for (int j2 = 0; j2 < 8; ++j2) ssq += kkr[j2] * kkr[j2];
        ssq = allreduce8(ssq);
        const float inv = 1.0f / fmaxf(sqrtf(ssq), 1e-12f);
        float nk[8], bb[8], kp[8], g1[8];
        float bs = 0.f;
        float r[8], rk[8];
        if (FULL) { if (L1M) {
#pragma unroll
                for (int j2 = 0; j2 < 8; ++j2) r[j2] = keep_r[j2]; } else ld8l(lds, T_R + toff, r);
            if (HOISTF) ld8l(lds, T_CRK + ch8 * 4, rk); else ld8f(a.in[I_RK] + c8, rk); }
        float vv[8], gg[8];
        if (L1M) { ld8l(lds, T_G + toff, gg);
#pragma unroll
            for (int j2 = 0; j2 < 8; ++j2) vv[j2] = keep_v[j2]; }
#pragma unroll
        for (int j2 = 0; j2 < 8; ++j2) {
            const float kk = kkr[j2] * inv; const float kpv = k[j2] * (1.0f + (av[j2] - 1.0f) * ka[j2]);
            g1[j2] = L1M ? cu[j2] : __expf(cu[j2]); const float gi = __builtin_amdgcn_rcpf(g1[j2]), g0 = L1M ? cp[j2] : __expf(cp[j2]);
            if (FULL) bs += r[j2] * kpv * rk[j2];
            nk[j2] = -kk * g0; bb[j2] = kk * av[j2] * gi; kp[j2] = kpv * gi;
        }
        if (!L1M) { st8(lds, T_NKK + toff, nk); st8(lds, T_B + toff, bb); st8(lds, T_K + toff, kp); }
        if (FULL) {
#pragma unroll
            for (int j2 = 0; j2 < 8; ++j2) r[j2] *= g1[j2];
            if (!L1M) st8(lds, T_R + toff, r);
            bs = allreduce8(bs);
            if (part == 0) *(LAS float*)(lds + T_BONUS + slot * 4) = bs;
            if (slot == 63) st8(lds, T_GL + ch8 * 4, g1);
            if (STORE) {
                const int go = slot * 128 + part * 16;
                if (!L1M) { ld8l(lds, T_V + toff, vv); ld8l(lds, T_G + toff, gg); }
                v4u w;
                w.x = pg8::cvt_pk_bf16(r[0], r[1]); w.y = pg8::cvt_pk_bf16(r[2], r[3]); w.z = pg8::cvt_pk_bf16(r[4], r[5]); w.w = pg8::cvt_pk_bf16(r[6], r[7]); if (!L1M) *(v4u*)(rec + go) = w; else *(LAS v4u*)(lds + L_RBF + slot * 144 + part * 16) = w;
                w.x = pg8::cvt_pk_bf16(bb[0], bb[1]); w.y = pg8::cvt_pk_bf16(bb[2], bb[3]); w.z = pg8::cvt_pk_bf16(bb[4], bb[5]); w.w = pg8::cvt_pk_bf16(bb[6], bb[7]); if (!L1M) *(v4u*)(rec + 8192 + go) = w;
                if (L1M) *(LAS v4u*)(lds + L_BBF + slot * 144 + part * 16) = w;
                w.x = pg8::cvt_pk_bf16(kp[0], kp[1]); w.y = pg8::cvt_pk_bf16(kp[2], kp[3]); w.z = pg8::cvt_pk_bf16(kp[4], kp[5]); w.w = pg8::cvt_pk_bf16(kp[6], kp[7]); if (!L1M) *(v4u*)(rec + 16384 + go) = w;
                if (L1M) *(LAS v4u*)(lds + L_KBF + slot * 144 + part * 16) = w;
                w.x = pg8::cvt_pk_bf16(vv[0], vv[1]); w.y = pg8::cvt_pk_bf16(vv[2], vv[3]); w.z = pg8::cvt_pk_bf16(vv[4], vv[5]); w.w = pg8::cvt_pk_bf16(vv[6], vv[7]); *(v4u*)(rec + 24576 + go) = w;
                if (L1M) { *(LAS v4u*)(lds + L_VBF + slot * 144 + part * 16) = w;
                    v4u wa; wa.x = pg8::cvt_pk_bf16(nk[0], nk[1]); wa.y = pg8::cvt_pk_bf16(nk[2], nk[3]); wa.z = pg8::cvt_pk_bf16(nk[4], nk[5]); wa.w = pg8::cvt_pk_bf16(nk[6], nk[7]); *(LAS v4u*)(lds + L_ABF + slot * 144 + part * 16) = wa; }
                w.x = pg8::cvt_pk_bf16(gg[0], gg[1]); w.y = pg8::cvt_pk_bf16(gg[2], gg[3]); w.z = pg8::cvt_pk_bf16(gg[4], gg[5]); w.w = pg8::cvt_pk_bf16(gg[6], gg[7]); *(v4u*)(rec + 32768 + go) = w;
                if (part == 0) *(float*)(rec + 40960 + slot * 4) = bs;
                if (slot == 63) { *(f32x4*)(rec + 41216 + ch8 * 4) = (f32x4){g1[0], g1[1], g1[2], g1[3]}; *(f32x4*)(rec + 41216 + ch8 * 4 + 16) = (f32x4){g1[4], g1[5], g1[6], g1[7]}; }
            }
        }
    }
    __syncthreads();
}

typedef float f2 __attribute__((ext_vector_type(2)));
struct L1Ops { f2 a[4], b[4], k[4]; f2 v; };
template <bool IS_STATE>
__device__ __forceinline__ void l1_load(LAS unsigned char* lds, int slot, int coff, int rp, L1Ops& o) {
    const int ro = slot * 256 + coff;
    const f32x4 a0 = *(LAS f32x4*)(lds + T_NKK + ro), a1 = *(LAS f32x4*)(lds + T_NKK + ro + 16);
    const f32x4 b0 = *(LAS f32x4*)(lds + T_B + ro), b1 = *(LAS f32x4*)(lds + T_B + ro + 16);
    o.a[0] = a0.xy; o.a[1] = a0.zw; o.a[2] = a1.xy; o.a[3] = a1.zw; o.b[0] = b0.xy; o.b[1] = b0.zw; o.b[2] = b1.xy; o.b[3] = b1.zw;
    if (IS_STATE) { const f32x4 k0 = *(LAS f32x4*)(lds + T_K + ro), k1 = *(LAS f32x4*)(lds + T_K + ro + 16); o.k[0] = k0.xy; o.k[1] = k0.zw; o.k[2] = k1.xy; o.k[3] = k1.zw;
        o.v = *(LAS f2*)(lds + T_V + slot * 256 + rp * 8); }
}
template <bool IS_STATE>
__device__ __forceinline__ void l1_compute(f2 (&S)[2][4], const L1Ops& o, bf16* uo, bool wr) {
    f2 u2;
#pragma unroll
    for (int r = 0; r < 2; ++r) {
        f2 acc = S[r][0] * o.a[0]; acc = __builtin_elementwise_fma(S[r][1], o.a[1], acc); acc = __builtin_elementwise_fma(S[r][2], o.a[2], acc); acc = __builtin_elementwise_fma(S[r][3], o.a[3], acc);
        const float u = allreduce8(acc.x + acc.y);
        u2[r] = u;
        const f2 uu = {u, u};
#pragma unroll
        for (int q = 0; q < 4; ++q) S[r][q] = __builtin_elementwise_fma(o.b[q], uu, S[r][q]);
        if (IS_STATE) { const f2 vv = {o.v[r], o.v[r]};
#pragma unroll
            for (int q = 0; q < 4; ++q) S[r][q] = __builtin_elementwise_fma(o.k[q], vv, S[r][q]); }
    }
    if (wr) *(unsigned*)uo = pk2(u2.x, u2.y);
}
template <bool IS_STATE, int NSB>
__device__ __forceinline__ void l1_steps(LAS unsigned char* lds, f2 (&S)[2][4], int cg, int rp, bf16* up) {
    const int coff = cg * 32;
#pragma unroll 1
    for (int sb = 0; sb < 64 / NSB; ++sb) {
        L1Ops A, B;
        l1_load<IS_STATE>(lds, sb * NSB, coff, rp, A);
#pragma unroll 2
        for (int tt = sb * NSB; tt < sb * NSB + NSB; tt += 2) {
            l1_load<IS_STATE>(lds, tt + 1, coff, rp, B);
            asm volatile("" ::: "memory");
            l1_compute<IS_STATE>(S, A, up + tt * 128 + rp * 2, cg == 0);
            l1_load<IS_STATE>(lds, tt + 2 < 64 ? tt + 2 : 63, coff, rp, A);
            asm volatile("" ::: "memory");
            l1_compute<IS_STATE>(S, B, up + (tt + 1) * 128 + rp * 2, cg == 0);
        }
        const f32x4 g0 = *(LAS f32x4*)(lds + T_W + (sb * NSB + NSB - 1) * 256 + coff), g1 = *(LAS f32x4*)(lds + T_W + (sb * NSB + NSB - 1) * 256 + coff + 16);
        const f2 e0 = {__expf(g0.x), __expf(g0.y)}, e1 = {__expf(g0.z), __expf(g0.w)}, e2 = {__expf(g1.x), __expf(g1.y)}, e3 = {__expf(g1.z), __expf(g1.w)};
#pragma unroll
        for (int r = 0; r < 2; ++r) { S[r][0] *= e0; S[r][1] *= e1; S[r][2] *= e2; S[r][3] *= e3; }
    }
}
struct L3Ops { f2 a[2], b[2], k[2], r[2]; f2 v; };
__device__ __forceinline__ void l3_load(LAS unsigned char* lds, int slot, int coff, int rg, L3Ops& o) {
    const int ro = slot * 256 + coff;
    const f32x4 a = *(LAS f32x4*)(lds + T_NKK + ro), b = *(LAS f32x4*)(lds + T_B + ro), k = *(LAS f32x4*)(lds + T_K + ro), rr = *(LAS f32x4*)(lds + T_R + ro);
    o.a[0] = a.xy; o.a[1] = a.zw; o.b[0] = b.xy; o.b[1] = b.zw; o.k[0] = k.xy; o.k[1] = k.zw; o.r[0] = rr.xy; o.r[1] = rr.zw;
    o.v = *(LAS f2*)(lds + T_V + slot * 256 + rg * 8);
}
template <int RP>
__device__ __forceinline__ void l3_compute(LAS unsigned char* lds, f2 (&S)[2][2], const L3Ops& o, int tt, int cg, int rg, int coff) {
    f2 o2;
#pragma unroll
    for (int r = 0; r < 2; ++r) {
        f2 acc = S[r][0] * o.a[0]; acc = __builtin_elementwise_fma(S[r][1], o.a[1], acc);
        const float u = allreduce16(acc.x + acc.y);
        const f2 uu = {u, u}, vv = {o.v[r], o.v[r]};
        S[r][0] = __builtin_elementwise_fma(o.b[0], uu, S[r][0]); S[r][1] = __builtin_elementwise_fma(o.b[1], uu, S[r][1]);
        S[r][0] = __builtin_elementwise_fma(o.k[0], vv, S[r][0]); S[r][1] = __builtin_elementwise_fma(o.k[1], vv, S[r][1]);
        f2 e = S[r][0] * o.r[0]; e = __builtin_elementwise_fma(S[r][1], o.r[1], e);
        o2[r] = allreduce16(e.x + e.y);
    }
    if (cg == 0) *(LAS f2*)(lds + T_OUT + tt * 256 + rg * 8) = o2;
    if ((tt % RP) == RP - 1) {
        const f32x4 g = *(LAS f32x4*)(lds + T_W + tt * 256 + coff);
        const f2 e0 = {__expf(g.x), __expf(g.y)}, e1 = {__expf(g.z), __expf(g.w)};
        S[0][0] *= e0; S[0][1] *= e1; S[1][0] *= e0; S[1][1] *= e1;
    }
}
template <int RP>
__device__ __forceinline__ void l3_steps(LAS unsigned char* lds, f2 (&S)[2][2], int cg, int rg, int t0, int t1) {
    const int coff = cg * 16;
    L3Ops A, B;
    l3_load(lds, t0, coff, rg, A);
#pragma unroll 1
    for (int tt = t0; tt < t1; tt += 2) {
        l3_load(lds, tt + 1, coff, rg, B);
        asm volatile("" ::: "memory");
        l3_compute<RP>(lds, S, A, tt, cg, rg, coff);
        l3_load(lds, tt + 2 < 64 ? tt + 2 : 63, coff, rg, A);
        asm volatile("" ::: "memory");
        l3_compute<RP>(lds, S, B, tt + 1, cg, rg, coff);
    }
}
template <class RowFn>
__device__ __forceinline__ void post_block(const Args& a, LAS unsigned char* lds, int h, const RowFn& rowfn, int tid) {
    const int slot = tid >> 3, part = tid & 7, ch8 = part * 8, c8 = h * HD + ch8, toff = slot * 256 + ch8 * 4;
    float o[8], v[8], g[8], lw[8], lb[8];
    ld8l(lds, T_OUT + toff, o); ld8l(lds, T_V + toff, v); ld8l(lds, T_G + toff, g); ld8f(a.in[I_LNW] + c8, lw); ld8f(a.in[I_LNB] + c8, lb);
    float s = 0.f;
#pragma unroll
    for (int j = 0; j < 8; ++j) s += o[j];
    const float mean = allreduce8(s) * (1.f / 64.f);
    float q = 0.f;
#pragma unroll
    for (int j = 0; j < 8; ++j) { o[j] -= mean; q += o[j] * o[j]; }
    const float rstd = 1.0f / sqrtf(allreduce8(q) * (1.f / 64.f) + GN_EPS);
    const float bonus = *(LAS float*)(lds + T_BONUS + slot * 4);
    float res[8];
#pragma unroll
    for (int j = 0; j < 8; ++j) res[j] = (o[j] * rstd * lw[j] + lb[j] + bonus * v[j]) * g[j];
    const long m = rowfn(slot);
    if (m >= 0) { v4u w; w.x = pk2(res[0], res[1]); w.y = pk2(res[2], res[3]); w.z = pk2(res[4], res[5]); w.w = pk2(res[6], res[7]);
        *(v4u*)((bf16*)(a.ws + WS_MIX) + (size_t)m * DM + c8) = w; }
}

__device__ __forceinline__ void l1_unit(const Args& a, LAS unsigned char* lds, int h, int s, int tid) {
    const bf16* P = (const bf16*)(a.ws + WS_P);
    const int cg = tid & 7, rp = tid >> 3;
    const bool is_state = __builtin_amdgcn_readfirstlane(tid >> 6) < 4;
    f2 S[2][4];
#pragma unroll
    for (int r = 0; r < 2; ++r)
#pragma unroll
        for (int q = 0; q < 4; ++q) { S[r][q] = (f2){0.f, 0.f}; if (!is_state) { const int d = (2 * rp + r - 64) - (8 * cg + 2 * q); if (d >= 0 && d < 2) S[r][q][d] = 1.0f; } }
    PrepRegs R; LoraFrags LF; lora_frags_load<true>(a, h, tid, LF);
    prep_consts_fill(a, lds, h, tid);
    __syncthreads();
    { const int mb = s * SEGLEN; auto src0 = [&](int slot) -> SlotSrc { const int m = mb + slot; SlotSrc r; r.cur = P + (size_t)m * PPITCH; r.prevb = m > 0 ? r.cur - PPITCH : nullptr; r.prevf = nullptr; return r; };
      prep_issue<true>(h, src0, tid, R); }
    for (int blk = 0; blk < NBLK; ++blk) {
        const int m0 = s * SEGLEN + blk * BLK;
        auto srcfn = [&](int slot) -> SlotSrc { const int m = m0 + slot; SlotSrc r; r.cur = P + (size_t)m * PPITCH; r.prevb = m > 0 ? r.cur - PPITCH : nullptr; r.prevf = nullptr; return r; };
        int tidv = tid; asm volatile("" : "+v"(tidv));
        prep_block<true, false, 64, true, true, true, false>(a, lds, h, srcfn, tidv, R, a.ws + WS_TL + ((size_t)h * (TP / BLK) + (m0 >> 6)) * TL_REC, LF);
        if (blk + 1 < NBLK) { const int m1 = m0 + BLK; auto src1 = [&](int slot) -> SlotSrc { const int m = m1 + slot; SlotSrc r; r.cur = P + (size_t)m * PPITCH; r.prevb = r.cur - PPITCH; r.prevf = nullptr; return r; };
            prep_issue<true>(h, src1, tidv, R); }
        { bf16* up = (bf16*)a.out + ((size_t)h * TP + m0) * 128;
          if (is_state) l1_steps<true, 64>(lds, S, cg, rp, up); else l1_steps<false, 64>(lds, S, cg, rp, up); }
        __syncthreads();
    }
    float* seg = (float*)(a.ws + WS_SEG) + ((size_t)(s * NH + h) * 2) * 4096;
#pragma unroll
    for (int r = 0; r < 2; ++r) { const int row = 2 * rp + r; *(f32x4*)(seg + (size_t)row * 64 + 8 * cg) = (f32x4){S[r][0].x, S[r][0].y, S[r][1].x, S[r][1].y}; *(f32x4*)(seg + (size_t)row * 64 + 8 * cg + 4) = (f32x4){S[r][2].x, S[r][2].y, S[r][3].x, S[r][3].y}; }
}

__device__ __forceinline__ bf16x8 frag_row(LAS unsigned char* tile, int row, int col0) {
    const f32x4 x = *(LAS f32x4*)(tile + row * 256 + col0 * 4), y = *(LAS f32x4*)(tile + row * 256 + col0 * 4 + 16);
    union { bf16x8 v; unsigned u[4]; } f; f.u[0] = pg8::cvt_pk_bf16(x.x, x.y); f.u[1] = pg8::cvt_pk_bf16(x.z, x.w); f.u[2] = pg8::cvt_pk_bf16(y.x, y.y); f.u[3] = pg8::cvt_pk_bf16(y.z, y.w); return f.v;
}
__device__ __forceinline__ void frag_row_hilo(LAS unsigned char* tile, int row, int col0, bf16x8& hi, bf16x8& lo) {
    const f32x4 x = *(LAS f32x4*)(tile + row * 256 + col0 * 4), y = *(LAS f32x4*)(tile + row * 256 + col0 * 4 + 16);
    const float v[8] = {x.x, x.y, x.z, x.w, y.x, y.y, y.z, y.w};
    union { bf16x8 v; unsigned u[4]; } fh, fl;
#pragma unroll
    for (int q = 0; q < 4; ++q) { const unsigned uh = pg8::cvt_pk_bf16(v[2 * q], v[2 * q + 1]); fh.u[q] = uh; fl.u[q] = pg8::cvt_pk_bf16(v[2 * q] - bflo(uh), v[2 * q + 1] - bfhi(uh)); }
    hi = fh.v; lo = fl.v;
}
__device__ __forceinline__ bf16x8 frag_col2(LAS unsigned char* tile, int ra, int rb, int c) {
    float v[8];
#pragma unroll
    for (int q = 0; q < 4; ++q) { v[q] = *(LAS float*)(tile + (ra + q) * 256 + c * 4); v[4 + q] = *(LAS float*)(tile + (rb + q) * 256 + c * 4); }
    union { bf16x8 v; unsigned u[4]; } f;
#pragma unroll
    for (int q = 0; q < 4; ++q) f.u[q] = pg8::cvt_pk_bf16(v[2 * q], v[2 * q + 1]);
    return f.v;
}
constexpr int M_PB = 144;
constexpr int M_RB = 0, M_BB = 9216, M_KB = 18432, M_VB = 27648, M_GB = 36864, M_ULOC = 49152, M_PSEQ = 58368, M_UT = 67584, M_VT = 76800, M_BT = 86016, M_KT = 95232, M_OUT = 104448, M_SST = M_OUT, M_S0 = 120832, M_BONUS = 129024, M_GL = 129280, M_S0F = 130048;
typedef short s16x4_ __attribute__((ext_vector_type(4)));
__device__ __forceinline__ bf16x8 fragt2(LAS unsigned char* tile, int row, int ca, int cb) {
    union { bf16x8 v; s16x4_ h[2]; } f; f.h[0] = *(LAS s16x4_*)(tile + row * M_PB + ca * 2); f.h[1] = *(LAS s16x4_*)(tile + row * M_PB + cb * 2); return f.v;
}
__device__ __forceinline__ bf16x8 fragb(LAS unsigned char* tile, int row, int col0) { return *(LAS bf16x8*)(tile + row * M_PB + col0 * 2); }
__device__ __forceinline__ bf16x8 fragt2s(LAS unsigned char* tile, int row, int ca, int cb) { const int sw = 8 * (row >> 3); return fragt2(tile, row, (ca + sw) & 63, (cb + sw) & 63); }
__device__ __forceinline__ bf16x8 fragbs(LAS unsigned char* tile, int row, int col0) { return fragb(tile, row, (col0 + 8 * (row >> 3)) & 63); }
__device__ __forceinline__ bf16x8 fragb_col2(LAS unsigned char* tile, int ra, int rb, int c) {
    unsigned v[8];
#pragma unroll
    for (int q = 0; q < 4; ++q) { v[q] = *(LAS unsigned short*)(tile + (ra + q) * M_PB + c * 2); v[4 + q] = *(LAS unsigned short*)(tile + (rb + q) * M_PB + c * 2); }
    union { bf16x8 v; unsigned u[4]; } f;
#pragma unroll
    for (int q = 0; q < 4; ++q) f.u[q] = v[2 * q] | (v[2 * q + 1] << 16);
    return f.v;
}
__device__ __forceinline__ bf16x8 l1m_half(LAS unsigned char* p) { union { bf16x8 v; s16x4_ h[2]; } f; f.h[0] = *(LAS s16x4_*)p; f.h[1] = (s16x4_){0, 0, 0, 0}; return f.v; }
__device__ __forceinline__ bf16x8 l1m_pack2(const f32x4 x, const f32x4 y) { union { bf16x8 v; unsigned u[4]; } f; f.u[0] = pg8::cvt_pk_bf16(x[0], x[1]); f.u[1] = pg8::cvt_pk_bf16(x[2], x[3]); f.u[2] = pg8::cvt_pk_bf16(y[0], y[1]); f.u[3] = pg8::cvt_pk_bf16(y[2], y[3]); return f.v; }
__device__ __forceinline__ bf16x8 l1m_pack1(const f32x4 x) { union { bf16x8 v; unsigned u[4]; } f; f.u[0] = pg8::cvt_pk_bf16(x[0], x[1]); f.u[1] = pg8::cvt_pk_bf16(x[2], x[3]); f.u[2] = 0u; f.u[3] = 0u; return f.v; }
__device__ __forceinline__ void l1m_hilo2(const f32x4 x, const f32x4 y, bf16x8& hi, bf16x8& lo) {
    union { bf16x8 v; unsigned u[4]; } fh, fl;
    fh.u[0] = pg8::cvt_pk_bf16(x[0], x[1]); fh.u[1] = pg8::cvt_pk_bf16(x[2], x[3]); fh.u[2] = pg8::cvt_pk_bf16(y[0], y[1]); fh.u[3] = pg8::cvt_pk_bf16(y[2], y[3]);
    fl.u[0] = pg8::cvt_pk_bf16(x[0] - bflo(fh.u[0]), x[1] - bfhi(fh.u[0])); fl.u[1] = pg8::cvt_pk_bf16(x[2] - bflo(fh.u[1]), x[3] - bfhi(fh.u[1]));
    fl.u[2] = pg8::cvt_pk_bf16(y[0] - bflo(fh.u[2]), y[1] - bfhi(fh.u[2])); fl.u[3] = pg8::cvt_pk_bf16(y[2] - bflo(fh.u[3]), y[3] - bfhi(fh.u[3]));
    hi = fh.v; lo = fl.v;
}
__device__ __forceinline__ void l1m_store_c(LAS unsigned char* tile, int pitch, int r0, int col, int fq, const f32x4 v) {
    const unsigned w0 = pg8::cvt_pk_bf16(v[0], v[1]), w1 = pg8::cvt_pk_bf16(v[2], v[3]);
    LAS unsigned short* p = (LAS unsigned short*)(tile + (r0 + 4 * fq) * pitch + col * 2);
    p[0] = (unsigned short)(w0 & 0xffff); p[pitch / 2] = (unsigned short)(w0 >> 16); p[pitch] = (unsigned short)(w1 & 0xffff); p[3 * (pitch / 2)] = (unsigned short)(w1 >> 16);
}
template <int R> struct DinvRows {
    static __device__ __forceinline__ void run(const float (&nrow)[16], float (&x)[16], int c) {
        DinvRows<R - 1>::run(nrow, x, c);
        float acc4[4] = {(R == c) ? 1.f : 0.f, 0.f, 0.f, 0.f};
#pragma unroll
        for (int sc = 0; sc < R; ++sc)
            asm volatile("v_fmac_f32_dpp %0, %1, %2 row_newbcast:%3 row_mask:0xf bank_mask:0xf" : "+v"(acc4[sc & 3]) : "v"(nrow[sc]), "v"(x[sc]), "n"(R));
        x[R] = (acc4[0] + acc4[1]) + (acc4[2] + acc4[3]);
    }
};
template <> struct DinvRows<-1> { static __device__ __forceinline__ void run(const float (&)[16], float (&)[16], int) {} };
#define L1M_TR(dst, base, off) asm volatile("ds_read_b64_tr_b16 %0, %1 offset:%2" : "=&v"(dst) : "v"(base), "i"(off) : "memory")
#define L1M_TRWAIT() do { asm volatile("s_waitcnt lgkmcnt(0)" ::: "memory"); __builtin_amdgcn_sched_barrier(0); } while (0)
__device__ __forceinline__ bf16x8 l1m_join(const s16x4_ lo, const s16x4_ hi) { return (bf16x8){lo[0], lo[1], lo[2], lo[3], hi[0], hi[1], hi[2], hi[3]}; }
#define L1M_MFMA(A, B, C) __builtin_amdgcn_mfma_f32_16x16x32_bf16((A), (B), (C), 0, 0, 0)
__device__ __forceinline__ void l1m_block(LAS unsigned char* lds, int tid, f32x4 (&ST)[4], bf16* up, unsigned char* rec) {
    const int lane = tid & 63, wave = __builtin_amdgcn_readfirstlane(tid >> 6), fr = lane & 15, fq = lane >> 4;
    const int ct = wave & 3; const bool sideC = wave >= 4;
    const f32x4 zero4 = {0.f, 0.f, 0.f, 0.f};
    const unsigned trb4 = (unsigned)(size_t)lds + (4 * fq + (fr >> 2)) * 144 + (fr & 3) * 8, trb8 = (unsigned)(size_t)lds + (8 * fq + (fr >> 2)) * 144 + (fr & 3) * 8;
    {
        bf16x8 af[2], rf[2];
#pragma unroll
        for (int ks = 0; ks < 2; ++ks) { af[ks] = fragb(lds + L_ABF, 16 * ct + fr, 32 * ks + 8 * fq); rf[ks] = fragb(lds + L_RBF, 16 * ct + fr, 32 * ks + 8 * fq); }
        LAS unsigned char* bsrc = lds + (sideC ? L_KBF : L_BBF); LAS unsigned char* dstn = lds + (sideC ? L_ML : L_NL); LAS unsigned char* dstr = lds + (sideC ? L_RK : L_RB);
#pragma unroll
        for (int st = 0; st < 4; ++st) {
            if (st > ct) {
                if (st == ct + 1 && !(ct & 1)) { if (sideC) l1m_store_c(dstn, 144, 16 * ct, 16 * st + fr, fq, zero4); l1m_store_c(dstr, 144, 16 * ct, 16 * st + fr, fq, zero4); }
                continue;
            }
            f32x4 accn = zero4, accr = zero4;
#pragma unroll
            for (int ks = 0; ks < 2; ++ks) { const bf16x8 bf = fragb(bsrc, 16 * st + fr, 32 * ks + 8 * fq); accn = L1M_MFMA(af[ks], bf, accn); accr = L1M_MFMA(rf[ks], bf, accr); }
            if (st == ct) {
#pragma unroll
                for (int rg = 0; rg < 4; ++rg) { const int tl = 4 * fq + rg; accn[rg] = (fr < tl) ? accn[rg] : 0.f; accr[rg] = (fr <= tl) ? accr[rg] : 0.f;
                    if (!sideC) *(LAS float*)(lds + L_ND + ((16 * ct + tl) * 16 + fr) * 4) = accn[rg]; }
            }
            l1m_store_c(dstn, 144, 16 * ct, 16 * st + fr, fq, accn); l1m_store_c(dstr, 144, 16 * ct, 16 * st + fr, fq, accr);
        }
    }
    __syncthreads();
    if (wave == 0) {
        const int k = lane >> 4, c = lane & 15;
        float nrow[16], x[16];
#pragma unroll
        for (int q = 0; q < 4; ++q) { const f32x4 n = *(LAS f32x4*)(lds + L_ND + ((16 * k + c) * 16 + 4 * q) * 4); nrow[4 * q] = n[0]; nrow[4 * q + 1] = n[1]; nrow[4 * q + 2] = n[2]; nrow[4 * q + 3] = n[3]; }
        DinvRows<15>::run(nrow, x, c);
#pragma unroll
        for (int r = 0; r < 16; ++r) *(LAS unsigned short*)(lds + L_DINV + ((16 * k + r) * 16 + c) * 2) = (unsigned short)f2bf(x[r]);
    }
    f32x4 X[4];
    bf16x8 v01, v23;
    f32x4 Sc[4];
    if (!sideC) {
#pragma unroll
        for (int k = 0; k < 4; ++k)
#pragma unroll
            for (int rg = 0; rg < 4; ++rg) X[k][rg] = bf2f(*(LAS unsigned short*)(lds + L_ABF + (16 * k + 4 * fq + rg) * 144 + (16 * ct + fr) * 2));
    } else {
        s16x4_ tv[4], tp[4], tk[4][4];
        const unsigned tv8 = trb8 + 32 * ct, tv4 = trb4 + 32 * ct;
        L1M_TR(tv[0], tv8, L_VBF); L1M_TR(tv[1], tv8, L_VBF + 4 * 144); L1M_TR(tv[2], tv8, L_VBF + 32 * 144); L1M_TR(tv[3], tv8, L_VBF + 36 * 144);
#pragma unroll
        for (int blk = 0; blk < 4; ++blk) L1M_TR(tp[blk], tv4, L_VBF + 16 * blk * 144);
#pragma unroll
        for (int jt = 0; jt < 4; ++jt)
#pragma unroll
            for (int blk = 0; blk < 4; ++blk) L1M_TR(tk[jt][blk], trb4, L_KBF + 32 * jt + 16 * blk * 144);
        L1M_TRWAIT();
        const bf16x8 bv[2] = {l1m_join(tv[0], tv[1]), l1m_join(tv[2], tv[3])};
#pragma unroll
        for (int k = 0; k < 4; ++k) { f32x4 acc = zero4;
#pragma unroll
            for (int ks = 0; ks < 2; ++ks) if (32 * ks <= 16 * k + 15) acc = L1M_MFMA(fragb(lds + L_ML, 16 * k + fr, 32 * ks + 8 * fq), bv[ks], acc);
            X[k] = acc; }
        v01 = l1m_join(tp[0], tp[1]); v23 = l1m_join(tp[2], tp[3]);
#pragma unroll
        for (int jt = 0; jt < 4; ++jt) { f32x4 acc = zero4;
            acc = L1M_MFMA(l1m_join(tk[jt][0], tk[jt][1]), v01, acc); acc = L1M_MFMA(l1m_join(tk[jt][2], tk[jt][3]), v23, acc);
            Sc[jt] = acc; }
    }
    __syncthreads();
    X[0] = L1M_MFMA(l1m_half(lds + L_DINV + ((0 + fr) * 16 + 4 * fq) * 2), l1m_pack1(X[0]), zero4);
    X[1] = L1M_MFMA(l1m_half(lds + L_NL + (16 + fr) * 144 + (4 * fq) * 2), l1m_pack1(X[0]), X[1]);
    X[1] = L1M_MFMA(l1m_half(lds + L_DINV + ((16 + fr) * 16 + 4 * fq) * 2), l1m_pack1(X[1]), zero4);
    const bf16x8 b01 = l1m_pack2(X[0], X[1]);
    X[2] = L1M_MFMA(fragt2(lds + L_NL, 32 + fr, 4 * fq, 16 + 4 * fq), b01, X[2]);
    X[2] = L1M_MFMA(l1m_half(lds + L_DINV + ((32 + fr) * 16 + 4 * fq) * 2), l1m_pack1(X[2]), zero4);
    X[3] = L1M_MFMA(fragt2(lds + L_NL, 48 + fr, 4 * fq, 16 + 4 * fq), b01, X[3]);
    X[3] = L1M_MFMA(l1m_half(lds + L_NL + (48 + fr) * 144 + (32 + 4 * fq) * 2), l1m_pack1(X[2]), X[3]);
    X[3] = L1M_MFMA(l1m_half(lds + L_DINV + ((48 + fr) * 16 + 4 * fq) * 2), l1m_pack1(X[3]), zero4);
    const bf16x8 b23 = l1m_pack2(X[2], X[3]);
#pragma unroll
    for (int tt = 0; tt < 4; ++tt) {
        f32x4 acc = zero4;
        if (!sideC) {
#pragma unroll
            for (int rg = 0; rg < 4; ++rg) acc[rg] = bf2f(*(LAS unsigned short*)(lds + L_RBF + (16 * tt + 4 * fq + rg) * 144 + (16 * ct + fr) * 2)); }
        acc = L1M_MFMA(fragt2(lds + L_RB, 16 * tt + fr, 4 * fq, 16 + 4 * fq), b01, acc);
        if (tt >= 2) acc = L1M_MFMA(fragt2(lds + L_RB, 16 * tt + fr, 32 + 4 * fq, 48 + 4 * fq), b23, acc);
        if (sideC) { acc = L1M_MFMA(fragt2(lds + L_RK, 16 * tt + fr, 4 * fq, 16 + 4 * fq), v01, acc);
            if (tt >= 2) acc = L1M_MFMA(fragt2(lds + L_RK, 16 * tt + fr, 32 + 4 * fq, 48 + 4 * fq), v23, acc); }
        l1m_store_c(lds + (sideC ? L_XO : L_XR), 144, 16 * tt, 16 * ct + fr, fq, acc);
    }
    s16x4_ tb[4][4];
#pragma unroll
    for (int jt = 0; jt < 4; ++jt)
#pragma unroll
        for (int blk = 0; blk < 4; ++blk) L1M_TR(tb[jt][blk], trb4, L_BBF + 32 * jt + 16 * blk * 144);
    L1M_TRWAIT();
#pragma unroll
    for (int jt = 0; jt < 4; ++jt) {
        f32x4 acc = sideC ? Sc[jt] : zero4;
        acc = L1M_MFMA(l1m_join(tb[jt][0], tb[jt][1]), b01, acc);
        acc = L1M_MFMA(l1m_join(tb[jt][2], tb[jt][3]), b23, acc);
        if (!sideC && jt == ct) {
#pragma unroll
            for (int rg = 0; rg < 4; ++rg) acc[rg] += (4 * fq + rg == fr) ? 1.f : 0.f; }
        const f32x4 gl = *(LAS f32x4*)(lds + T_GL + (16 * jt + 4 * fq) * 4);
        acc *= gl;
        Sc[jt] = acc;
        if (!sideC) l1m_store_c(lds + L_PCT, 144, 16 * jt, 16 * ct + fr, fq, acc);
        else *(f32x4*)(rec + 8192 + ((16 * ct + fr) * 64 + 16 * jt + 4 * fq) * 4) = acc;
    }
    __syncthreads();
    {
        bf16x8 sh[2], sl[2];
        l1m_hilo2(ST[0], ST[1], sh[0], sl[0]); l1m_hilo2(ST[2], ST[3], sh[1], sl[1]);
#pragma unroll
        for (int jt = 0; jt < 4; ++jt) {
            f32x4 acc = sideC ? Sc[jt] : zero4;
#pragma unroll
            for (int s2 = 0; s2 < 2; ++s2) { const bf16x8 ap = fragt2(lds + L_PCT, 16 * jt + fr, 32 * s2 + 4 * fq, 32 * s2 + 16 + 4 * fq);
                acc = L1M_MFMA(ap, sh[s2], acc); acc = L1M_MFMA(ap, sl[s2], acc); }
            Sc[jt] = acc;
        }
#pragma unroll
        for (int jt = 0; jt < 4; ++jt) ST[jt] = Sc[jt];
    }
#pragma unroll
    for (int i = 0; i < 2; ++i) { const int e = tid + 512 * i, row = e >> 4, c16 = e & 15; *(v4u*)(up + (size_t)row * 128 + c16 * 8) = *(LAS v4u*)(lds + (c16 < 8 ? L_XO : L_XR) + row * 144 + (c16 & 7) * 16); }
    { const int row = tid >> 3, c16 = tid & 7; *(v4u*)(rec + row * 128 + c16 * 16) = *(LAS v4u*)(lds + L_PCT + row * 144 + c16 * 16); }
}
__device__ __forceinline__ void l1m_unit(const Args& a, LAS unsigned char* lds, int h, int s, int tid) {
    const bf16* P = (const bf16*)(a.ws + WS_P);
    const int lane = tid & 63, wave = __builtin_amdgcn_readfirstlane(tid >> 6), fr0 = lane & 15, fq0 = lane >> 4;
    f32x4 ST[4];
#pragma unroll
    for (int jt = 0; jt < 4; ++jt)
#pragma unroll
        for (int rg = 0; rg < 4; ++rg) ST[jt][rg] = (wave < 4 && jt == (wave & 3) && 4 * fq0 + rg == fr0) ? 1.f : 0.f;
    PrepRegs R; LoraFrags LF; lora_frags_load<true>(a, h, tid, LF);
    prep_consts_fill(a, lds, h, tid);
    __syncthreads();
    { const int mb = s * SEGLEN; auto src0 = [&](int slot) -> SlotSrc { const int m = mb + slot; SlotSrc r; r.cur = P + (size_t)m * PPITCH; r.prevb = m > 0 ? r.cur - PPITCH : nullptr; r.prevf = nullptr; return r; };
      prep_issue<true>(h, src0, tid, R); }
    for (int blk = 0; blk < NBLK; ++blk) {
        const int m0 = s * SEGLEN + blk * BLK;
        auto srcfn = [&](int slot) -> SlotSrc { const int m = m0 + slot; SlotSrc r; r.cur = P + (size_t)m * PPITCH; r.prevb = m > 0 ? r.cur - PPITCH : nullptr; r.prevf = nullptr; return r; };
        int tidv = tid; asm volatile("" : "+v"(tidv));
        prep_block<true, false, 64, true, true, true, true>(a, lds, h, srcfn, tidv, R, a.ws + WS_TL + ((size_t)h * (TP / BLK) + (m0 >> 6)) * TL_REC, LF);
        if (blk + 1 < NBLK) { const int m1 = m0 + BLK; auto src1 = [&](int slot) -> SlotSrc { const int m = m1 + slot; SlotSrc r; r.cur = P + (size_t)m * PPITCH; r.prevb = r.cur - PPITCH; r.prevf = nullptr; return r; };
            prep_issue<true>(h, src1, tidv, R); }
        l1m_block(lds, tidv, ST, (bf16*)a.out + ((size_t)h * TP + m0) * 128, a.ws + WS_TL + ((size_t)h * (TP / BLK) + (m0 >> 6)) * TL_REC);
    }
    __syncthreads();
    float* seg = (float*)(a.ws + WS_SEG) + ((size_t)(s * NH + h) * 2) * 4096;
#pragma unroll
    for (int jt = 0; jt < 4; ++jt) {
        if (wave >= 4) *(f32x4*)(seg + (size_t)(16 * (wave & 3) + fr0) * 64 + 16 * jt + 4 * fq0) = ST[jt];
        else {
            pg8::u32x2 wh, wl; wh.x = pg8::cvt_pk_bf16(ST[jt][0], ST[jt][1]); wh.y = pg8::cvt_pk_bf16(ST[jt][2], ST[jt][3]);
            wl.x = pg8::cvt_pk_bf16(ST[jt][0] - bflo(wh.x), ST[jt][1] - bfhi(wh.x)); wl.y = pg8::cvt_pk_bf16(ST[jt][2] - bflo(wh.y), ST[jt][3] - bfhi(wh.y));
            unsigned char* pmt = (unsigned char*)(seg + 4096) + ((16 * (wave & 3) + fr0) * 64 + 16 * jt + 4 * fq0) * 2;
            *(pg8::u32x2*)pmt = wh; *(pg8::u32x2*)(pmt + 8192) = wl; }
    }
}
struct L3Pre { v4u tl[5]; v4u up[2]; float bon, gl; };
__device__ __forceinline__ void l3m_issue(const Args& a, int h, int m0, int tid, L3Pre& R) {
    const unsigned char* rec = a.ws + WS_TL + ((size_t)h * (TP / BLK) + (m0 >> 6)) * TL_REC;
    const int go = (tid >> 3) * 128 + (tid & 7) * 16;
#pragma unroll
    for (int q = 0; q < 5; ++q) R.tl[q] = *(const v4u*)(rec + 8192 * q + go);
    const bf16* up = (const bf16*)a.out + ((size_t)h * TP + m0) * 128;
#pragma unroll
    for (int i = 0; i < 2; ++i) R.up[i] = *(const v4u*)(up + 8 * (tid + 512 * i));
    R.bon = 0.f; R.gl = 0.f;
    if (tid < 64) { R.bon = *(const float*)(rec + 40960 + tid * 4); R.gl = *(const float*)(rec + 41216 + tid * 4); }
}
__device__ __forceinline__ void l3m_unit(const Args& a, LAS unsigned char* lds, int h, int s, int tid) {
    const int lane = tid & 63, wave = __builtin_amdgcn_readfirstlane(tid >> 6), fr0 = lane & 15, fq0 = lane >> 4;
    const int cg = tid & 15, rg = tid >> 4;
    L3Pre R; l3m_issue(a, h, s * SEGLEN, tid, R);
    f32x4 S[2] = {{0.f, 0.f, 0.f, 0.f}, {0.f, 0.f, 0.f, 0.f}};
    const float* segb = (const float*)(a.ws + WS_SEG);
    for (int sp = 0; sp < s; ++sp) {
        const float* sl = segb + ((size_t)(sp * NH + h) * 2) * 4096; const float* pm = sl + 4096;
        f32x4 acc[2];
#pragma unroll
        for (int r = 0; r < 2; ++r) acc[r] = *(const f32x4*)(sl + (size_t)(2 * rg + r) * 64 + 4 * cg);
        if (sp > 0) {
#pragma unroll
            for (int r = 0; r < 2; ++r) *(LAS f32x4*)(lds + SL_OFF + ((2 * rg + r) * SLP + 4 * cg) * 4) = S[r];
#pragma unroll
            for (int i = 0; i < 2; ++i) { const int e = (tid + 512 * i) * 4; *(LAS f32x4*)(lds + PM_OFF + e * 4) = *(const f32x4*)(pm + e); }
            __syncthreads();
#pragma unroll 4
            for (int l4 = 0; l4 < 16; ++l4) {
                const f32x4 s0 = *(LAS f32x4*)(lds + SL_OFF + ((2 * rg) * SLP + 4 * l4) * 4), s1 = *(LAS f32x4*)(lds + SL_OFF + ((2 * rg + 1) * SLP + 4 * l4) * 4);
#pragma unroll
                for (int j = 0; j < 4; ++j) { const f32x4 p = *(LAS f32x4*)(lds + PM_OFF + ((4 * l4 + j) * 64 + 4 * cg) * 4); acc[0] += p * s0[j]; acc[1] += p * s1[j]; }
            }
            __syncthreads();
        }
        S[0] = acc[0]; S[1] = acc[1];
    }
#pragma unroll
    for (int r = 0; r < 2; ++r) {
        *(LAS f32x4*)(lds + M_SST + ((2 * rg + r) * 64 + 4 * cg) * 4) = S[r];
        *(LAS f32x4*)(lds + M_S0F + ((2 * rg + r) * 64 + 4 * cg) * 4) = S[r];
        pg8::u32x2 w; w.x = pg8::cvt_pk_bf16(S[r].x, S[r].y); w.y = pg8::cvt_pk_bf16(S[r].z, S[r].w);
        *(LAS pg8::u32x2*)(lds + M_S0 + ((2 * rg + r) * 64 + 4 * cg) * 2) = w;
    }
    __syncthreads();
    const int ita = wave & 3, tpa = wave >> 2;
    const int tt = wave >> 1, ih = wave & 1;
    f32x4 Sacc[2];
#pragma unroll
    for (int x = 0; x < 2; ++x)
#pragma unroll
        for (int rg4 = 0; rg4 < 4; ++rg4) Sacc[x][rg4] = *(LAS float*)(lds + M_SST + ((16 * tt + 4 * fq0 + rg4) * 64 + 16 * (2 * ih + x) + fr0) * 4);
    __syncthreads();
    for (int blk = 0; blk < NBLK; ++blk) {
        const int m0 = s * SEGLEN + blk * BLK;
        int fr = fr0, fq = fq0; asm volatile("" : "+v"(fr), "+v"(fq));
        {
            const int slot = tid >> 3, part = tid & 7;
#pragma unroll
            for (int q = 0; q < 5; ++q) *(LAS v4u*)(lds + 9216 * q + slot * M_PB + part * 16) = R.tl[q];
#pragma unroll
            for (int q = 1; q < 4; ++q) {
                LAS unsigned short* tp = (LAS unsigned short*)(lds + (q == 1 ? M_BT : q == 2 ? M_KT : M_VT) + (8 * part) * M_PB + ((slot + 8 * part) & 63) * 2);
                const v4u w = R.tl[q];
                tp[0 * (M_PB / 2)] = (unsigned short)(w.x & 0xffff); tp[1 * (M_PB / 2)] = (unsigned short)(w.x >> 16);
                tp[2 * (M_PB / 2)] = (unsigned short)(w.y & 0xffff); tp[3 * (M_PB / 2)] = (unsigned short)(w.y >> 16);
                tp[4 * (M_PB / 2)] = (unsigned short)(w.z & 0xffff); tp[5 * (M_PB / 2)] = (unsigned short)(w.z >> 16);
                tp[6 * (M_PB / 2)] = (unsigned short)(w.w & 0xffff); tp[7 * (M_PB / 2)] = (unsigned short)(w.w >> 16);
            }
#pragma unroll
            for (int i = 0; i < 2; ++i) { const int e = tid + 512 * i, sl2 = e >> 4, c = e & 15; *(LAS v4u*)(lds + (c < 8 ? M_ULOC : M_PSEQ) + sl2 * M_PB + (c & 7) * 16) = R.up[i]; }
            if (tid < 64) { *(LAS float*)(lds + M_BONUS + tid * 4) = R.bon; *(LAS float*)(lds + M_GL + tid * 4) = R.gl; }
        }
        __syncthreads();
        if (blk + 1 < NBLK) l3m_issue(a, h, m0 + BLK, tid, R);
        bf16x8 sbh[2], sbl[2];
#pragma unroll
        for (int ks = 0; ks < 2; ++ks) frag_row_hilo(lds + M_S0F, 16 * ita + fr, 32 * ks + 8 * fq, sbh[ks], sbl[ks]);
#pragma unroll
        for (int x = 0; x < 2; ++x) {
            const int ta = 2 * tpa + x;
            f32x4 acc;
#pragma unroll
            for (int rg4 = 0; rg4 < 4; ++rg4) acc[rg4] = bf2f(*(LAS unsigned short*)(lds + M_ULOC + (16 * ta + 4 * fq + rg4) * M_PB + (16 * ita + fr) * 2));
#pragma unroll
            for (int ks = 0; ks < 2; ++ks) {
                const bf16x8 ap = fragb(lds + M_PSEQ, 16 * ta + fr, 32 * ks + 8 * fq);
                acc = __builtin_amdgcn_mfma_f32_16x16x32_bf16(ap, sbh[ks], acc, 0, 0, 0);
                acc = __builtin_amdgcn_mfma_f32_16x16x32_bf16(ap, sbl[ks], acc, 0, 0, 0);
            }
            { pg8::u32x2 w; w.x = pk2(acc[0], acc[1]); w.y = pk2(acc[2], acc[3]); *(LAS pg8::u32x2*)(lds + M_UT + (16 * ita + fr) * M_PB + (16 * ta + 4 * fq) * 2) = w; }
        }
        __syncthreads();
        bf16x8 rbf[2];
#pragma unroll
        for (int ks = 0; ks < 2; ++ks) rbf[ks] = fragb(lds + M_RB, 16 * tt + fr, 32 * ks + 8 * fq);
        float pb[4][4], pk[4][4];
#pragma unroll
        for (int st = 0; st < 4; ++st) {
            f32x4 accb = {0.f, 0.f, 0.f, 0.f}, acck = {0.f, 0.f, 0.f, 0.f};
            if (st <= tt) {
#pragma unroll
                for (int ks = 0; ks < 2; ++ks) {
                    accb = __builtin_amdgcn_mfma_f32_16x16x32_bf16(fragb(lds + M_BB, 16 * st + fr, 32 * ks + 8 * fq), rbf[ks], accb, 0, 0, 0);
                    acck = __builtin_amdgcn_mfma_f32_16x16x32_bf16(fragb(lds + M_KB, 16 * st + fr, 32 * ks + 8 * fq), rbf[ks], acck, 0, 0, 0);
                }
            }
#pragma unroll
            for (int rg4 = 0; rg4 < 4; ++rg4) { const bool ok = (16 * st + 4 * fq + rg4) <= (16 * tt + fr); pb[st][rg4] = ok ? accb[rg4] : 0.f; pk[st][rg4] = ok ? acck[rg4] : 0.f; }
        }
#pragma unroll
        for (int x = 0; x < 2; ++x) {
            const int it = 2 * ih + x;
            f32x4 acc = {0.f, 0.f, 0.f, 0.f};
#pragma unroll
            for (int p2 = 0; p2 < 2; ++p2) {
                if (2 * p2 <= tt) {
                    union { bf16x8 v; unsigned u[4]; } afb, afk;
                    afb.u[0] = pg8::cvt_pk_bf16(pb[2 * p2][0], pb[2 * p2][1]); afb.u[1] = pg8::cvt_pk_bf16(pb[2 * p2][2], pb[2 * p2][3]); afb.u[2] = pg8::cvt_pk_bf16(pb[2 * p2 + 1][0], pb[2 * p2 + 1][1]); afb.u[3] = pg8::cvt_pk_bf16(pb[2 * p2 + 1][2], pb[2 * p2 + 1][3]);
                    afk.u[0] = pg8::cvt_pk_bf16(pk[2 * p2][0], pk[2 * p2][1]); afk.u[1] = pg8::cvt_pk_bf16(pk[2 * p2][2], pk[2 * p2][3]); afk.u[2] = pg8::cvt_pk_bf16(pk[2 * p2 + 1][0], pk[2 * p2 + 1][1]); afk.u[3] = pg8::cvt_pk_bf16(pk[2 * p2 + 1][2], pk[2 * p2 + 1][3]);
                    acc = __builtin_amdgcn_mfma_f32_16x16x32_bf16(afb.v, fragt2(lds + M_UT, 16 * it + fr, 32 * p2 + 4 * fq, 32 * p2 + 16 + 4 * fq), acc, 0, 0, 0);
                    acc = __builtin_amdgcn_mfma_f32_16x16x32_bf16(afk.v, fragt2s(lds + M_VT, 16 * it + fr, 32 * p2 + 4 * fq, 32 * p2 + 16 + 4 * fq), acc, 0, 0, 0);
                }
            }
#pragma unroll
            for (int ks = 0; ks < 2; ++ks) acc = __builtin_amdgcn_mfma_f32_16x16x32_bf16(rbf[ks], *(LAS bf16x8*)(lds + M_S0 + ((16 * it + fr) * 64 + 32 * ks + 8 * fq) * 2), acc, 0, 0, 0);
#pragma unroll
            for (int rg4 = 0; rg4 < 4; ++rg4) *(LAS float*)(lds + M_OUT + (16 * tt + 4 * fq + rg4) * 256 + (16 * it + fr) * 4) = acc[rg4];
        }
        {
            bf16x8 au[2], av[2];
#pragma unroll
            for (int ks = 0; ks < 2; ++ks) { au[ks] = fragb(lds + M_UT, 16 * tt + fr, 32 * ks + 8 * fq); av[ks] = fragbs(lds + M_VT, 16 * tt + fr, 32 * ks + 8 * fq); }
#pragma unroll
            for (int x = 0; x < 2; ++x) { const int tj = 2 * ih + x;
#pragma unroll
                for (int ks = 0; ks < 2; ++ks) {
                    Sacc[x] = __builtin_amdgcn_mfma_f32_16x16x32_bf16(au[ks], fragbs(lds + M_BT, 16 * tj + fr, 32 * ks + 8 * fq), Sacc[x], 0, 0, 0);
                    Sacc[x] = __builtin_amdgcn_mfma_f32_16x16x32_bf16(av[ks], fragbs(lds + M_KT, 16 * tj + fr, 32 * ks + 8 * fq), Sacc[x], 0, 0, 0);
                }
            }
        }
        __syncthreads();
#pragma unroll
        for (int x = 0; x < 2; ++x) { const int tj = 2 * ih + x; const float gl = *(LAS float*)(lds + M_GL + (16 * tj + fr) * 4);
            Sacc[x] *= gl;
#pragma unroll
            for (int rg4 = 0; rg4 < 4; ++rg4) { *(LAS unsigned short*)(lds + M_S0 + ((16 * tt + 4 * fq + rg4) * 64 + 16 * tj + fr) * 2) = (unsigned short)f2bf(Sacc[x][rg4]);
                *(LAS float*)(lds + M_S0F + ((16 * tt + 4 * fq + rg4) * 64 + 16 * tj + fr) * 4) = Sacc[x][rg4]; }
        }
        {
            const int slot = tid >> 3, part = tid & 7, c8 = h * HD + part * 8;
            float o[8], v[8], g[8], lw[8], lb[8];
            ld8l(lds, M_OUT + slot * 256 + part * 32, o); ld8f(a.in[I_LNW] + c8, lw); ld8f(a.in[I_LNB] + c8, lb);
            { const v4u wv = *(LAS v4u*)(lds + M_VB + slot * M_PB + part * 16), wg = *(LAS v4u*)(lds + M_GB + slot * M_PB + part * 16);
              v[0] = bflo(wv.x); v[1] = bfhi(wv.x); v[2] = bflo(wv.y); v[3] = bfhi(wv.y); v[4] = bflo(wv.z); v[5] = bfhi(wv.z); v[6] = bflo(wv.w); v[7] = bfhi(wv.w);
              g[0] = bflo(wg.x); g[1] = bfhi(wg.x); g[2] = bflo(wg.y); g[3] = bfhi(wg.y); g[4] = bflo(wg.z); g[5] = bfhi(wg.z); g[6] = bflo(wg.w); g[7] = bfhi(wg.w); }
            float sm = 0.f;
#pragma unroll
            for (int j = 0; j < 8; ++j) sm += o[j];
            const float mean = allreduce8(sm) * (1.f / 64.f);
            float q = 0.f;
#pragma unroll
            for (int j = 0; j < 8; ++j) { o[j] -= mean; q += o[j] * o[j]; }
            const float rstd = 1.0f / sqrtf(allreduce8(q) * (1.f / 64.f) + GN_EPS);
            const float bonus = *(LAS float*)(lds + M_BONUS + slot * 4);
            v4u w; float res[8];
#pragma unroll
            for (int j = 0; j < 8; ++j) res[j] = (o[j] * rstd * lw[j] + lb[j] + bonus * v[j]) * g[j];
            w.x = pk2(res[0], res[1]); w.y = pk2(res[2], res[3]); w.z = pk2(res[4], res[5]); w.w = pk2(res[6], res[7]);
            *(v4u*)((bf16*)(a.ws + WS_MIX) + (size_t)(m0 + slot) * DM + c8) = w;
        }
        __syncthreads();
    }
    if (s == SEGS - 1) {
#pragma unroll
        for (int x = 0; x < 2; ++x)
#pragma unroll
            for (int rg4 = 0; rg4 < 4; ++rg4) a.out[O_PST + ((size_t)h * HD + 16 * tt + 4 * fq0 + rg4) * HD + 16 * (2 * ih + x) + fr0] = Sacc[x][rg4];
    }
}

constexpr int S_VB = 0, S_GB = 9216, S_OR = 18432, S_ORP = 272, S_PCT = 35840, S_BUF = 45056, S_OUT = 90112, S_S0F = 106496, S_S0B = 18432, S_BON = 143360, S_LN = 143872;
struct L3sPre { v4u pct, v, g, orr[2]; f32x4 sc[2]; float bon; };
__device__ __forceinline__ void l3s_issue(const Args& a, int h, int m0, int tid, L3sPre& R) {
    const unsigned char* rec = a.ws + WS_TL + ((size_t)h * (TP / BLK) + (m0 >> 6)) * TL_REC;
    const int go = (tid >> 3) * 128 + (tid & 7) * 16;
    R.pct = *(const v4u*)(rec + go); R.v = *(const v4u*)(rec + 24576 + go); R.g = *(const v4u*)(rec + 32768 + go);
    const bf16* up = (const bf16*)a.out + ((size_t)h * TP + m0) * 128;
#pragma unroll
    for (int i = 0; i < 2; ++i) R.orr[i] = *(const v4u*)(up + 8 * (tid + 512 * i));
    const int lane = tid & 63, wave = tid >> 6, fr = lane & 15, fq = lane >> 4, it = wave & 3, jh = wave >> 2;
#pragma unroll
    for (int x = 0; x < 2; ++x) R.sc[x] = *(const f32x4*)(rec + 8192 + ((16 * it + fr) * 64 + 16 * (2 * jh + x) + 4 * fq) * 4);
    R.bon = 0.f; if (tid < 64) R.bon = *(const float*)(rec + 40960 + tid * 4);
}
__device__ __forceinline__ void l3s_unit(const Args& a, LAS unsigned char* lds, int h, int s, int tid) {
    const int lane = tid & 63, wave = __builtin_amdgcn_readfirstlane(tid >> 6), fr0 = lane & 15, fq0 = lane >> 4;
    L3sPre R; l3s_issue(a, h, s * SEGLEN, tid, R);
    if (tid < 128) *(LAS float*)(lds + S_LN + tid * 4) = a.in[tid < 64 ? I_LNW : I_LNB][h * HD + (tid & 63)];
    const int itc = wave & 3, jh = wave >> 2;
    const float* segb = (const float*)(a.ws + WS_SEG);
    {
        const int e0 = tid * 4, e1 = (tid + 512) * 4;
        int cb = (s > 0 ? s - 1 : 0) & 1;
        {
            f32x4 v0 = {0.f, 0.f, 0.f, 0.f}, v1 = {0.f, 0.f, 0.f, 0.f};
            if (s > 0) { const float* sl = segb + ((size_t)(0 * NH + h) * 2) * 4096; v0 = *(const f32x4*)(sl + e0); v1 = *(const f32x4*)(sl + e1); }
#pragma unroll
            for (int i = 0; i < 2; ++i) { const f32x4 v = i ? v1 : v0; const int e = i ? e1 : e0, row = e >> 6, col = e & 63;
                pg8::u32x2 wh, wl; wh.x = pg8::cvt_pk_bf16(v[0], v[1]); wh.y = pg8::cvt_pk_bf16(v[2], v[3]);
                wl.x = pg8::cvt_pk_bf16(v[0] - bflo(wh.x), v[1] - bfhi(wh.x)); wl.y = pg8::cvt_pk_bf16(v[2] - bflo(wh.y), v[3] - bfhi(wh.y));
                *(LAS pg8::u32x2*)(lds + S_S0F + cb * S_S0B + row * M_PB + col * 2) = wh; *(LAS pg8::u32x2*)(lds + S_S0F + cb * S_S0B + 9216 + row * M_PB + col * 2) = wl; }
        }
        v4u pmh, pml; f32x4 sl2[2];
        const int prow = tid >> 3, ppc = tid & 7;
        auto chain_load = [&](int sp) { const float* sl = segb + ((size_t)(sp * NH + h) * 2) * 4096; const unsigned char* pmt = (const unsigned char*)(sl + 4096);
            pmh = *(const v4u*)(pmt + prow * 128 + ppc * 16); pml = *(const v4u*)(pmt + 8192 + prow * 128 + ppc * 16);
#pragma unroll
            for (int x = 0; x < 2; ++x) sl2[x] = *(const f32x4*)(sl + (size_t)(16 * itc + fr0) * 64 + 16 * (2 * jh + x) + 4 * fq0); };
        if (s > 1) chain_load(1);
        const unsigned trl = (unsigned)(size_t)lds + (8 * fq0 + (fr0 >> 2)) * M_PB + (fr0 & 3) * 8 + 32 * (2 * jh);
        for (int sp = 1; sp < s; ++sp) {
            LAS unsigned char* pmb = lds + (sp & 1) * 18432;
            *(LAS v4u*)(pmb + prow * M_PB + ppc * 16) = pmh; *(LAS v4u*)(pmb + 9216 + prow * M_PB + ppc * 16) = pml;
            f32x4 acc[2] = {sl2[0], sl2[1]};
            __syncthreads();
            if (sp + 1 < s) chain_load(sp + 1);
            LAS unsigned char* s0c = lds + S_S0F + cb * S_S0B; LAS unsigned char* s0n = lds + S_S0F + (cb ^ 1) * S_S0B;
            bf16x8 bh[2], bl[2];
#pragma unroll
            for (int ks = 0; ks < 2; ++ks) { bh[ks] = fragb(s0c, 16 * itc + fr0, 32 * ks + 8 * fq0); bl[ks] = fragb(s0c + 9216, 16 * itc + fr0, 32 * ks + 8 * fq0); }
            const unsigned trb = trl + (sp & 1) * 18432;
            s16x4_ th[2][2][2], tlo[2][2][2];
#pragma unroll
            for (int x = 0; x < 2; ++x)
#pragma unroll
                for (int ks = 0; ks < 2; ++ks)
#pragma unroll
                    for (int hf = 0; hf < 2; ++hf) { L1M_TR(th[x][ks][hf], trb, (32 * ks + 4 * hf) * 144 + 32 * x); L1M_TR(tlo[x][ks][hf], trb, 9216 + (32 * ks + 4 * hf) * 144 + 32 * x); }
            L1M_TRWAIT();
#pragma unroll
            for (int x = 0; x < 2; ++x) {
#pragma unroll
                for (int ks = 0; ks < 2; ++ks) { const bf16x8 ah = l1m_join(th[x][ks][0], th[x][ks][1]), al = l1m_join(tlo[x][ks][0], tlo[x][ks][1]);
                    acc[x] = __builtin_amdgcn_mfma_f32_16x16x32_bf16(ah, bh[ks], acc[x], 0, 0, 0); acc[x] = __builtin_amdgcn_mfma_f32_16x16x32_bf16(ah, bl[ks], acc[x], 0, 0, 0); acc[x] = __builtin_amdgcn_mfma_f32_16x16x32_bf16(al, bh[ks], acc[x], 0, 0, 0); }
                pg8::u32x2 wh, wl; wh.x = pg8::cvt_pk_bf16(acc[x][0], acc[x][1]); wh.y = pg8::cvt_pk_bf16(acc[x][2], acc[x][3]);
                wl.x = pg8::cvt_pk_bf16(acc[x][0] - bflo(wh.x), acc[x][1] - bfhi(wh.x)); wl.y = pg8::cvt_pk_bf16(acc[x][2] - bflo(wh.y), acc[x][3] - bfhi(wh.y));
                *(LAS pg8::u32x2*)(s0n + (16 * itc + fr0) * M_PB + (16 * (2 * jh + x) + 4 * fq0) * 2) = wh; *(LAS pg8::u32x2*)(s0n + 9216 + (16 * itc + fr0) * M_PB + (16 * (2 * jh + x) + 4 * fq0) * 2) = wl;
            }
            cb ^= 1;
        }
        __syncthreads();
    }
    const int tt = wave >> 1, ih = wave & 1;
    for (int blk = 0; blk < NBLK; ++blk) {
        const int m0 = s * SEGLEN + blk * BLK;
        int fr = fr0, fq = fq0; asm volatile("" : "+v"(fr), "+v"(fq));
        LAS unsigned char* tb = lds + (blk & 1) * S_BUF;
        LAS unsigned char* s0c = lds + S_S0F + (blk & 1) * S_S0B; LAS unsigned char* s0n = lds + S_S0F + ((blk + 1) & 1) * S_S0B;
        {
            const int slot = tid >> 3, part = tid & 7;
            *(LAS v4u*)(tb + S_VB + slot * M_PB + part * 16) = R.v; *(LAS v4u*)(tb + S_GB + slot * M_PB + part * 16) = R.g; *(LAS v4u*)(tb + S_PCT + slot * M_PB + part * 16) = R.pct;
#pragma unroll
            for (int i = 0; i < 2; ++i) { const int e = tid + 512 * i; *(LAS v4u*)(tb + S_OR + (e >> 4) * S_ORP + (e & 15) * 16) = R.orr[i]; }
            if (tid < 64) *(LAS float*)(lds + S_BON + (blk & 1) * 256 + tid * 4) = R.bon;
        }
        const f32x4 sc0 = R.sc[0], sc1 = R.sc[1];
        __syncthreads();
        if (blk + 1 < NBLK) l3s_issue(a, h, m0 + BLK, tid, R);
        {
            bf16x8 ar[2];
#pragma unroll
            for (int ks = 0; ks < 2; ++ks) ar[ks] = *(LAS bf16x8*)(tb + S_OR + (16 * tt + fr) * S_ORP + (64 + 32 * ks + 8 * fq) * 2);
#pragma unroll
            for (int x = 0; x < 2; ++x) {
                const int it = 2 * ih + x;
                f32x4 acc;
#pragma unroll
                for (int rg4 = 0; rg4 < 4; ++rg4) acc[rg4] = bf2f(*(LAS unsigned short*)(tb + S_OR + (16 * tt + 4 * fq + rg4) * S_ORP + (16 * it + fr) * 2));
#pragma unroll
                for (int ks = 0; ks < 2; ++ks) { const bf16x8 bh = fragb(s0c, 16 * it + fr, 32 * ks + 8 * fq), bl = fragb(s0c + 9216, 16 * it + fr, 32 * ks + 8 * fq);
                    acc = __builtin_amdgcn_mfma_f32_16x16x32_bf16(ar[ks], bh, acc, 0, 0, 0); acc = __builtin_amdgcn_mfma_f32_16x16x32_bf16(ar[ks], bl, acc, 0, 0, 0); }
#pragma unroll
                for (int rg4 = 0; rg4 < 4; ++rg4) *(LAS float*)(lds + S_OUT + (16 * tt + 4 * fq + rg4) * 256 + (16 * it + fr) * 4) = acc[rg4];
            }
        }
        {
            bf16x8 bh[2], bl[2];
#pragma unroll
            for (int ks = 0; ks < 2; ++ks) { bh[ks] = fragb(s0c, 16 * itc + fr, 32 * ks + 8 * fq); bl[ks] = fragb(s0c + 9216, 16 * itc + fr, 32 * ks + 8 * fq); }
#pragma unroll
            for (int x = 0; x < 2; ++x) {
                const int jt = 2 * jh + x;
                f32x4 acc = x == 0 ? sc0 : sc1;
#pragma unroll
                for (int ks = 0; ks < 2; ++ks) { const bf16x8 ap = fragb(tb + S_PCT, 16 * jt + fr, 32 * ks + 8 * fq);
                    acc = __builtin_amdgcn_mfma_f32_16x16x32_bf16(ap, bh[ks], acc, 0, 0, 0); acc = __builtin_amdgcn_mfma_f32_16x16x32_bf16(ap, bl[ks], acc, 0, 0, 0); }
                {
                    pg8::u32x2 wh, wl; wh.x = pg8::cvt_pk_bf16(acc[0], acc[1]); wh.y = pg8::cvt_pk_bf16(acc[2], acc[3]);
                    wl.x = pg8::cvt_pk_bf16(acc[0] - bflo(wh.x), acc[1] - bfhi(wh.x)); wl.y = pg8::cvt_pk_bf16(acc[2] - bflo(wh.y), acc[3] - bfhi(wh.y));
                    *(LAS pg8::u32x2*)(s0n + (16 * itc + fr) * M_PB + (16 * jt + 4 * fq) * 2) = wh; *(LAS pg8::u32x2*)(s0n + 9216 + (16 * itc + fr) * M_PB + (16 * jt + 4 * fq) * 2) = wl; }
                if (s == SEGS - 1 && blk == NBLK - 1) *(f32x4*)(a.out + O_PST + (size_t)h * HD * HD + (16 * itc + fr) * 64 + 16 * jt + 4 * fq) = acc;
            }
        }
        __syncthreads();
        {
            const int slot = tid >> 3, part = tid & 7, c8 = h * HD + part * 8;
            float o[8], v[8], g[8], lw[8], lb[8];
            ld8l(lds, S_OUT + slot * 256 + part * 32, o); ld8l(lds, S_LN + part * 32, lw); ld8l(lds, S_LN + 256 + part * 32, lb);
            { const v4u wv = *(LAS v4u*)(tb + S_VB + slot * M_PB + part * 16), wg = *(LAS v4u*)(tb + S_GB + slot * M_PB + part * 16);
              v[0] = bflo(wv.x); v[1] = bfhi(wv.x); v[2] = bflo(wv.y); v[3] = bfhi(wv.y); v[4] = bflo(wv.z); v[5] = bfhi(wv.z); v[6] = bflo(wv.w); v[7] = bfhi(wv.w);
              g[0] = bflo(wg.x); g[1] = bfhi(wg.x); g[2] = bflo(wg.y); g[3] = bfhi(wg.y); g[4] = bflo(wg.z); g[5] = bfhi(wg.z); g[6] = bflo(wg.w); g[7] = bfhi(wg.w); }
            float sm = 0.f;
#pragma unroll
            for (int j = 0; j < 8; ++j) sm += o[j];
            const float mean = allreduce8(sm) * (1.f / 64.f);
            float q = 0.f;
#pragma unroll
            for (int j = 0; j < 8; ++j) { o[j] -= mean; q += o[j] * o[j]; }
            const float rstd = 1.0f / sqrtf(allreduce8(q) * (1.f / 64.f) + GN_EPS);
            const float bonus = *(LAS float*)(lds + S_BON + (blk & 1) * 256 + slot * 4);
            v4u w; float res[8];
#pragma unroll
            for (int j = 0; j < 8; ++j) res[j] = (o[j] * rstd * lw[j] + lb[j] + bonus * v[j]) * g[j];
            w.x = pk2(res[0], res[1]); w.y = pk2(res[2], res[3]); w.z = pk2(res[4], res[5]); w.w = pk2(res[6], res[7]);
            *(v4u*)((bf16*)(a.ws + WS_MIX) + (size_t)(m0 + slot) * DM + c8) = w;
        }
    }
    __syncthreads();
}

__device__ __forceinline__ void sample_unit(const Args& a, LAS unsigned char* lds, int h, int bg, int tid) {
    const bf16* P = (const bf16*)(a.ws + WS_P);
    const int cg = tid & 15, rg = tid >> 4;
    auto srcfn = [&](int slot) -> SlotSrc { const int b = bg * 16 + (slot >> 2), t = slot & 3; const int m = TP + b * TS + t; SlotSrc r; r.cur = P + (size_t)m * PPITCH;
        r.prevb = t > 0 ? r.cur - PPITCH : nullptr; r.prevf = t > 0 ? nullptr : a.in[I_SHIFT] + (size_t)b * RCOLS; return r; };
    { PrepRegs R0; LoraFrags LF0; prep_block<true, true, 4, false, false, false, false>(a, lds, h, srcfn, tid, R0, nullptr, LF0); }
    f32x4 Sn[2];
    { const float* sp = a.in[I_STATE] + (((size_t)(bg * 16) * NH + h) * HD) * HD;
#pragma unroll
      for (int r = 0; r < 2; ++r) Sn[r] = *(const f32x4*)(sp + (size_t)(2 * rg + r) * HD + 4 * cg); }
    for (int bl = 0; bl < 16; ++bl) {
        const int b = bg * 16 + bl;
        f2 Sp[2][2] = {{Sn[0].xy, Sn[0].zw}, {Sn[1].xy, Sn[1].zw}};
        if (bl < 15) { const float* sp = a.in[I_STATE] + (((size_t)(b + 1) * NH + h) * HD) * HD;
#pragma unroll
            for (int r = 0; r < 2; ++r) Sn[r] = *(const f32x4*)(sp + (size_t)(2 * rg + r) * HD + 4 * cg); }
        l3_steps<4>(lds, Sp, cg, rg, 4 * bl, 4 * bl + 4);
        float* so = a.out + O_SST + (((size_t)b * NH + h) * HD) * HD;
#pragma unroll
        for (int r = 0; r < 2; ++r) *(f32x4*)(so + (size_t)(2 * rg + r) * HD + 4 * cg) = (f32x4){Sp[r][0].x, Sp[r][0].y, Sp[r][1].x, Sp[r][1].y};
    }
    __syncthreads();
    post_block(a, lds, h, [&](int slot) -> long { return TP + (bg * 16 + (slot >> 2)) * TS + (slot & 3); }, tid);
    __syncthreads();
}
}

namespace at {
constexpr int KTPB = 144;
constexpr int P_KEYS = 208, P_VTPB = 432;
constexpr int P_KT = 0, P_VT = P_KT + P_KEYS * KTPB, P_END = P_VT + 64 * P_VTPB;
constexpr int S_KEYS = 160, S_VTPB = 336;
constexpr int S_KT = 0, S_VT = S_KEYS * KTPB, S_STRIDE = S_VT + 64 * S_VTPB;
static_assert(P_END <= 131072 && 2 * S_STRIDE <= 131072, "attention LDS map");
typedef short s16x4 __attribute__((ext_vector_type(4)));

__device__ __forceinline__ void attn_wave16(LAS unsigned char* kt, LAS unsigned char* vt, int vtpb, int kt0, const bf16x8 (&qf)[2], int qrel, float slope, float sink, int kmin, f32x4 (&o)[4], int lane) {
    const int fr = lane & 15, fq = lane >> 4;
    float p[10][4];
    float mx = -INFINITY;
#pragma unroll
    for (int tl = 0; tl < 9; ++tl) {
        f32x4 acc = {0.f, 0.f, 0.f, 0.f};
#pragma unroll
        for (int ks = 0; ks < 2; ++ks) {
            const bf16x8 kf = *(LAS bf16x8*)(kt + ((kt0 + tl) * 16 + fr) * KTPB + (32 * ks + 8 * fq) * 2);
            acc = __builtin_amdgcn_mfma_f32_16x16x32_bf16(kf, qf[ks], acc, 0, 0, 0);
        }
#pragma unroll
        for (int rg = 0; rg < 4; ++rg) {
            const int kidx = (kt0 + tl) * 16 + 4 * fq + rg, dist = qrel - kidx;
            bool ok = kidx >= kmin;
            if (tl == 0 || tl == 8) ok = ok && dist >= 0 && dist < WIN;
            const float s = ok ? acc[rg] * 0.125f - slope * (float)dist : -INFINITY;
            p[tl][rg] = s; mx = fmaxf(mx, s);
        }
    }
#pragma unroll
    for (int rg = 0; rg < 4; ++rg) p[9][rg] = -INFINITY;
    mx = fmaxf(mx, __shfl_xor(mx, 16)); mx = fmaxf(mx, __shfl_xor(mx, 32));
    mx = fmaxf(mx, sink);
    float sum = 0.f;
#pragma unroll
    for (int tl = 0; tl < 10; ++tl)
#pragma unroll
        for (int rg = 0; rg < 4; ++rg) { const float e = __expf(p[tl][rg] - mx); p[tl][rg] = e; sum += e; }
    sum += __shfl_xor(sum, 16); sum += __shfl_xor(sum, 32);
    const float inv = 1.0f / (sum + __expf(sink - mx));
#pragma unroll
    for (int dt = 0; dt < 4; ++dt) o[dt] = (f32x4){0.f, 0.f, 0.f, 0.f};
#pragma unroll
    for (int pr = 0; pr < 5; ++pr) {
        union { bf16x8 v; unsigned u[4]; } af;
        af.u[0] = pk2(p[2 * pr][0] * inv, p[2 * pr][1] * inv); af.u[1] = pk2(p[2 * pr][2] * inv, p[2 * pr][3] * inv);
        af.u[2] = pk2(p[2 * pr + 1][0] * inv, p[2 * pr + 1][1] * inv); af.u[3] = pk2(p[2 * pr + 1][2] * inv, p[2 * pr + 1][3] * inv);
#pragma unroll
        for (int dt = 0; dt < 4; ++dt) {
            LAS unsigned char* vp = vt + (16 * dt + fr) * vtpb + ((kt0 + 2 * pr) * 16 + 4 * fq) * 2;
            union { bf16x8 v; s16x4 h[2]; } bfv;
            bfv.h[0] = *(LAS s16x4*)vp; bfv.h[1] = *(LAS s16x4*)(vp + 32);
            o[dt] = __builtin_amdgcn_mfma_f32_16x16x32_bf16(af.v, bfv.v, o[dt], 0, 0, 0);
        }
    }
}

struct KVRegs { v4u k[4], v[4]; };
constexpr int P_OST = P_END;
static_assert(P_OST + 8 * 4096 <= 131072, "attention LDS map (O stage)");
__device__ __forceinline__ void kv_issue(const Args& a, int qb, int kvh, int tid, KVRegs& R) {
    const bf16* P = (const bf16*)(a.ws + WS_P);
    const int tok0 = qb * 64 - 128;
#pragma unroll
    for (int i = 0; i < 4; ++i) {
        const int idx = tid + 512 * i, row = idx >> 3, ch = idx & 7, tok = tok0 + row;
        R.k[i] = (v4u){0u, 0u, 0u, 0u}; R.v[i] = (v4u){0u, 0u, 0u, 0u};
        if (idx < P_KEYS * 8 && tok >= 0 && row < 192) { const bf16* pr = P + (size_t)tok * PPITCH + kvh * HD + 8 * ch; R.k[i] = *(const v4u*)(pr + C_SK); R.v[i] = *(const v4u*)(pr + C_SV); }
    }
}
__device__ __forceinline__ void prompt_unit(const Args& a, LAS unsigned char* lds, int qb, int kvh, int tid, KVRegs& R, int nqb, int nkvh) {
    const bf16* P = (const bf16*)(a.ws + WS_P);
    bf16* MIX = (bf16*)(a.ws + WS_MIX);
    const int lane = tid & 63, wave = __builtin_amdgcn_readfirstlane(tid >> 6), fr = lane & 15, fq = lane >> 4;
    const int q0 = qb * 64, tok0 = q0 - 128;
#pragma unroll
    for (int i = 0; i < 4; ++i) {
        const int idx = tid + 512 * i;
        if (idx < P_KEYS * 8) {
            const int row = idx >> 3, ch = idx & 7;
            const v4u kv = R.k[i], vv = R.v[i];
            *(LAS v4u*)(lds + P_KT + row * KTPB + ch * 16) = kv;
            LAS unsigned short* vt = (LAS unsigned short*)(lds + P_VT + (8 * ch) * P_VTPB + row * 2);
            vt[0 * (P_VTPB / 2)] = (unsigned short)(vv.x & 0xffff); vt[1 * (P_VTPB / 2)] = (unsigned short)(vv.x >> 16);
            vt[2 * (P_VTPB / 2)] = (unsigned short)(vv.y & 0xffff); vt[3 * (P_VTPB / 2)] = (unsigned short)(vv.y >> 16);
            vt[4 * (P_VTPB / 2)] = (unsigned short)(vv.z & 0xffff); vt[5 * (P_VTPB / 2)] = (unsigned short)(vv.z >> 16);
            vt[6 * (P_VTPB / 2)] = (unsigned short)(vv.w & 0xffff); vt[7 * (P_VTPB / 2)] = (unsigned short)(vv.w >> 16);
        }
    }
    const int g = wave >> 1, half = wave & 1, h = kvh * 4 + g;
    bf16x8 qf[2][2];
#pragma unroll
    for (int i = 0; i < 2; ++i)
#pragma unroll
        for (int ks = 0; ks < 2; ++ks) qf[i][ks] = *(const bf16x8*)(P + (size_t)(q0 + 32 * half + 16 * i + fr) * PPITCH + C_Q + h * HD + 32 * ks + 8 * fq);
    __syncthreads();
    if (nqb >= 0) kv_issue(a, nqb, nkvh, tid, R);
    const float slope = exp2f(-0.5f * (float)(h + 1)), sink = a.in[I_SINK][h];
    const int kmin = tok0 < 0 ? -tok0 : 0;
    LAS unsigned char* ost = lds + P_OST + wave * 4096;
#pragma unroll 1
    for (int i = 0; i < 2; ++i) {
        const int ql = 32 * half + 16 * i, qa = q0 + ql;
        f32x4 o[4];
        if (i == 0) attn_wave16(lds + P_KT, lds + P_VT, P_VTPB, ql >> 4, qf[0], ql + 128 + fr, slope, sink, kmin, o, lane);
        else attn_wave16(lds + P_KT, lds + P_VT, P_VTPB, ql >> 4, qf[1], ql + 128 + fr, slope, sink, kmin, o, lane);
#pragma unroll
        for (int dt = 0; dt < 4; ++dt)
#pragma unroll
            for (int rg = 0; rg < 4; ++rg) *(LAS unsigned short*)(ost + (4 * fq + rg) * 128 + (16 * dt + fr) * 2) = (unsigned short)f2bf(o[dt][rg]);
        asm volatile("s_waitcnt lgkmcnt(0)" ::: "memory");
#pragma unroll
        for (int c2 = 0; c2 < 2; ++c2) { const int row = lane >> 2, c = (lane & 3) + 4 * c2;
            const v4u w = *(LAS v4u*)(ost + row * 128 + c * 16);
            *(v4u*)(MIX + (size_t)(qa + row) * DM + CW + h * HD + 8 * c) = w; }
        asm volatile("s_waitcnt lgkmcnt(0)" ::: "memory");
    }
    __syncthreads();
}

__device__ __forceinline__ void sample_unit(const Args& a, LAS unsigned char* lds, int b, int kp, int tid) {
    const bf16* P = (const bf16*)(a.ws + WS_P);
    bf16* MIX = (bf16*)(a.ws + WS_MIX);
    const int lane = tid & 63, wave = __builtin_amdgcn_readfirstlane(tid >> 6), fr = lane & 15, fq = lane >> 4;
    struct SRow { f32x4 k0, k1, v0, v1; };
    auto sload = [&](int i, SRow& r) {
        const int idx = tid + 512 * i;
        const int e = idx / (S_KEYS * 8), rem = idx - e * (S_KEYS * 8), row = rem >> 3, ch = rem & 7, kvh = 2 * kp + e;
        r.k0 = (f32x4){0.f, 0.f, 0.f, 0.f}; r.k1 = r.k0; r.v0 = r.k0; r.v1 = r.k0;
        if (row < WIN) {
            const size_t src = (((size_t)b * WIN + row) * KVH + kvh) * HD + 8 * ch;
            r.k0 = *(const f32x4*)(a.in[I_CK] + src); r.k1 = *(const f32x4*)(a.in[I_CK] + src + 4); r.v0 = *(const f32x4*)(a.in[I_CV] + src); r.v1 = *(const f32x4*)(a.in[I_CV] + src + 4);
        } else if (row < WIN + TS) {
            const bf16* pr = P + (size_t)(TP + b * TS + row - WIN) * PPITCH + kvh * HD + 8 * ch;
            float kf[8], vf[8]; rw::ld8bf(pr + C_SK, kf); rw::ld8bf(pr + C_SV, vf);
            r.k0 = (f32x4){kf[0], kf[1], kf[2], kf[3]}; r.k1 = (f32x4){kf[4], kf[5], kf[6], kf[7]}; r.v0 = (f32x4){vf[0], vf[1], vf[2], vf[3]}; r.v1 = (f32x4){vf[4], vf[5], vf[6], vf[7]};
        }
    };
    auto sstore = [&](int i, const SRow& r) {
        const int idx = tid + 512 * i;
        const int e = idx / (S_KEYS * 8), rem = idx - e * (S_KEYS * 8), row = rem >> 3, ch = rem & 7, kvh = 2 * kp + e;
        if (row >= TS && row < WIN + TS) {
            const size_t dst = (((size_t)b * WIN + row - TS) * KVH + kvh) * HD + 8 * ch;
            *(f32x4*)(a.out + O_SCK + dst) = r.k0; *(f32x4*)(a.out + O_SCK + dst + 4) = r.k1;
            *(f32x4*)(a.out + O_SCV + dst) = r.v0; *(f32x4*)(a.out + O_SCV + dst + 4) = r.v1;
        }
        LAS unsigned char* base = lds + e * S_STRIDE;
        v4u kw; kw.x = pk2(r.k0[0], r.k0[1]); kw.y = pk2(r.k0[2], r.k0[3]); kw.z = pk2(r.k1[0], r.k1[1]); kw.w = pk2(r.k1[2], r.k1[3]);
        *(LAS v4u*)(base + S_KT + row * KTPB + ch * 16) = kw;
        LAS unsigned short* vt = (LAS unsigned short*)(base + S_VT + (8 * ch) * S_VTPB + row * 2);
        const unsigned w0 = pk2(r.v0[0], r.v0[1]), w1 = pk2(r.v0[2], r.v0[3]), w2 = pk2(r.v1[0], r.v1[1]), w3 = pk2(r.v1[2], r.v1[3]);
        vt[0 * (S_VTPB / 2)] = (unsigned short)(w0 & 0xffff); vt[1 * (S_VTPB / 2)] = (unsigned short)(w0 >> 16); vt[2 * (S_VTPB / 2)] = (unsigned short)(w1 & 0xffff); vt[3 * (S_VTPB / 2)] = (unsigned short)(w1 >> 16);
        vt[4 * (S_VTPB / 2)] = (unsigned short)(w2 & 0xffff); vt[5 * (S_VTPB / 2)] = (unsigned short)(w2 >> 16); vt[6 * (S_VTPB / 2)] = (unsigned short)(w3 & 0xffff); vt[7 * (S_VTPB / 2)] = (unsigned short)(w3 >> 16);
    };
    {
        SRow ra, rb;
        sload(0, ra);
#pragma unroll 1
        for (int i = 0; i < 4; i += 2) { sload(i + 1, rb); sstore(i, ra); sload(i + 2, ra); sstore(i + 1, rb); }
        sstore(4, ra);
    }
    __syncthreads();
    if (wave < 2) {
        const int kvh = 2 * kp + wave, g = fr >> 2, t = fr & 3, h = kvh * 4 + g, m = TP + b * TS + t;
        const float slope = exp2f(-0.5f * (float)(h + 1)), sink = a.in[I_SINK][h];
        bf16x8 qf[2];
#pragma unroll
        for (int ks = 0; ks < 2; ++ks) qf[ks] = *(const bf16x8*)(P + (size_t)m * PPITCH + C_Q + h * HD + 32 * ks + 8 * fq);
        f32x4 o[4];
        LAS unsigned char* base = lds + wave * S_STRIDE;
        attn_wave16(base + S_KT, base + S_VT, S_VTPB, 0, qf, t + WIN, slope, sink, 0, o, lane);
#pragma unroll
        for (int dt = 0; dt < 4; ++dt)
#pragma unroll
            for (int rg = 0; rg < 4; ++rg) { const int r = 4 * fq + rg, hh = kvh * 4 + (r >> 2), mm = TP + b * TS + (r & 3);
                MIX[(size_t)mm * DM + CW + hh * HD + 16 * dt + fr] = (bf16)f2bf(o[dt][rg]); }
    }
    __syncthreads();
}

__device__ __forceinline__ void copies(const Args& a, size_t gt, size_t gs) {
    const bf16* P = (const bf16*)(a.ws + WS_P);
    for (size_t i = gt; i < RCOLS; i += gs) a.out[O_PSH + i] = bf2f(P[(size_t)(TP - 1) * PPITCH + i]);
    for (size_t i = gt; i < (size_t)NB * RCOLS; i += gs) { const int b = i / RCOLS, cc = i % RCOLS; a.out[O_SSH + i] = bf2f(P[(size_t)(TP + b * TS + TS - 1) * PPITCH + cc]); }
    for (size_t i = gt; i < (size_t)WIN * KVW; i += gs) { const int w = i / KVW, cc = i % KVW; const size_t row = (size_t)(TP - WIN + w) * PPITCH;
        a.out[O_PCK + i] = bf2f(P[row + C_SK + cc]); a.out[O_PCV + i] = bf2f(P[row + C_SV + cc]); }
}
}
enum { PH_PRO = 0, PH_GIN = 1, PH_L1 = 2, PH_L3 = 3, PH_GOUT = 4, PH_GGU = 5, PH_GDN = 6, PH_FIN = 7, PH_N = 8 };
struct OneUnit {
    int pm, pn;
    __device__ __forceinline__ bool next(int i, pg8::Unit& u) const { if (i) return false; u.pm = pm; u.pn = pn; u.ks = 0; return true; }
    __device__ __forceinline__ void a_ready(const pg8::Unit&) const {}
    __device__ __forceinline__ void done(const pg8::Unit&) const {}
};
struct FlagOrder {
    pg8::StaticOrder so; unsigned* flag; unsigned* tmo; unsigned want; int pm_from;
    __device__ __forceinline__ bool next(int i, pg8::Unit& u) const { return so.next(i, u); }
    __device__ __forceinline__ void a_ready(const pg8::Unit& u) const {
        if (u.pm >= pm_from) {
            unsigned sp = 0u;
            while (xb_ld(flag) < want) { __builtin_amdgcn_s_sleep(1); if ((++sp & 255u) == 0u) { if (xb_ld(tmo)) break; if (sp > XB_SPIN_CAP) { atomicAdd(tmo, 1u); break; } } }
            __builtin_amdgcn_fence(__ATOMIC_ACQUIRE, "agent");
        }
    }
    __device__ __forceinline__ void done(const pg8::Unit&) const {}
};
constexpr int OUT_TAIL_UNITS = 2 * (DM / pg8::BM);
static_assert(M - TP == 2 * pg8::BM, "out-projection tail: two sample-row panels");
__global__ void __launch_bounds__(NWAVES * 64, 2) mk_fwd(Args args) {
    extern __shared__ __attribute__((aligned(16))) unsigned char lds_raw[];
    LAS unsigned char* lds = (LAS unsigned char*)lds_raw;
    volatile LAS unsigned* MISC = (volatile LAS unsigned*)(lds + MISC_OFF);
    const int tid = threadIdx.x, lane = tid & 63, wave = __builtin_amdgcn_readfirstlane(tid >> 6);
    const int G = gridDim.x; const int bx = blockIdx.x; const int vcu = (G % 8 == 0) ? (bx % 8) * (G / 8) + bx / 8 : bx;
    if (tid < 64) ((LAS unsigned*)(lds + MISC_OFF))[tid] = 0u;
    __syncthreads();
    unsigned char* ws = args.ws;
    XcdBarrier bar = xcd_barrier_post((unsigned*)(ws + WS_CTL) + CW_BAR, MISC + 8);
    const int lo = args.ph_lo, hi = args.ph_hi;
#define IN(k) (lo <= (k) && (k) < hi)
#define BOTH(k) (IN(k) && IN((k) + 1))
    if (IN(PH_PRO)) { for (int rep = 0; rep < REP_PRO; ++rep) p0_prologue(args, lds, vcu, G, wave, lane); if (BOTH(PH_PRO)) xcd_barrier(bar); }
    if (IN(PH_GIN)) {
        pg8::Gemm g{(const bf16*)(ws + WS_XN), (const bf16*)(ws + WS_WIN), M, PPITCH, DM, DM}; pg8::StaticOrder S; S.init(M, PPITCH, G, bx);
        pg8::EpiP E{(bf16*)(ws + WS_P), PPITCH};
        for (int rep = 0; rep < REP_GIN; ++rep) pg8::gemm_phase<pg8::EpiP, pg8::StaticOrder, true, true>(lds, g, S, E);
#if LATE_WEIGHTS
        { const int nfull = S.nwg % G;
          if (nfull && bx >= nfull) convert_late_weights(args, lds, (bx - nfull) * NWAVES + wave, (G - nfull) * NWAVES, wave, lane, 0);
          else if (!nfull) convert_late_weights(args, lds, bx * NWAVES + wave, G * NWAVES, wave, lane, 0); }
#endif
        if (BOTH(PH_GIN)) xcd_barrier(bar);
    }
    if (IN(PH_L1)) {
      for (int rep = 0; rep < REP_L1; ++rep) {
        for (int r2 = 0; r2 < REP_L1A; ++r2)
        for (int u = bx; u < 256; u += G) { const int h = u & 15, s = u >> 4; rw::l1m_unit(args, lds, h, s, tid);
        }
        for (int r3 = 0; r3 < REP_L1B; ++r3)
        { at::KVRegs KR; if (bx < 1024) at::kv_issue(args, bx >> 2, bx & 3, tid, KR);
          for (int u = bx; u < 1024; u += G) { const int un = u + G; at::prompt_unit(args, lds, u >> 2, u & 3, tid, KR, un < 1024 ? (un >> 2) : -1, un & 3); } }
        if (G < 256) for (int u = bx; u < 256; u += G) at::sample_unit(args, lds, u >> 1, u & 1, tid);
        at::copies(args, (size_t)bx * 512 + tid, (size_t)G * 512);
      }
        if (BOTH(PH_L1)) xcd_barrier(bar);
    }
    if (IN(PH_L3)) {
      for (int rep = 0; rep < REP_L3; ++rep) {
        for (int r2 = 0; r2 < REP_L3A; ++r2)
        for (int u = bx; u < 256; u += G) { const int h = u & 15, s = u >> 4; rw::l3s_unit(args, lds, h, s, tid); }
        for (int r2 = 0; r2 < REP_L3B; ++r2)
        for (int u = bx; u < 128; u += G) { const int h = u & 15, bg = u >> 4; rw::sample_unit(args, lds, h, bg, tid); }
        for (int r3 = 0; r3 < REP_L1C; ++r3)
        if (rep == 0 && G >= 256 && bx >= 128) for (int u = bx - 128; u < 256; u += G - 128) at::sample_unit(args, lds, u >> 1, u & 1, tid);
      }
        if (BOTH(PH_L3)) xcd_barrier(bar);
    }
    const pg8::Gemm g_out{(const bf16*)(ws + WS_MIX), (const bf16*)(ws + WS_WOUT), M, DM, DM, DM};
    const pg8::EpiOut E_out{args.in[I_XP], args.in[I_XS], TP, (bf16*)(ws + WS_XN), (float*)(ws + WS_SS1), DM};
    if (IN(PH_GOUT)) {
        pg8::StaticOrder S; S.init(TP, DM, G, bx);
        pg8::gemm_phase<pg8::EpiOut, pg8::StaticOrder, true, true>(lds, g_out, S, E_out);
        if (BOTH(PH_GOUT)) xcd_barrier(bar);
    }
    if (IN(PH_GGU)) {
        pg8::Gemm g{(const bf16*)(ws + WS_XN), (const bf16*)(ws + WS_WGU), M, 2 * DFF, DM, DM};
        FlagOrder S; S.so.init(M, 2 * DFF, G, bx); S.flag = (unsigned*)(ws + WS_CTL) + CW_OUTTAIL; S.want = OUT_TAIL_UNITS; S.pm_from = TP / pg8::BM; S.tmo = (unsigned*)(ws + WS_CTL) + CW_BAR + XB_TMO;
        const int nfull = S.so.nwg % G, t0 = (nfull + OUT_TAIL_UNITS <= G) ? nfull : 0;
        for (int t = bx - t0; t >= 0 && t < OUT_TAIL_UNITS; t += G) {
            OneUnit S1; S1.pm = TP / pg8::BM + (t & 1); S1.pn = t >> 1;
            pg8::gemm_phase<pg8::EpiOut, OneUnit, true, true>(lds, g_out, S1, E_out);
            asm volatile("s_waitcnt vmcnt(0)" ::: "memory");
            __syncthreads();
            if (tid == 0) { __builtin_amdgcn_fence(__ATOMIC_RELEASE, "agent"); asm volatile("s_waitcnt vmcnt(0)" ::: "memory"); (void)xb_add(S.flag, 1u); }
        }
        pg8::EpiGU E{(bf16*)(ws + WS_H), DFF, (const float*)(ws + WS_SS1), 1.f / DM, RMS_EPS};
        for (int rep = 0; rep < REP_GGU; ++rep) pg8::gemm_phase<pg8::EpiGU, FlagOrder, true, true>(lds, g, S, E);
#if LATE_WEIGHTS
        { const int c0 = t0 + OUT_TAIL_UNITS;
          if (nfull && bx >= c0) convert_late_weights(args, lds, (bx - c0) * NWAVES + wave, (G - c0) * NWAVES, wave, lane, 1);
          else if (!nfull || c0 >= G) convert_late_weights(args, lds, bx * NWAVES + wave, G * NWAVES, wave, lane, 1); }
#endif
        if (BOTH(PH_GGU)) xcd_barrier(bar);
    }
    if (IN(PH_GDN)) {
        {
            pg8::Gemm g{(const bf16*)(ws + WS_H), (const bf16*)(ws + WS_WDN), M, DM, DFF, DFF}; pg8::StaticOrder S; S.init(M, DM, G, bx); S.lim = GDN_FULL;
            pg8::EpiDown E{(bf16*)(ws + WS_XN), DM};
            pg8::gemm_phase<pg8::EpiDown, pg8::StaticOrder, true, true>(lds, g, S, E);
        }
        {
            pg8::Gemm g{(const bf16*)(ws + WS_H), (const bf16*)(ws + WS_WDN), M, DM, DFF / GDN_NSL, DFF}; pg8::SplitOrder S; S.so.init(M, DM, G, bx); S.base = GDN_FULL; S.nsl = GDN_NSL;
            pg8::EpiSlab E{(float*)(ws + WS_SLAB), nullptr, GDN_FULL, GDN_NSL, DM / 256, M / 256, (M / 256) * (DM / 256)};
            pg8::gemm_phase<pg8::EpiSlab, pg8::SplitOrder, true, true>(lds, g, S, E);
        }
        if (BOTH(PH_GDN)) xcd_barrier(bar);
    }
    if (IN(PH_FIN)) { final_norm(args, vcu, G, wave, lane); }
#undef IN
#undef BOTH
}

extern "C" void kernel_launch(void* const* d_in, const int* in_sizes, int n_in, void* d_out, int out_size, void* d_ws, size_t ws_size, hipStream_t stream) {
    static int grid = 0;
    if (grid == 0) {
        if (n_in != 26 || (size_t)out_size != O_END || ws_size < WS_END) { fprintf(stderr, "kernel_launch: unexpected shapes: n_in %d out %d ws %zu\n", n_in, out_size, ws_size); grid = -1; return; }
        int dev = 0, cus = 0, per_cu = 0;
        if (hipGetDevice(&dev) != hipSuccess || hipDeviceGetAttribute(&cus, hipDeviceAttributeMultiprocessorCount, dev) != hipSuccess) { grid = -1; return; }
        if (hipFuncSetAttribute((const void*)mk_fwd, hipFuncAttributeMaxDynamicSharedMemorySize, LDS_BYTES) != hipSuccess) { grid = -1; return; }
        if (hipOccupancyMaxActiveBlocksPerMultiprocessor(&per_cu, (const void*)mk_fwd, NWAVES * 64, LDS_BYTES) != hipSuccess || per_cu < 1) { fprintf(stderr, "kernel_launch: occupancy query says %d\n", per_cu); per_cu = 1; }
        (void)hipGetLastError();
        grid = cus;
    }
    if (grid < 0) return;
    (void)hipMemsetAsync((char*)d_ws + WS_CTL, 0, CTL_ZERO_BYTES, stream);
    Args a{};
    for (int i = 0; i < 26; ++i) a.in[i] = (const float*)d_in[i];
    a.out = (float*)d_out; a.ws = (unsigned char*)d_ws;
#if MK_ONE_LAUNCH
    a.ph_lo = 0; a.ph_hi = PH_N;
    hipLaunchKernelGGL(mk_fwd, dim3(grid), dim3(NWAVES * 64), LDS_BYTES, stream, a);
#else
    a.ph_lo = PH_PRO; a.ph_hi = PH_GIN + 1;
    hipLaunchKernelGGL(mk_fwd, dim3(grid), dim3(NWAVES * 64), LDS_BYTES, stream, a);
    (void)hipMemsetAsync((char*)d_ws + WS_CTL, 0, CTL_ZERO_BYTES, stream);
    a.ph_lo = PH_L1; a.ph_hi = PH_N;
    hipLaunchKernelGGL(mk_fwd, dim3(grid), dim3(NWAVES * 64), LDS_BYTES, stream, a);
#endif
}
```

```cpp
#define MK_ONE_LAUNCH 1
#define REP_PRO 1
#define REP_GIN 1
#define REP_L1 1
#define REP_L3 1
#define REP_GGU 1
#define REP_L1A 1
#define REP_L1B 1
#define REP_L1C 1
#define REP_L3A 1
#define REP_L3B 1
#define REP_PREP 1
#define REP_STA 1
#define REP_STBC 1
#define LATE_WEIGHTS 1
#include <hip/hip_runtime.h>
#include <cstdio>
#include <cstdint>
namespace pg8 {
#define PG8_LAS __attribute__((address_space(3)))
typedef unsigned short bf16_t;
typedef short bf16x8 __attribute__((ext_vector_type(8)));
typedef float f32x4 __attribute__((ext_vector_type(4)));
typedef unsigned u32x4 __attribute__((ext_vector_type(4)));
constexpr int BM = 256, BK = 64, HALF = 128, HTB = HALF * BK * 2  , STAGE_BYTES = 8 * HTB, NXCD = 8, WGM = 8;

__host__ __device__ __forceinline__ int lds_byte(int r, int c) { const int st = (r >> 4) * 2 + (c >> 5), rr = r & 15, cc = c & 31, ob = rr * 64 + cc * 2; return st * 1024 + (ob ^ (((ob >> 9) & 1) << 5)); }
__host__ __device__ __forceinline__ void stage_rc(int b, int& R, int& C) { const int st = b / 1024, sb = b % 1024, swz = sb ^ (((sb >> 9) & 1) << 5); R = (st >> 1) * 16 + swz / 64; C = (st & 1) * 32 + (swz % 64) / 2; }
__host__ __device__ __forceinline__ int perm32(int rho) { const int n = rho >> 4, i = rho & 15; return 8 * (i >> 2) + 4 * n + (i & 3); }

struct Unit { int pm, pn, ks; };
struct Gemm { const bf16_t* A; const bf16_t* Bt; int M, N, K, ld; };

struct StaticOrder {
    int nM, nN, nwg, G, c, lim;
    __host__ __device__ void init(int M, int N, int G_, int c_) { nM = M / BM; nN = N / BM; nwg = nM * nN; G = G_; c = c_; lim = nwg; }
    __host__ __device__ void unit_of(int L, Unit& u) const {
        int wgid = L; { const int q = nwg / NXCD, r = nwg % NXCD, xcd = wgid % NXCD, off = wgid / NXCD; wgid = (xcd < r ? xcd * (q + 1) : r * (q + 1) + (xcd - r) * q) + off; }
        const int nig = WGM * nN, gid = wgid / nig, fm = gid * WGM, gsz = (nM - fm) < WGM ? (nM - fm) : WGM;
        u.pm = fm + ((wgid % nig) % gsz); u.pn = (wgid % nig) / gsz; u.ks = 0;
    }
    __host__ __device__ bool next(int i, Unit& u) const {
        const long L = (long)i * G + c; if (L >= lim) return false;
        u.ks = 0;
        int wgid = (int)L; { const int q = nwg / NXCD, r = nwg % NXCD, xcd = wgid % NXCD, off = wgid / NXCD; wgid = (xcd < r ? xcd * (q + 1) : r * (q + 1) + (xcd - r) * q) + off; }
        const int nig = WGM * nN, gid = wgid / nig, fm = gid * WGM, gsz = (nM - fm) < WGM ? (nM - fm) : WGM;
        u.pm = fm + ((wgid % nig) % gsz); u.pn = (wgid % nig) / gsz; return true;
    }
    __device__ __forceinline__ void a_ready(const Unit&) const {}
    __device__ __forceinline__ void done(const Unit&) const {}
};
struct ColumnOrder {
    int first, stride, nM, pn;
    __host__ __device__ bool next(int i, Unit& u) const { if (first < 0) return false; const int k = first + i * stride; if (k >= nM) return false; u.pm = k; u.pn = pn; u.ks = 0; return true; }
    __device__ __forceinline__ void a_ready(const Unit&) const {}
    __device__ __forceinline__ void done(const Unit&) const {}
};
struct SplitOrder {
    StaticOrder so; int base, nsl;
    __host__ __device__ bool next(int i, Unit& u) const {
        const long q = (long)i * so.G + so.c; if (q >= (long)(so.nwg - base) * nsl) return false;
        so.unit_of(base + (int)(q / nsl), u); u.ks = (int)(q % nsl); return true;
    }
    __device__ __forceinline__ void a_ready(const Unit&) const {}
    __device__ __forceinline__ void done(const Unit&) const {}
};

typedef __bf16 bf16x2_t __attribute__((ext_vector_type(2)));
typedef float f32x2_t __attribute__((ext_vector_type(2)));
__device__ __forceinline__ unsigned cvt_pk_bf16(float lo, float hi) { const f32x2_t v = {lo, hi}; return __builtin_bit_cast(unsigned, __builtin_convertvector(v, bf16x2_t)); }
typedef unsigned u32x2 __attribute__((ext_vector_type(2)));

struct EpiP {
    static constexpr bool PERM = true, AFTER_DRAIN = false;
    bf16_t* O; int ldc;
    __device__ __forceinline__ void operator()(const f32x4 (&acc)[2][2][4][2], const Unit& u, int wr, int wc, int fr, int fq) const {
        const int row0 = u.pm * BM + wr * 64 + fr, col0 = u.pn * BM + wc * 32 + 8 * fq;
#pragma unroll
        for (int ai = 0; ai < 2; ++ai)
#pragma unroll
            for (int m = 0; m < 4; ++m) { bf16_t* rowp = O + (size_t)(row0 + ai * HALF + m * 16) * ldc + col0;
#pragma unroll
                for (int bj = 0; bj < 2; ++bj) { const f32x4 v0 = acc[ai][bj][m][0], v1 = acc[ai][bj][m][1];
                    u32x4 w; w.x = cvt_pk_bf16(v0[0], v0[1]); w.y = cvt_pk_bf16(v0[2], v0[3]); w.z = cvt_pk_bf16(v1[0], v1[1]); w.w = cvt_pk_bf16(v1[2], v1[3]);
                    *(u32x4*)(rowp + bj * HALF) = w; } }
    }
};
struct EpiOut {
    static constexpr bool PERM = true, AFTER_DRAIN = false;
    const float* base0; const float* base1; int split; bf16_t* xb; float* ss; int ldc;
    __device__ __forceinline__ void operator()(const f32x4 (&acc)[2][2][4][2], const Unit& u, int wr, int wc, int fr, int fq) const {
        const int row0 = u.pm * BM + wr * 64 + fr, col0 = u.pn * BM + wc * 32 + 8 * fq;
#pragma unroll
        for (int ai = 0; ai < 2; ++ai)
#pragma unroll
            for (int m = 0; m < 4; ++m) {
                const int row = row0 + ai * HALF + m * 16;
                const float* bp = (row < split ? base0 + (size_t)row * ldc : base1 + (size_t)(row - split) * ldc) + col0;
                float s = 0.f;
#pragma unroll
                for (int bj = 0; bj < 2; ++bj) {
                    const f32x4 o0 = *(const f32x4*)(bp + bj * HALF) + acc[ai][bj][m][0], o1 = *(const f32x4*)(bp + bj * HALF + 4) + acc[ai][bj][m][1];
                    s += ((o0[0] * o0[0] + o0[1] * o0[1]) + (o0[2] * o0[2] + o0[3] * o0[3])) + ((o1[0] * o1[0] + o1[1] * o1[1]) + (o1[2] * o1[2] + o1[3] * o1[3]));
                    u32x4 w; w.x = cvt_pk_bf16(o0[0], o0[1]); w.y = cvt_pk_bf16(o0[2], o0[3]); w.z = cvt_pk_bf16(o1[0], o1[1]); w.w = cvt_pk_bf16(o1[2], o1[3]);
                    *(u32x4*)(xb + (size_t)row * ldc + col0 + bj * HALF) = w;
                }
                s += __shfl_xor(s, 16); s += __shfl_xor(s, 32);
                if (fq == 0) atomicAdd(ss + row, s);
            }
    }
};
struct EpiDown {
    static constexpr bool PERM = true, AFTER_DRAIN = false;
    bf16_t* xb; int ldc;
    __device__ __forceinline__ void operator()(const f32x4 (&acc)[2][2][4][2], const Unit& u, int wr, int wc, int fr, int fq) const {
        const int row0 = u.pm * BM + wr * 64 + fr, col0 = u.pn * BM + wc * 32 + 8 * fq;
#pragma unroll
        for (int ai = 0; ai < 2; ++ai)
#pragma unroll
            for (int m = 0; m < 4; ++m) {
                bf16_t* rp = xb + (size_t)(row0 + ai * HALF + m * 16) * ldc + col0;
#pragma unroll
                for (int bj = 0; bj < 2; ++bj) {
                    const u32x4 b = *(const u32x4*)(rp + bj * HALF);
                    const f32x4 v0 = acc[ai][bj][m][0], v1 = acc[ai][bj][m][1];
                    u32x4 w;
                    w.x = cvt_pk_bf16(__builtin_bit_cast(float, b.x << 16) + v0[0], __builtin_bit_cast(float, b.x & 0xffff0000u) + v0[1]);
                    w.y = cvt_pk_bf16(__builtin_bit_cast(float, b.y << 16) + v0[2], __builtin_bit_cast(float, b.y & 0xffff0000u) + v0[3]);
                    w.z = cvt_pk_bf16(__builtin_bit_cast(float, b.z << 16) + v1[0], __builtin_bit_cast(float, b.z & 0xffff0000u) + v1[1]);
                    w.w = cvt_pk_bf16(__builtin_bit_cast(float, b.w << 16) + v1[2], __builtin_bit_cast(float, b.w & 0xffff0000u) + v1[3]);
                    *(u32x4*)(rp + bj * HALF) = w;
                }
            }
    }
};
struct EpiGU {
    static constexpr bool PERM = true, AFTER_DRAIN = false;
    bf16_t* H; int ldh; const float* ss; float inv_n, eps;
    __device__ __forceinline__ void operator()(const f32x4 (&acc)[2][2][4][2], const Unit& u, int wr, int wc, int fr, int fq) const {
        const int row0 = u.pm * BM + wr * 64 + fr, col0 = u.pn * HALF + wc * 32 + 8 * fq;
#pragma unroll
        for (int ai = 0; ai < 2; ++ai)
#pragma unroll
            for (int m = 0; m < 4; ++m) {
                const int row = row0 + ai * HALF + m * 16;
                const float rs = __builtin_amdgcn_rsqf(ss[row] * inv_n + eps);
                float h[8];
#pragma unroll
                for (int n = 0; n < 2; ++n)
#pragma unroll
                    for (int j = 0; j < 4; ++j) {
                        const float g = acc[ai][0][m][n][j] * rs, up = acc[ai][1][m][n][j] * rs;
                        const float sg = __builtin_amdgcn_rcpf(1.0f + __expf(-g));
                        h[n * 4 + j] = g * sg * up;
                    }
                u32x4 w; w.x = cvt_pk_bf16(h[0], h[1]); w.y = cvt_pk_bf16(h[2], h[3]); w.z = cvt_pk_bf16(h[4], h[5]); w.w = cvt_pk_bf16(h[6], h[7]);
                *(u32x4*)(H + (size_t)row * ldh + col0) = w;
            }
    }
};

struct EpiSlab {
    static constexpr bool PERM = false, AFTER_DRAIN = false;
    float* slab; const StaticOrder* so_unused; int base, nsl, nN, nM, nwg;
    __device__ __forceinline__ void operator()(const f32x4 (&acc)[2][2][4][2], const Unit& u, int wr, int wc, int fr, int fq) const {
        float* sp = slab + ((size_t)(tail_index(u) * nsl + u.ks) << 16);
        const int r0 = wr * 64 + fr, c0 = wc * 32 + 4 * fq;
#pragma unroll
        for (int ai = 0; ai < 2; ++ai)
#pragma unroll
            for (int m = 0; m < 4; ++m)
#pragma unroll
                for (int bj = 0; bj < 2; ++bj)
#pragma unroll
                    for (int n = 0; n < 2; ++n) *(f32x4*)(sp + (size_t)(r0 + ai * HALF + m * 16) * 256 + c0 + bj * HALF + n * 16) = acc[ai][bj][m][n];
    }
    __device__ __forceinline__ int tail_index(const Unit& u) const {
        StaticOrder so; so.nM = nM; so.nN = nN; so.nwg = nwg; so.G = 0; so.c = 0; so.lim = nwg;
        int t = 0;
        for (int L = base; L < nwg; ++L) { Unit v; so.unit_of(L, v); if (v.pm == u.pm && v.pn == u.pn) t = L - base; }
        return t;
    }
};
template <class Epi, class Sched, bool ALIGN_EPI = false, bool SP2 = false, bool NARROW = false>
__device__ __forceinline__ void gemm_phase(PG8_LAS unsigned char* lds, const Gemm g, const Sched& S, const Epi& E) {
    const int tid = threadIdx.x, wid = __builtin_amdgcn_readfirstlane(tid >> 6), lane = tid & 63, wr = wid >> 2, wc = wid & 3, fr = lane & 15, fq = lane >> 4;
    const int K = g.K, nt = K / BK;
    unsigned voffA[2], voffB[2];
#pragma unroll
    for (int i = 0; i < 2; ++i) { int R, C; stage_rc(tid * 16 + i * 8192, R, C); const int Rb = Epi::PERM ? ((R & ~31) + perm32(R & 31)) : R;
        voffA[i] = (unsigned)(R * g.ld + C) * 2u; voffB[i] = (unsigned)(Rb * g.ld + C) * 2u; }
    const size_t kstep = (size_t)(BK * 2);
    const size_t hstep = (size_t)HALF * g.ld * 2;
    const size_t tstep = 2 * hstep;
    const unsigned ldsw = (unsigned)wid * 1024u;
    const int aoff = lds_byte(wr * 64 + fr, fq * 8), boff = lds_byte(wc * 32 + fr, fq * 8);
#define PG8_SA(b, h) (((b) * 2 + (h)) * HTB)
#define PG8_SB(b, h) ((4 + (b) * 2 + (h)) * HTB)
#define PG8_STAGE(bufoff, gbase, voff) do { _Pragma("unroll") for (int _i = 0; _i < 2; ++_i) \
        __builtin_amdgcn_global_load_lds((const unsigned*)((const char*)(gbase) + (voff)[_i]), (PG8_LAS unsigned*)(lds + (bufoff) + ldsw + _i * 8192), 16, 0, 0); } while (0)
#define PG8_LDA(dst, b, h) do { _Pragma("unroll") for (int m = 0; m < 4; ++m) _Pragma("unroll") for (int k = 0; k < 2; ++k) dst[m][k] = *(const PG8_LAS bf16x8*)(lds + PG8_SA(b, h) + aoff + m * 2048 + k * 1024); } while (0)
#define PG8_LDB(dst, b, h) do { _Pragma("unroll") for (int n = 0; n < 2; ++n) _Pragma("unroll") for (int k = 0; k < 2; ++k) dst[n][k] = *(const PG8_LAS bf16x8*)(lds + PG8_SB(b, h) + boff + n * 2048 + k * 1024); } while (0)
#define PG8_MMA(ai, bj, At, Bt) do { if (NARROW && !((bj) == 0 && wc == 0)) break; __builtin_amdgcn_s_setprio(1); _Pragma("unroll") for (int m = 0; m < 4; ++m) _Pragma("unroll") for (int n = 0; n < 2; ++n) _Pragma("unroll") for (int k = 0; k < 2; ++k) \
        acc[ai][bj][m][n] = __builtin_amdgcn_mfma_f32_16x16x32_bf16(Bt[n][k], At[m][k], acc[ai][bj][m][n], 0, 0, 0); __builtin_amdgcn_s_setprio(0); } while (0)
#define PG8_WAIT_V(n) asm volatile("s_waitcnt vmcnt(" #n ")" ::: "memory")
#define PG8_WAIT_L(n) asm volatile("s_waitcnt lgkmcnt(" #n ")" ::: "memory")
#define PG8_BAR __builtin_amdgcn_s_barrier()
#define PG8_SCHED __builtin_amdgcn_sched_barrier(0)
    Unit cur, nxt; int ui = 0;
    if (!S.next(0, cur)) return;
    f32x4 acc[2][2][4][2];
#pragma unroll
    for (int a = 0; a < 2; ++a)
#pragma unroll
        for (int b = 0; b < 2; ++b)
#pragma unroll
            for (int m = 0; m < 4; ++m)
#pragma unroll
                for (int n = 0; n < 2; ++n) acc[a][b][m][n] = (f32x4){0.f, 0.f, 0.f, 0.f};
    bf16x8 At[4][2], B0[2][2], B1[2][2];
    const size_t sstep = (size_t)K * 2;
    const char* cA = (const char*)g.A + (size_t)cur.pm * tstep + (size_t)cur.ks * sstep; const char* cB = (const char*)g.Bt + (size_t)cur.pn * tstep + (size_t)cur.ks * sstep;
    S.a_ready(cur);
    if constexpr (SP2) {
        PG8_STAGE(PG8_SB(0, 0), cB, voffB); PG8_STAGE(PG8_SB(0, 1), cB + hstep, voffB); PG8_STAGE(PG8_SA(0, 0), cA, voffA); PG8_STAGE(PG8_SA(0, 1), cA + hstep, voffA);
        if (wr == 1) PG8_BAR;
        PG8_WAIT_V(2); PG8_BAR;
        PG8_STAGE(PG8_SB(1, 0), cB + kstep, voffB); PG8_STAGE(PG8_SA(1, 0), cA + kstep, voffA); PG8_STAGE(PG8_SB(1, 1), cB + hstep + kstep, voffB);
        PG8_WAIT_V(6); PG8_BAR;
    } else {
        PG8_STAGE(PG8_SB(0, 0), cB, voffB); PG8_STAGE(PG8_SA(0, 0), cA, voffA); PG8_STAGE(PG8_SB(0, 1), cB + hstep, voffB); PG8_STAGE(PG8_SA(0, 1), cA + hstep, voffA);
        if (wr == 1) PG8_BAR;
        PG8_WAIT_V(4); PG8_BAR;
        PG8_STAGE(PG8_SB(1, 0), cB + kstep, voffB); PG8_STAGE(PG8_SA(1, 0), cA + kstep, voffA); PG8_STAGE(PG8_SB(1, 1), cB + hstep + kstep, voffB);
        PG8_WAIT_V(6); PG8_BAR;
    }
    for (;;) {
        const bool has_next = S.next(ui + 1, nxt);
        const char* nA = has_next ? (const char*)g.A + (size_t)nxt.pm * tstep + (size_t)nxt.ks * sstep : cA; const char* nB = has_next ? (const char*)g.Bt + (size_t)nxt.pn * tstep + (size_t)nxt.ks * sstep : cB;
        for (int t = 0; t < nt; t += 2) {
            const bool last = (t == nt - 2);
            const char* a1 = cA + (size_t)(t + 1) * kstep;
            const char* a2 = last ? nA : cA + (size_t)(t + 2) * kstep; const char* b2 = last ? nB : cB + (size_t)(t + 2) * kstep;
            const char* a3 = a2 + kstep; const char* b3 = b2 + kstep;
            if (last && has_next) S.a_ready(nxt);
            if constexpr (SP2) {
            PG8_LDB(B0, 0, 0); PG8_LDB(B1, 0, 1); PG8_SCHED; PG8_LDA(At, 0, 0); PG8_STAGE(PG8_SA(1, 1), a1 + hstep, voffA);
            PG8_WAIT_V(8); PG8_WAIT_L(0); PG8_BAR; PG8_MMA(0, 0, At, B0); PG8_MMA(0, 1, At, B1); PG8_BAR; PG8_SCHED;
            PG8_LDA(At, 0, 1); PG8_STAGE(PG8_SB(0, 0), b2, voffB); PG8_STAGE(PG8_SB(0, 1), b2 + hstep, voffB); PG8_STAGE(PG8_SA(0, 0), a2, voffA);
            PG8_WAIT_V(8); PG8_WAIT_L(0); PG8_BAR; PG8_MMA(1, 0, At, B0); PG8_MMA(1, 1, At, B1); PG8_BAR; PG8_SCHED;
            PG8_LDB(B0, 1, 0); PG8_LDB(B1, 1, 1); PG8_SCHED; PG8_LDA(At, 1, 0); PG8_STAGE(PG8_SA(0, 1), a2 + hstep, voffA);
            PG8_WAIT_V(8); PG8_WAIT_L(0); PG8_BAR; PG8_MMA(0, 0, At, B0); PG8_MMA(0, 1, At, B1); PG8_BAR; PG8_SCHED;
            PG8_LDA(At, 1, 1); PG8_STAGE(PG8_SB(1, 0), b3, voffB); PG8_STAGE(PG8_SB(1, 1), b3 + hstep, voffB); PG8_STAGE(PG8_SA(1, 0), a3, voffA);
            PG8_WAIT_V(8); PG8_WAIT_L(0); PG8_BAR; PG8_MMA(1, 0, At, B0); PG8_MMA(1, 1, At, B1); PG8_BAR; PG8_SCHED;
            } else {
            PG8_LDB(B0, 0, 0); PG8_SCHED; PG8_LDA(At, 0, 0); PG8_STAGE(PG8_SA(1, 1), a1 + hstep, voffA);
            PG8_WAIT_L(8); PG8_BAR; PG8_WAIT_L(0); PG8_MMA(0, 0, At, B0); PG8_BAR; PG8_SCHED;
            PG8_LDB(B1, 0, 1); PG8_STAGE(PG8_SB(0, 0), b2, voffB);
            PG8_BAR; PG8_WAIT_L(0); PG8_MMA(0, 1, At, B1); PG8_BAR;
            PG8_LDA(At, 0, 1); PG8_STAGE(PG8_SA(0, 0), a2, voffA);
            PG8_BAR; PG8_WAIT_L(0); PG8_MMA(1, 0, At, B0); PG8_BAR; PG8_SCHED;
            PG8_STAGE(PG8_SB(0, 1), b2 + hstep, voffB);
            PG8_WAIT_V(6); PG8_BAR; PG8_MMA(1, 1, At, B1); PG8_BAR;
            PG8_LDB(B0, 1, 0); PG8_SCHED; PG8_LDA(At, 1, 0); PG8_STAGE(PG8_SA(0, 1), a2 + hstep, voffA);
            PG8_WAIT_L(8); PG8_BAR; PG8_WAIT_L(0); PG8_MMA(0, 0, At, B0); PG8_BAR; PG8_SCHED;
            PG8_LDB(B1, 1, 1); PG8_STAGE(PG8_SB(1, 0), b3, voffB);
            PG8_BAR; PG8_WAIT_L(0); PG8_MMA(0, 1, At, B1); PG8_BAR;
            PG8_LDA(At, 1, 1); PG8_STAGE(PG8_SA(1, 0), a3, voffA);
            PG8_BAR; PG8_WAIT_L(0); PG8_MMA(1, 0, At, B0); PG8_BAR; PG8_SCHED;
            PG8_STAGE(PG8_SB(1, 1), b3 + hstep, voffB);
            PG8_WAIT_V(6); PG8_BAR; PG8_MMA(1, 1, At, B1); PG8_BAR;
            }
        }
        if constexpr (ALIGN_EPI) { if (wr == 0) PG8_BAR; }
        if constexpr (!Epi::AFTER_DRAIN) { E(acc, cur, wr, wc, fr, fq); S.done(cur); }
        if (!has_next) break;
#pragma unroll
        for (int a = 0; a < 2; ++a)
#pragma unroll
            for (int b = 0; b < 2; ++b)
#pragma unroll
                for (int m = 0; m < 4; ++m)
#pragma unroll
                    for (int n = 0; n < 2; ++n) acc[a][b][m][n] = (f32x4){0.f, 0.f, 0.f, 0.f};
        cur = nxt; cA = nA; cB = nB; ++ui;
        if constexpr (ALIGN_EPI) { if (wr == 1) PG8_BAR; }
    }
    PG8_WAIT_V(0);
    if constexpr (!ALIGN_EPI) { if (wr == 0) PG8_BAR; }
    PG8_BAR;
    if constexpr (Epi::AFTER_DRAIN) { E.fused(acc, cur, wr, wc, fr, fq, lds, wid, lane); S.done(cur); }
#undef PG8_SA
#undef PG8_SB
#undef PG8_STAGE
#undef PG8_LDA
#undef PG8_LDB
#undef PG8_MMA
#undef PG8_WAIT_V
#undef PG8_WAIT_L
#undef PG8_BAR
#undef PG8_SCHED
}
}

constexpr int NWAVES = 8;
constexpr int DM = 2048, TP = 16384, NB = 128, TS = 4, MS = NB * TS, M = TP + MS;
constexpr int HD = 64, NH = 16, CW = 1024;
constexpr int RCOLS = 3360, INC = 4896, PPITCH = 5120;
constexpr int C_R = 0, C_K = 1024, C_V = 2048, C_XW = 3072, C_XA = 3136, C_XG = 3200, C_Q = 3360, C_SK = 4384, C_SV = 4640;
constexpr int KVH = 4, WIN = 128, KVW = KVH * HD;
constexpr int DFF = 5632;
constexpr float RMS_EPS = 1e-5f, GN_EPS = 64e-5f;
constexpr size_t O_YP = 0, O_YS = 33554432, O_PST = 34603008, O_PSH = 34668544, O_PCK = 34671904, O_PCV = 34704672,
                 O_SST = 34737440, O_SSH = 43126048, O_SCK = 43556128, O_SCV = 47750432, O_END = 51944736;
constexpr size_t MiB = 1u << 20;
constexpr size_t WS_CTL = 0, CTL_ZERO_BYTES = 64 * 1024;
constexpr size_t WS_SS1 = 1 * MiB, WS_SS2 = 1 * MiB + 128 * 1024;
constexpr size_t WS_W2T = 2 * MiB, WS_A2T = 2 * MiB + 128 * 1024, WS_G2T = 2 * MiB + 256 * 1024;
constexpr size_t WS_WIN = 4 * MiB, WS_WOUT = 24 * MiB, WS_WGU = 32 * MiB, WS_WDN = 76 * MiB;
constexpr size_t WS_XN = 98 * MiB, WS_MIX = 164 * MiB, WS_P = 230 * MiB, WS_H = 230 * MiB, WS_SEG = 412 * MiB, WS_SST = 420 * MiB, WS_TL = 424 * MiB, WS_END = 640 * MiB;
constexpr size_t TL_REC = 41472;
static_assert(WS_TL + (size_t)16 * 256 * TL_REC <= WS_END, "ws map (operand records)");
static_assert(WS_WIN + (size_t)PPITCH * DM * 2 <= WS_WOUT && WS_WOUT + (size_t)DM * DM * 2 <= WS_WGU && WS_WGU + (size_t)2 * DFF * DM * 2 <= WS_WDN && WS_WDN + (size_t)DM * DFF * 2 <= WS_XN, "ws map (weights)");
static_assert(WS_XN + (size_t)M * DM * 2 <= WS_MIX && WS_MIX + (size_t)M * DM * 2 <= WS_P && WS_P + (size_t)M * PPITCH * 2 <= WS_SEG && WS_H + (size_t)M * DFF * 2 <= WS_SEG, "ws map (activations)");
constexpr int CW_BAR = 4096, CW_OUTTAIL = 2048;
constexpr int NGIN = 4864;
constexpr int GDN_FULL = 512, GDN_NSL = 11;
constexpr size_t WS_SLAB = 592 * MiB;
static_assert(DFF % (GDN_NSL * 128) == 0, "slab map");
constexpr int RING_BYTES = 131072, LDS_BYTES = 163840, MISC_OFF = LDS_BYTES - 256;

#define GAS __attribute__((address_space(1)))
#define LAS __attribute__((address_space(3)))
typedef unsigned short bf16;
typedef unsigned v4u __attribute__((ext_vector_type(4)));
typedef float f32x4 __attribute__((ext_vector_type(4)));
typedef short bf16x8 __attribute__((ext_vector_type(8)));
#define LDS_WAIT() asm volatile("s_waitcnt lgkmcnt(0)" ::: "memory")
#define VM_WAIT() asm volatile("s_waitcnt vmcnt(0)" ::: "memory")
__device__ __forceinline__ unsigned f2bf(float f) { unsigned u = __builtin_bit_cast(unsigned, f); return (u + 0x7fffu + ((u >> 16) & 1u)) >> 16; }
__device__ __forceinline__ unsigned pk2(float lo, float hi) { return pg8::cvt_pk_bf16(lo, hi); }
__device__ __forceinline__ float bf2f(unsigned short b) { return __builtin_bit_cast(float, (unsigned)b << 16); }
__device__ __forceinline__ float bflo(unsigned w) { return __builtin_bit_cast(float, w << 16); }
__device__ __forceinline__ float bfhi(unsigned w) { return __builtin_bit_cast(float, w & 0xffff0000u); }
__device__ __forceinline__ float sigmoidf_(float x) { return 1.0f / (1.0f + __expf(-x)); }
__device__ __forceinline__ float wave_sum(float v) {
#pragma unroll
    for (int o = 1; o < 64; o <<= 1) v += __shfl_xor(v, o);
    return v;
}
__device__ __forceinline__ float wave_max(float v) {
#pragma unroll
    for (int o = 1; o < 64; o <<= 1) v = fmaxf(v, __shfl_xor(v, o));
    return v;
}

#define XB_TMO      128
#define XB_XCNT(j)  (256  + 64 * (j))
#define XB_XSUB(j)  (1280 + 64 * (j))
#define XB_XGEN(j)  (2304 + 64 * (j))
#define XB_TOP      3328
#define XB_TOPGEN   3392
#define XCD_BAR_WORDS 3456
#define XB_SPIN_CAP (1u << 18)
__device__ __forceinline__ unsigned xb_ld(unsigned* p)              { return __hip_atomic_load(p, __ATOMIC_RELAXED, __HIP_MEMORY_SCOPE_AGENT); }
__device__ __forceinline__ unsigned xb_add(unsigned* p, unsigned v) { return __hip_atomic_fetch_add(p, v, __ATOMIC_RELAXED, __HIP_MEMORY_SCOPE_AGENT); }
__device__ __forceinline__ unsigned xb_xcc_id() { return (unsigned)__builtin_amdgcn_s_getreg((3 << 11) | 20) & 0xFu; }
#define XB_SPIN(cond, bar) do { unsigned _sp = 0; while (cond) { __builtin_amdgcn_s_sleep(1); \
    if ((++_sp & 255u) == 0u) { if (xb_ld(&(bar)[XB_TMO])) break; if (_sp > XB_SPIN_CAP) { atomicAdd(&(bar)[XB_TMO], 1u); break; } } } } while (0)
struct XcdBarrier { unsigned* bar; unsigned x; volatile LAS unsigned* st; };
__device__ __forceinline__ XcdBarrier xcd_barrier_post(unsigned* bar, volatile LAS unsigned* st) {
    XcdBarrier b; b.bar = bar; b.x = xb_xcc_id(); b.st = st;
    if (threadIdx.x == 0) (void)xb_add(&bar[XB_XCNT(b.x)], 1u);
    return b;
}
__device__ __forceinline__ void xcd_barrier_complete(unsigned* bar, unsigned x, unsigned& nloc, unsigned& nx) {
    const unsigned G = gridDim.x * gridDim.y * gridDim.z;
    unsigned sum, cnt, mine, sp = 0u;
    for (;;) {
        sum = 0u; cnt = 0u; mine = 0u;
#pragma unroll
        for (unsigned j = 0; j < 16; ++j) { const unsigned c = xb_ld(&bar[XB_XCNT(j)]); sum += c; cnt += (c > 0u) ? 1u : 0u; mine = (j == x) ? c : mine; }
        if (sum == G) break;
        __builtin_amdgcn_s_sleep(1);
        if ((++sp & 255u) == 0u) { if (xb_ld(&bar[XB_TMO])) break; if (sp > XB_SPIN_CAP) { atomicAdd(&bar[XB_TMO], 1u); break; } }
    }
    nloc = mine > 0u ? mine : 1u; nx = cnt > 0u ? cnt : 1u;
}
__device__ __forceinline__ void xcd_barrier(const XcdBarrier& b) {
    asm volatile("s_waitcnt vmcnt(0)" ::: "memory");
    __syncthreads();
    if (threadIdx.x == 0) {
        unsigned* bar = b.bar;
        __builtin_amdgcn_s_waitcnt(0);
        unsigned nloc = b.st[0], nx = b.st[1];
        if (nloc == 0u) { xcd_barrier_complete(bar, b.x, nloc, nx); b.st[0] = nloc; b.st[1] = nx; }
        const unsigned old = xb_add(&bar[XB_XSUB(b.x)], 1u);
        const unsigned gen = old / nloc;
        if (old + 1u == (gen + 1u) * nloc) {
            __builtin_amdgcn_fence(__ATOMIC_RELEASE, "agent");
            asm volatile("s_waitcnt vmcnt(0)" ::: "memory");
            const unsigned og = xb_add(&bar[XB_TOP], 1u);
            const unsigned tg = og / nx;
            if (og + 1u == (tg + 1u) * nx) xb_add(&bar[XB_TOPGEN], 1u);
            else XB_SPIN(xb_ld(&bar[XB_TOPGEN]) == tg, bar);
            __builtin_amdgcn_fence(__ATOMIC_ACQUIRE, "agent");
            xb_add(&bar[XB_XGEN(b.x)], 1u);
            asm volatile("s_waitcnt vmcnt(0)" ::: "memory");
        } else {
            XB_SPIN(xb_ld(&bar[XB_XGEN(b.x)]) == gen, bar);
            __builtin_amdgcn_fence(__ATOMIC_ACQUIRE, "agent");
            asm volatile("s_waitcnt vmcnt(0)" ::: "memory");
        }
    }
    __syncthreads();
}

struct Args { const float* in[26]; float* out; unsigned char* ws; int ph_lo, ph_hi; };
enum { I_XP = 0, I_XS, I_STATE, I_SHIFT, I_CK, I_CV, I_NATT, I_WIN, I_MU, I_W0, I_W2, I_A0, I_A2, I_G2, I_KK, I_KA, I_RK, I_LNW, I_LNB, I_SINK, I_WOUT, I_NFFN, I_WG, I_WU, I_WD, I_NFIN };

__device__ __forceinline__ void p0_transpose_item(const float* W, int N, bf16* WT, int ldk, int k0, int n0, int row0, int ncols, const float* ksc, LAS float* scr, int lane) {
    const int n4 = lane & 15, kl = lane >> 4;
    f32x4 v[16];
#pragma unroll
    for (int i = 0; i < 16; ++i) { v[i] = (f32x4){0.f, 0.f, 0.f, 0.f}; if (4 * n4 < ncols) v[i] = *(const f32x4*)(W + (size_t)(k0 + 4 * i + kl) * N + n0 + 4 * n4); }
#pragma unroll
    for (int i = 0; i < 16; ++i) { const int k = 4 * i + kl; const float sc = ksc ? ksc[k0 + k] : 1.0f; LAS float* d = scr + k * 65 + 4 * n4;
        d[0] = v[i].x * sc; d[1] = v[i].y * sc; d[2] = v[i].z * sc; d[3] = v[i].w * sc; }
    LDS_WAIT(); asm volatile("" ::: "memory");
    const int c = lane & 7;
#pragma unroll
    for (int j = 0; j < 8; ++j) { const int n = (lane >> 3) + 8 * j; const LAS float* s = scr + (8 * c) * 65 + n;
        v4u o; o.x = pk2(s[0 * 65], s[1 * 65]); o.y = pk2(s[2 * 65], s[3 * 65]); o.z = pk2(s[4 * 65], s[5 * 65]); o.w = pk2(s[6 * 65], s[7 * 65]);
        if (n < ncols) *(GAS v4u*)(WT + (size_t)(row0 + n) * ldk + k0 + 8 * c) = o; }
    LDS_WAIT(); asm volatile("" ::: "memory");
}
__device__ __forceinline__ void convert_late_weights(const Args& a, LAS unsigned char* lds, int gw, int NGW, int wave, int lane, int part) {
    unsigned char* ws = a.ws;
    LAS float* scr = (LAS float*)(lds + wave * 16640);
    constexpr int I_OUT = (DM / 64) * (DM / 64), I_GU = (DM / 64) * (DFF / 64), I_DN = (DFF / 64) * (DM / 64);
    bf16* Wout = (bf16*)(ws + WS_WOUT); bf16* Wgu = (bf16*)(ws + WS_WGU); bf16* Wdn = (bf16*)(ws + WS_WDN);
    const int lo = part == 1 ? I_OUT + 2 * I_GU : 0, hi = part == 0 ? I_OUT + 2 * I_GU : I_OUT + 2 * I_GU + I_DN;
    for (int it = lo + gw; it < hi; it += NGW) {
        int r = it;
        if (r < I_OUT) { const int nblk = DM / 64, kb = r / nblk, nb = r % nblk; p0_transpose_item(a.in[I_WOUT], DM, Wout, DM, 64 * kb, 64 * nb, 64 * nb, 64, nullptr, scr, lane); continue; } r -= I_OUT;
        if (r < 2 * I_GU) { const int s = r / I_GU; r -= s * I_GU; const int nblk = DFF / 64, kb = r / nblk, nb = r % nblk, f0 = 64 * nb;
            p0_transpose_item(a.in[s ? I_WU : I_WG], DFF, Wgu, DM, 64 * kb, f0, 256 * (f0 >> 7) + 128 * s + (f0 & 127), 64, a.in[I_NFFN], scr, lane); continue; } r -= 2 * I_GU;
        { const int nblk = DM / 64, kb = r / nblk, nb = r % nblk; p0_transpose_item(a.in[I_WD], DM, Wdn, DFF, 64 * kb, 64 * nb, 64 * nb, 64, nullptr, scr, lane); }
    }
}
__device__ __forceinline__ void rms_row_to_bf16(const float* xrow, const float* g, bf16* orow, int lane) {
    const GAS f32x4* xr = (const GAS f32x4*)xrow + lane;
    f32x4 v[8]; float s = 0.f;
#pragma unroll
    for (int j = 0; j < 8; ++j) { v[j] = xr[64 * j]; s += (v[j].x * v[j].x + v[j].y * v[j].y) + (v[j].z * v[j].z + v[j].w * v[j].w); }
    const float rs = 1.0f / sqrtf(wave_sum(s) * (1.f / DM) + RMS_EPS);
    GAS unsigned long long* o8 = (GAS unsigned long long*)orow + lane;
#pragma unroll
    for (int j = 0; j < 8; ++j) { const f32x4 gg = *((const f32x4*)g + lane + 64 * j);
        o8[64 * j] = (unsigned long long)pk2(v[j].x * rs * gg.x, v[j].y * rs * gg.y) | ((unsigned long long)pk2(v[j].z * rs * gg.z, v[j].w * rs * gg.w) << 32); }
}

__device__ __forceinline__ void p0_prologue(const Args& a, LAS unsigned char* lds, int vcu, int G, int wave, int lane) {
    unsigned char* ws = a.ws;
    LAS float* scr = (LAS float*)(lds + wave * 16640);
    const int gw = vcu * NWAVES + wave, NGW = G * NWAVES;
    constexpr int NBI = (INC + 63) / 64, I_IN = (DM / 64) * NBI;
    bf16* Win = (bf16*)(ws + WS_WIN);
    for (int it = gw; it < I_IN; it += NGW) { const int kb = it / NBI, nb = it % NBI; p0_transpose_item(a.in[I_WIN], INC, Win, DM, 64 * kb, 64 * nb, 64 * nb, (INC - 64 * nb) < 64 ? (INC - 64 * nb) : 64, nullptr, scr, lane); }
#if !LATE_WEIGHTS
    convert_late_weights(a, lds, gw, NGW, wave, lane, 2);
#endif
    { GAS v4u* z = (GAS v4u*)(Win + (size_t)INC * DM); const int n16 = (PPITCH - INC) * DM * 2 / 16;
      for (int i = gw * 64 + lane; i < n16; i += NGW * 64) z[i] = (v4u){0u, 0u, 0u, 0u}; }
    { float* s1 = (float*)(ws + WS_SS1); float* s2 = (float*)(ws + WS_SS2);
      for (int i = gw * 64 + lane; i < M; i += NGW * 64) { s1[i] = 0.f; s2[i] = 0.f; } }
    { bf16* w2t = (bf16*)(ws + WS_W2T); bf16* a2t = (bf16*)(ws + WS_A2T); bf16* g2t = (bf16*)(ws + WS_G2T);
      for (int i = gw * 64 + lane; i < CW * 64; i += NGW * 64) { const int c = i >> 6, k = i & 63; w2t[i] = (bf16)f2bf(a.in[I_W2][(size_t)k * CW + c]); a2t[i] = (bf16)f2bf(a.in[I_A2][(size_t)k * CW + c]); }
      for (int i = gw * 64 + lane; i < CW * 160; i += NGW * 64) { const int c = i / 160, k = i % 160; g2t[i] = (bf16)f2bf(a.in[I_G2][(size_t)k * CW + c]); } }
    bf16* XN = (bf16*)(ws + WS_XN);
    for (int m = gw; m < M; m += NGW) {
        const float* xr = m < TP ? a.in[I_XP] + (size_t)m * DM : a.in[I_XS] + (size_t)(m - TP) * DM;
        rms_row_to_bf16(xr, a.in[I_NATT], XN + (size_t)m * DM, lane);
    }
}

__device__ __forceinline__ void final_norm(const Args& a, int vcu, int G, int wave, int lane) {
    const int gw = vcu * NWAVES + wave, NGW = G * NWAVES;
    const f32x4* gf = (const f32x4*)a.in[I_NFIN];
    const float* slab = (const float*)(a.ws + WS_SLAB);
    const bf16* XB = (const bf16*)(a.ws + WS_XN);
    pg8::StaticOrder so; so.init(M, DM, G, 0);
    for (int m = gw; m < M; m += NGW) {
        const pg8::u32x2* xr = (const pg8::u32x2*)(XB + (size_t)m * DM) + lane;
        f32x4 v[8];
#pragma unroll
        for (int j = 0; j < 8; ++j) { const pg8::u32x2 w = xr[64 * j]; v[j] = (f32x4){bflo(w.x), bfhi(w.x), bflo(w.y), bfhi(w.y)}; }
        const int pm = m >> 8, rl = m & 255;
        for (int t = 0; t < so.nwg - GDN_FULL; ++t) {
            pg8::Unit u; so.unit_of(GDN_FULL + t, u);
            if (u.pm == pm) {
                f32x4 s = {0.f, 0.f, 0.f, 0.f};
                for (int ks = 0; ks < GDN_NSL; ++ks) s += *(const f32x4*)(slab + ((size_t)(t * GDN_NSL + ks) << 16) + (size_t)rl * 256 + 4 * lane);
#pragma unroll
                for (int j = 0; j < 8; ++j) if (j == u.pn) v[j] += s;
            }
        }
        float ss = 0.f;
#pragma unroll
        for (int j = 0; j < 8; ++j) ss += (v[j].x * v[j].x + v[j].y * v[j].y) + (v[j].z * v[j].z + v[j].w * v[j].w);
        const float rs = 1.0f / sqrtf(wave_sum(ss) * (1.f / DM) + RMS_EPS);
        GAS f32x4* yr = (GAS f32x4*)(a.out + (size_t)m * DM) + lane;
#pragma unroll
        for (int j = 0; j < 8; ++j) { const f32x4 g = gf[lane + 64 * j]; yr[64 * j] = v[j] * rs * g; }
    }
}

namespace rw {
constexpr int SEGS = 16, SEGLEN = TP / SEGS, BLK = 64, NBLK = SEGLEN / BLK;
constexpr int T_R = 0, T_W = 16384, T_K = 32768, T_V = 49152, T_NKK = 65536, T_B = 81920, T_G = 98304, T_OUT = 114688;
constexpr int TWP = 72, SGP = 168;
constexpr int ST_TW = 114688, ST_XA = ST_TW + 64 * TWP * 2, ST_SG = ST_XA + 64 * TWP * 2, T_BONUS = ST_SG + 64 * SGP * 2, T_END = T_BONUS + 256;
constexpr int T_UO = 114688;
constexpr int T_TOT = 147456;
constexpr int T_ULOC = 131072, T_PSEQ = T_NKK, T_UF = T_W, T_GL = T_BONUS + 256, T_S0 = T_GL + 256, T_SST = T_B;
static_assert(T_S0 + 8192 <= 163840 - 256 && T_TOT + 2048 <= ST_SG + 64 * SGP * 2 && T_ULOC + 16384 <= T_TOT, "rwkv LDS map (L3)");
constexpr int SL_OFF = 0, SLP = 68, PM_OFF = 32768;
static_assert(T_END <= 163840 - 512, "rwkv LDS map");

__device__ __forceinline__ float dpp_add(float x, const int ctrl_sel) {
    int y;
    switch (ctrl_sel) {
        case 0: y = __builtin_amdgcn_update_dpp(0, __builtin_bit_cast(int, x), 0xB1, 0xF, 0xF, true); break;
        case 1: y = __builtin_amdgcn_update_dpp(0, __builtin_bit_cast(int, x), 0x4E, 0xF, 0xF, true); break;
        case 2: y = __builtin_amdgcn_update_dpp(0, __builtin_bit_cast(int, x), 0x141, 0xF, 0xF, true); break;
        default: y = __builtin_amdgcn_update_dpp(0, __builtin_bit_cast(int, x), 0x140, 0xF, 0xF, true); break;
    }
    return x + __builtin_bit_cast(float, y);
}
__device__ __forceinline__ float allreduce16(float x) { x = dpp_add(x, 0); x = dpp_add(x, 1); x = dpp_add(x, 2); x = dpp_add(x, 3); return x; }
__device__ __forceinline__ float allreduce8(float x) { x = dpp_add(x, 0); x = dpp_add(x, 1); x = dpp_add(x, 2); return x; }
__device__ __forceinline__ float dot4(const f32x4 a, const f32x4 b) { return (a.x * b.x + a.y * b.y) + (a.z * b.z + a.w * b.w); }
__device__ __forceinline__ void ld8bf(const bf16* p, float (&o)[8]) { const v4u w = *(const v4u*)p; o[0] = bflo(w.x); o[1] = bfhi(w.x); o[2] = bflo(w.y); o[3] = bfhi(w.y); o[4] = bflo(w.z); o[5] = bfhi(w.z); o[6] = bflo(w.w); o[7] = bfhi(w.w); }
__device__ __forceinline__ void ld8f(const float* p, float (&o)[8]) { const f32x4 a = *(const f32x4*)p, b = *(const f32x4*)(p + 4); o[0] = a.x; o[1] = a.y; o[2] = a.z; o[3] = a.w; o[4] = b.x; o[5] = b.y; o[6] = b.z; o[7] = b.w; }
__device__ __forceinline__ float fast_tanh(float x) { return 1.0f - 2.0f * __builtin_amdgcn_rcpf(1.0f + __expf(2.0f * x)); }
__device__ __forceinline__ float fast_sigmoid(float x) { return __builtin_amdgcn_rcpf(1.0f + __expf(-x)); }

struct SlotSrc { const bf16* cur; const bf16* prevb; const float* prevf; };

__device__ __forceinline__ void shift8(const SlotSrc& s, const float* mu, int col, float (&xs)[8]) {
    float x[8], p[8], m[8];
    ld8bf(s.cur + col, x); ld8f(mu + col, m);
    if (s.prevb) ld8bf(s.prevb + col, p);
    else if (s.prevf) ld8f(s.prevf + col, p);
    else {
#pragma unroll
        for (int j = 0; j < 8; ++j) p[j] = 0.f; }
#pragma unroll
    for (int j = 0; j < 8; ++j) xs[j] = x[j] + m[j] * (p[j] - x[j]);
}
__device__ __forceinline__ void st8(LAS unsigned char* lds, int off, const float (&v)[8]) {
    *(LAS f32x4*)(lds + off) = (f32x4){v[0], v[1], v[2], v[3]}; *(LAS f32x4*)(lds + off + 16) = (f32x4){v[4], v[5], v[6], v[7]};
}
__device__ __forceinline__ void ld8l(LAS unsigned char* lds, int off, float (&v)[8]) {
    const f32x4 a = *(LAS f32x4*)(lds + off), b = *(LAS f32x4*)(lds + off + 16); v[0] = a.x; v[1] = a.y; v[2] = a.z; v[3] = a.w; v[4] = b.x; v[5] = b.y; v[6] = b.z; v[7] = b.w;
}

struct PrepRegs { v4u cur[8], prv[8]; };
template <bool FULL, class SrcFn>
__device__ __forceinline__ void prep_issue(int h, const SrcFn& srcfn, int tid, PrepRegs& R) {
    const int slot = tid >> 3, part = tid & 7, c8 = h * HD + part * 8;
    const SlotSrc s = srcfn(slot);
#pragma unroll
    for (int q = 0; q < 8; ++q) {
        const int col = q == 0 ? C_R + c8 : q == 1 ? C_K + c8 : q == 2 ? C_V + c8 : C_XW + 8 * (part + 8 * (q - 3));
        const bool on = q == 0 ? FULL : q < 3 ? true : (part + 8 * (q - 3)) < (FULL ? 36 : 16);
        R.cur[q] = (v4u){0u, 0u, 0u, 0u}; R.prv[q] = (v4u){0u, 0u, 0u, 0u};
        if (on) { R.cur[q] = *(const v4u*)(s.cur + col); if (s.prevb) R.prv[q] = *(const v4u*)(s.prevb + col);
            else if (s.prevf) { const f32x4 p0 = *(const f32x4*)(s.prevf + col), p1 = *(const f32x4*)(s.prevf + col + 4);
                R.prv[q] = (v4u){pg8::cvt_pk_bf16(p0[0], p0[1]), pg8::cvt_pk_bf16(p0[2], p0[3]), pg8::cvt_pk_bf16(p1[0], p1[1]), pg8::cvt_pk_bf16(p1[2], p1[3])}; } }
    }
}
constexpr int L_XO = 16384, L_XR = 69632;
constexpr int T_TOT2 = 11264;
constexpr int L_ABF = 0, L_DINV = 9216, L_BBF = 32768, L_KBF = 41984, L_VBF = 51200, L_RBF = 60416, L_PCT = 83968, L_NL = 93184, L_ML = 102400, L_RB = 111616, L_RK = 120832, L_ND = 130048, L_XROW = 134144, L_XP = 272;
constexpr int T_CMU = T_S0, T_CKK = T_CMU + 2048, T_CKA = T_CKK + 256, T_CRK = T_CKA + 256, T_CW0 = T_CRK + 256, T_CA0 = T_CW0 + 256;
__device__ __forceinline__ void prep_consts_fill(const Args& a, LAS unsigned char* lds, int h, int tid) {
    { const int q = tid >> 6, part = (tid >> 3) & 7, e = tid & 7;
      const int col = q == 0 ? C_R + h * HD + part * 8 : q == 1 ? C_K + h * HD + part * 8 : q == 2 ? C_V + h * HD + part * 8 : C_XW + 8 * (part + 8 * (q - 3));
      const bool on = q < 3 ? true : (part + 8 * (q - 3)) < 36;
      *(LAS float*)(lds + T_CMU + tid * 4) = on ? a.in[I_MU][col + e] : 0.f; }
    if (tid < 320) { const int arr = tid >> 6, ch = tid & 63; const int idx = arr == 0 ? I_KK : arr == 1 ? I_KA : arr == 2 ? I_RK : arr == 3 ? I_W0 : I_A0;
      *(LAS float*)(lds + T_CKK + tid * 4) = a.in[idx][h * HD + ch]; }
}
struct LoraFrags { bf16x8 bw[2], ba[2], bg[5]; };
template <bool FULL>
__device__ __forceinline__ void lora_frags_load(const Args& a, int h, int tid, LoraFrags& F) {
    const int lane = tid & 63, wave = tid >> 6, fr = lane & 15, fq = lane >> 4, ct = wave & 3;
    const bf16* w2t = (const bf16*)(a.ws + WS_W2T); const bf16* a2t = (const bf16*)(a.ws + WS_A2T); const bf16* g2t = (const bf16*)(a.ws + WS_G2T);
    const int c = h * HD + 16 * ct + fr;
#pragma unroll
    for (int ks = 0; ks < 2; ++ks) { F.bw[ks] = *(const bf16x8*)(w2t + (size_t)c * 64 + ks * 32 + 8 * fq); F.ba[ks] = *(const bf16x8*)(a2t + (size_t)c * 64 + ks * 32 + 8 * fq); }
    if (FULL) {
#pragma unroll
        for (int ks = 0; ks < 5; ++ks) F.bg[ks] = *(const bf16x8*)(g2t + (size_t)c * 160 + ks * 32 + 8 * fq); }
}
template <bool FULL, bool PREVF, int RP, bool PRE, bool STORE, bool HOISTF, bool L1M, class SrcFn>
__device__ __forceinline__ void prep_block(const Args& a, LAS unsigned char* lds, int h, const SrcFn& srcfn, int tid, const PrepRegs& R, unsigned char* rec, LoraFrags& F) {
    const int lane = tid & 63, wave = __builtin_amdgcn_readfirstlane(tid >> 6);
    const float* mu = a.in[I_MU];
    const int fr = lane & 15, fq = lane >> 4;
    float keep_r[8], keep_k[8], keep_kk[8], keep_v[8];
    {
        const int slot = tid >> 3, part = tid & 7, ch8 = part * 8, c8 = h * HD + ch8;
        const SlotSrc s = srcfn(slot);
        constexpr int NV = 8;
        int col[NV]; bool on[NV];
        col[0] = C_R + c8; on[0] = FULL; col[1] = C_K + c8; on[1] = true; col[2] = C_V + c8; on[2] = true;
#pragma unroll
        for (int q = 0; q < 5; ++q) { const int ci = part + 8 * q; col[3 + q] = C_XW + 8 * ci; on[3 + q] = ci < (FULL ? 36 : 16); }
        float kkc[8]; if (HOISTF) ld8l(lds, T_CKK + ch8 * 4, kkc); else ld8f(a.in[I_KK] + c8, kkc);
        const int toff = slot * 256 + ch8 * 4;
        constexpr int GS = PREVF ? 2 : 4;
#pragma unroll
        for (int g0 = 0; g0 < NV; g0 += GS) {
            v4u cur[GS], prv[GS]; f32x4 pf[GS][2], mv[GS][2];
#pragma unroll
            for (int qq = 0; qq < GS; ++qq) { const int q = g0 + qq; if (on[q]) { if (PRE) cur[qq] = R.cur[q]; else cur[qq] = *(const v4u*)(s.cur + col[q]); } }
#pragma unroll
            for (int qq = 0; qq < GS; ++qq) { const int q = g0 + qq; if (on[q]) {
                prv[qq] = (v4u){0u, 0u, 0u, 0u};
                if (PRE) prv[qq] = R.prv[q]; else if (s.prevb) prv[qq] = *(const v4u*)(s.prevb + col[q]);
                if (PREVF) { if (s.prevf) { pf[qq][0] = *(const f32x4*)(s.prevf + col[q]); pf[qq][1] = *(const f32x4*)(s.prevf + col[q] + 4); } }
            } }
#pragma unroll
            for (int qq = 0; qq < GS; ++qq) { const int q = g0 + qq; if (on[q]) {
                if (HOISTF) { mv[qq][0] = *(LAS f32x4*)(lds + T_CMU + (q * 8 + part) * 32); mv[qq][1] = *(LAS f32x4*)(lds + T_CMU + (q * 8 + part) * 32 + 16); }
                else { mv[qq][0] = *(const f32x4*)(mu + col[q]); mv[qq][1] = *(const f32x4*)(mu + col[q] + 4); } } }
#pragma unroll
            for (int qq = 0; qq < GS; ++qq) { const int q = g0 + qq; if (on[q]) {
                float x[8], p[8], xs[8];
                x[0] = bflo(cur[qq].x); x[1] = bfhi(cur[qq].x); x[2] = bflo(cur[qq].y); x[3] = bfhi(cur[qq].y); x[4] = bflo(cur[qq].z); x[5] = bfhi(cur[qq].z); x[6] = bflo(cur[qq].w); x[7] = bfhi(cur[qq].w);
                p[0] = bflo(prv[qq].x); p[1] = bfhi(prv[qq].x); p[2] = bflo(prv[qq].y); p[3] = bfhi(prv[qq].y); p[4] = bflo(prv[qq].z); p[5] = bfhi(prv[qq].z); p[6] = bflo(prv[qq].w); p[7] = bfhi(prv[qq].w);
                if (PREVF) { if (s.prevf) { p[0] = pf[qq][0].x; p[1] = pf[qq][0].y; p[2] = pf[qq][0].z; p[3] = pf[qq][0].w; p[4] = pf[qq][1].x; p[5] = pf[qq][1].y; p[6] = pf[qq][1].z; p[7] = pf[qq][1].w; } }
                const float m8[8] = {mv[qq][0].x, mv[qq][0].y, mv[qq][0].z, mv[qq][0].w, mv[qq][1].x, mv[qq][1].y, mv[qq][1].z, mv[qq][1].w};
#pragma unroll
                for (int e = 0; e < 8; ++e) xs[e] = x[e] + m8[e] * (p[e] - x[e]);
                if (q == 0) { if (L1M) {
#pragma unroll
                        for (int e = 0; e < 8; ++e) keep_r[e] = xs[e]; } else st8(lds, T_R + toff, xs); }
                else if (q == 1) { if (L1M) {
#pragma unroll
                        for (int e = 0; e < 8; ++e) { keep_k[e] = xs[e]; keep_kk[e] = xs[e] * kkc[e]; } }
                    else { st8(lds, T_K + toff, xs);
#pragma unroll
                        for (int e = 0; e < 8; ++e) xs[e] *= kkc[e];
                        st8(lds, T_NKK + toff, xs); } }
                else if (q == 2) { if (L1M) {
#pragma unroll
                        for (int e = 0; e < 8; ++e) keep_v[e] = xs[e]; } else st8(lds, T_V + toff, xs); }
                else {
                    const int ci = part + 8 * (q - 3); int off;
                    if (ci < 8) { off = ST_TW + slot * (TWP * 2) + ci * 16;
#pragma unroll
                        for (int e = 0; e < 8; ++e) xs[e] = fast_tanh(xs[e]); }
                    else if (ci < 16) off = ST_XA + slot * (TWP * 2) + (ci - 8) * 16;
                    else { off = ST_SG + slot * (SGP * 2) + (ci - 16) * 16;
#pragma unroll
                        for (int e = 0; e < 8; ++e) xs[e] = fast_sigmoid(xs[e]); }
                    v4u o; o.x = pk2(xs[0], xs[1]); o.y = pk2(xs[2], xs[3]); o.z = pk2(xs[4], xs[5]); o.w = pk2(xs[6], xs[7]);
                    *(LAS v4u*)(lds + off) = o;
                }
            } }
        }
    }
    if (!HOISTF) lora_frags_load<FULL>(a, h, tid, F);
    __syncthreads();
    {
        const int ct = wave & 3, rth = wave >> 2;
        const int ch = 16 * ct + fr, c = h * HD + ch;
        const float w0 = HOISTF ? *(LAS float*)(lds + T_CW0 + ch * 4) : a.in[I_W0][c], a0 = HOISTF ? *(LAS float*)(lds + T_CA0 + ch * 4) : a.in[I_A0][c];
        float wl[2][4];
#pragma unroll
        for (int rt2 = 0; rt2 < 2; ++rt2) {
            const int rt = 2 * rth + rt2;
            bf16x8 atw[2], axa[2], asg[5];
#pragma unroll
            for (int ks = 0; ks < 2; ++ks) {
                atw[ks] = *(LAS bf16x8*)(lds + ST_TW + (16 * rt + fr) * (TWP * 2) + (ks * 32 + 8 * fq) * 2);
                axa[ks] = *(LAS bf16x8*)(lds + ST_XA + (16 * rt + fr) * (TWP * 2) + (ks * 32 + 8 * fq) * 2);
            }
            if (FULL) {
#pragma unroll
                for (int ks = 0; ks < 5; ++ks) asg[ks] = *(LAS bf16x8*)(lds + ST_SG + (16 * rt + fr) * (SGP * 2) + (ks * 32 + 8 * fq) * 2);
            }
            f32x4 accW = {0.f, 0.f, 0.f, 0.f}, accA = {0.f, 0.f, 0.f, 0.f}, accG = {0.f, 0.f, 0.f, 0.f};
#pragma unroll
            for (int ks = 0; ks < 2; ++ks) {
                accW = __builtin_amdgcn_mfma_f32_16x16x32_bf16(atw[ks], F.bw[ks], accW, 0, 0, 0);
                accA = __builtin_amdgcn_mfma_f32_16x16x32_bf16(axa[ks], F.ba[ks], accA, 0, 0, 0);
            }
            if (FULL) {
#pragma unroll
                for (int ks = 0; ks < 5; ++ks) accG = __builtin_amdgcn_mfma_f32_16x16x32_bf16(asg[ks], F.bg[ks], accG, 0, 0, 0);
            }
#pragma unroll
            for (int rg = 0; rg < 4; ++rg) {
                const int slot = 16 * rt + 4 * fq + rg, off = slot * 256 + ch * 4;
                wl[rt2][rg] = -0.60653065971f * fast_sigmoid(w0 + accW[rg]);
                if (!L1M) *(LAS float*)(lds + T_W + off) = wl[rt2][rg];
                *(LAS float*)(lds + T_B + off) = fast_sigmoid(a0 + accA[rg]);
                if (FULL) *(LAS float*)(lds + T_G + off) = accG[rg];
            }
        }
        if (L1M) {
#pragma unroll
            for (int rt2 = 0; rt2 < 2; ++rt2) { wl[rt2][1] += wl[rt2][0]; wl[rt2][2] += wl[rt2][1]; wl[rt2][3] += wl[rt2][2]; }
            const float g0 = wl[0][3], g1 = wl[1][3];
            float s0 = g0, s1 = g1;
            { const float t0 = __shfl_up(s0, 16), t1 = __shfl_up(s1, 16); if (fq >= 1) { s0 += t0; s1 += t1; } }
            { const float t0 = __shfl_up(s0, 32), t1 = __shfl_up(s1, 32); if (fq >= 2) { s0 += t0; s1 += t1; } }
            const float tot0 = __shfl(s0, 48 + fr);
            const float e0 = s0 - g0, e1 = s1 - g1 + tot0;
#pragma unroll
            for (int rg = 0; rg < 4; ++rg) { wl[0][rg] += e0; wl[1][rg] += e1; }
            if (rth == 0 && fq == 3) *(LAS float*)(lds + T_TOT2 + ch * 4) = __expf(wl[1][3]);
#pragma unroll
            for (int rt2 = 0; rt2 < 2; ++rt2)
#pragma unroll
                for (int rg = 0; rg < 4; ++rg) *(LAS float*)(lds + T_W + (16 * (2 * rth + rt2) + 4 * fq + rg) * 256 + ch * 4) = __expf(wl[rt2][rg]);
        }
    }
    __syncthreads();
    if (!L1M) {
        const int ch = tid & 63, so = tid >> 6;
        float c[8]; float run = 0.f;
#pragma unroll
        for (int i2 = 0; i2 < 8; ++i2) { const int slot = 8 * so + i2; if ((slot % RP) == 0) run = 0.f; run += *(LAS float*)(lds + T_W + slot * 256 + ch * 4); c[i2] = run; }
        if (RP > 8) {
            *(LAS float*)(lds + T_TOT + (so * 64 + ch) * 4) = run;
            __syncthreads();
            float pre = 0.f;
#pragma unroll
            for (int q = 0; q < RP / 8 - 1; ++q) { const int so2 = (so / (RP / 8)) * (RP / 8) + q; if (so2 < so) pre += *(LAS float*)(lds + T_TOT + (so2 * 64 + ch) * 4); }
#pragma unroll
            for (int i2 = 0; i2 < 8; ++i2) c[i2] += pre;
        }
#pragma unroll
        for (int i2 = 0; i2 < 8; ++i2) *(LAS float*)(lds + T_W + (8 * so + i2) * 256 + ch * 4) = c[i2];
        __syncthreads();
    }
    {
        const int slot = tid >> 3, part = tid & 7, ch8 = part * 8, c8 = h * HD + ch8, toff = slot * 256 + ch8 * 4;
        float kkr[8], av[8], k[8], ka[8], cu[8], cp[8];
        if (L1M) {
#pragma unroll
            for (int j2 = 0; j2 < 8; ++j2) { kkr[j2] = keep_kk[j2]; k[j2] = keep_k[j2]; } }
        else { ld8l(lds, T_NKK + toff, kkr); ld8l(lds, T_K + toff, k); }
        ld8l(lds, T_B + toff, av); if (HOISTF) ld8l(lds, T_CKA + ch8 * 4, ka); else ld8f(a.in[I_KA] + c8, ka); ld8l(lds, T_W + toff, cu);
        if ((slot % RP) != 0) ld8l(lds, T_W + toff - 256, cp);
        else {
#pragma unroll
            for (int j2 = 0; j2 < 8; ++j2) cp[j2] = L1M ? 1.f : 0.f; }
        if (L1M && slot >= 32) { float t8[8]; ld8l(lds, T_TOT2 + ch8 * 4, t8);
#pragma unroll
            for (int j2 = 0; j2 < 8; ++j2) { cu[j2] *= t8[j2]; if (slot > 32) cp[j2] *= t8[j2]; } }
        float ssq = 0.f;
#pragma unroll
        for (int j2 = 0; j2 < 8; ++j2) ssq += kkr[j2] * kkr[j2];
        ssq = allreduce8(ssq);
        const float inv = 1.0f / fmaxf(sqrtf(ssq), 1e-12f);
        float nk[8], bb[8], kp[8], g1[8];
        float bs = 0.f;
        float r[8], rk[8];
        if (FULL) { if (L1M) {
#pragma unroll
                for (int j2 = 0; j2 < 8; ++j2) r[j2] = keep_r[j2]; } else ld8l(lds, T_R + toff, r);
            if (HOISTF) ld8l(lds, T_CRK + ch8 * 4, rk); else ld8f(a.in[I_RK] + c8, rk); }
        float vv[8], gg[8];
        if (L1M) { ld8l(lds, T_G + toff, gg);
#pragma unroll
            for (int j2 = 0; j2 < 8; ++j2) vv[j2] = keep_v[j2]; }
#pragma unroll
        for (int j2 = 0; j2 < 8; ++j2) {
            const float kk = kkr[j2] * inv; const float kpv = k[j2] * (1.0f + (av[j2] - 1.0f) * ka[j2]);
            g1[j2] = L1M ? cu[j2] : __expf(cu[j2]); const float gi = __builtin_amdgcn_rcpf(g1[j2]), g0 = L1M ? cp[j2] : __expf(cp[j2]);
            if (FULL) bs += r[j2] * kpv * rk[j2];
            nk[j2] = -kk * g0; bb[j2] = kk * av[j2] * gi; kp[j2] = kpv * gi;
        }
        if (!L1M) { st8(lds, T_NKK + toff, nk); st8(lds, T_B + toff, bb); st8(lds, T_K + toff, kp); }
        if (FULL) {
#pragma unroll
            for (int j2 = 0; j2 < 8; ++j2) r[j2] *= g1[j2];
            if (!L1M) st8(lds, T_R + toff, r);
            bs = allreduce8(bs);
            if (part == 0) *(LAS float*)(lds + T_BONUS + slot * 4) = bs;
            if (slot == 63) st8(lds, T_GL + ch8 * 4, g1);
            if (STORE) {
                const int go = slot * 128 + part * 16;
                if (!L1M) { ld8l(lds, T_V + toff, vv); ld8l(lds, T_G + toff, gg); }
                v4u w;
                w.x = pg8::cvt_pk_bf16(r[0], r[1]); w.y = pg8::cvt_pk_bf16(r[2], r[3]); w.z = pg8::cvt_pk_bf16(r[4], r[5]); w.w = pg8::cvt_pk_bf16(r[6], r[7]); if (!L1M) *(v4u*)(rec + go) = w; else *(LAS v4u*)(lds + L_RBF + slot * 144 + part * 16) = w;
                w.x = pg8::cvt_pk_bf16(bb[0], bb[1]); w.y = pg8::cvt_pk_bf16(bb[2], bb[3]); w.z = pg8::cvt_pk_bf16(bb[4], bb[5]); w.w = pg8::cvt_pk_bf16(bb[6], bb[7]); if (!L1M) *(v4u*)(rec + 8192 + go) = w;
                if (L1M) *(LAS v4u*)(lds + L_BBF + slot * 144 + part * 16) = w;
                w.x = pg8::cvt_pk_bf16(kp[0], kp[1]); w.y = pg8::cvt_pk_bf16(kp[2], kp[3]); w.z = pg8::cvt_pk_bf16(kp[4], kp[5]); w.w = pg8::cvt_pk_bf16(kp[6], kp[7]); if (!L1M) *(v4u*)(rec + 16384 + go) = w;
                if (L1M) *(LAS v4u*)(lds + L_KBF + slot * 144 + part * 16) = w;
                w.x = pg8::cvt_pk_bf16(vv[0], vv[1]); w.y = pg8::cvt_pk_bf16(vv[2], vv[3]); w.z = pg8::cvt_pk_bf16(vv[4], vv[5]); w.w = pg8::cvt_pk_bf16(vv[6], vv[7]); *(v4u*)(rec + 24576 + go) = w;
                if (L1M) { *(LAS v4u*)(lds + L_VBF + slot * 144 + part * 16) = w;
                    v4u wa; wa.x = pg8::cvt_pk_bf16(nk[0], nk[1]); wa.y = pg8::cvt_pk_bf16(nk[2], nk[3]); wa.z = pg8::cvt_pk_bf16(nk[4], nk[5]); wa.w = pg8::cvt_pk_bf16(nk[6], nk[7]); *(LAS v4u*)(lds + L_ABF + slot * 144 + part * 16) = wa; }
                w.x = pg8::cvt_pk_bf16(gg[0], gg[1]); w.y = pg8::cvt_pk_bf16(gg[2], gg[3]); w.z = pg8::cvt_pk_bf16(gg[4], gg[5]); w.w = pg8::cvt_pk_bf16(gg[6], gg[7]); *(v4u*)(rec + 32768 + go) = w;
                if (part == 0) *(float*)(rec + 40960 + slot * 4) = bs;
                if (slot == 63) { *(f32x4*)(rec + 41216 + ch8 * 4) = (f32x4){g1[0], g1[1], g1[2], g1[3]}; *(f32x4*)(rec + 41216 + ch8 * 4 + 16) = (f32x4){g1[4], g1[5], g1[6], g1[7]}; }
            }
        }
    }
    __syncthreads();
}

typedef float f2 __attribute__((ext_vector_type(2)));
struct L1Ops { f2 a[4], b[4], k[4]; f2 v; };
template <bool IS_STATE>
__device__ __forceinline__ void l1_load(LAS unsigned char* lds, int slot, int coff, int rp, L1Ops& o) {
    const int ro = slot * 256 + coff;
    const f32x4 a0 = *(LAS f32x4*)(lds + T_NKK + ro), a1 = *(LAS f32x4*)(lds + T_NKK + ro + 16);
    const f32x4 b0 = *(LAS f32x4*)(lds + T_B + ro), b1 = *(LAS f32x4*)(lds + T_B + ro + 16);
    o.a[0] = a0.xy; o.a[1] = a0.zw; o.a[2] = a1.xy; o.a[3] = a1.zw; o.b[0] = b0.xy; o.b[1] = b0.zw; o.b[2] = b1.xy; o.b[3] = b1.zw;
    if (IS_STATE) { const f32x4 k0 = *(LAS f32x4*)(lds + T_K + ro), k1 = *(LAS f32x4*)(lds + T_K + ro + 16); o.k[0] = k0.xy; o.k[1] = k0.zw; o.k[2] = k1.xy; o.k[3] = k1.zw;
        o.v = *(LAS f2*)(lds + T_V + slot * 256 + rp * 8); }
}
template <bool IS_STATE>
__device__ __forceinline__ void l1_compute(f2 (&S)[2][4], const L1Ops& o, bf16* uo, bool wr) {
    f2 u2;
#pragma unroll
    for (int r = 0; r < 2; ++r) {
        f2 acc = S[r][0] * o.a[0]; acc = __builtin_elementwise_fma(S[r][1], o.a[1], acc); acc = __builtin_elementwise_fma(S[r][2], o.a[2], acc); acc = __builtin_elementwise_fma(S[r][3], o.a[3], acc);
        const float u = allreduce8(acc.x + acc.y);
        u2[r] = u;
        const f2 uu = {u, u};
#pragma unroll
        for (int q = 0; q < 4; ++q) S[r][q] = __builtin_elementwise_fma(o.b[q], uu, S[r][q]);
        if (IS_STATE) { const f2 vv = {o.v[r], o.v[r]};
#pragma unroll
            for (int q = 0; q < 4; ++q) S[r][q] = __builtin_elementwise_fma(o.k[q], vv, S[r][q]); }
    }
    if (wr) *(unsigned*)uo = pk2(u2.x, u2.y);
}
template <bool IS_STATE, int NSB>
__device__ __forceinline__ void l1_steps(LAS unsigned char* lds, f2 (&S)[2][4], int cg, int rp, bf16* up) {
    const int coff = cg * 32;
#pragma unroll 1
    for (int sb = 0; sb < 64 / NSB; ++sb) {
        L1Ops A, B;
        l1_load<IS_STATE>(lds, sb * NSB, coff, rp, A);
#pragma unroll 2
        for (int tt = sb * NSB; tt < sb * NSB + NSB; tt += 2) {
            l1_load<IS_STATE>(lds, tt + 1, coff, rp, B);
            asm volatile("" ::: "memory");
            l1_compute<IS_STATE>(S, A, up + tt * 128 + rp * 2, cg == 0);
            l1_load<IS_STATE>(lds, tt + 2 < 64 ? tt + 2 : 63, coff, rp, A);
            asm volatile("" ::: "memory");
            l1_compute<IS_STATE>(S, B, up + (tt + 1) * 128 + rp * 2, cg == 0);
        }
        const f32x4 g0 = *(LAS f32x4*)(lds + T_W + (sb * NSB + NSB - 1) * 256 + coff), g1 = *(LAS f32x4*)(lds + T_W + (sb * NSB + NSB - 1) * 256 + coff + 16);
        const f2 e0 = {__expf(g0.x), __expf(g0.y)}, e1 = {__expf(g0.z), __expf(g0.w)}, e2 = {__expf(g1.x), __expf(g1.y)}, e3 = {__expf(g1.z), __expf(g1.w)};
#pragma unroll
        for (int r = 0; r < 2; ++r) { S[r][0] *= e0; S[r][1] *= e1; S[r][2] *= e2; S[r][3] *= e3; }
    }
}
struct L3Ops { f2 a[2], b[2], k[2], r[2]; f2 v; };
__device__ __forceinline__ void l3_load(LAS unsigned char* lds, int slot, int coff, int rg, L3Ops& o) {
    const int ro = slot * 256 + coff;
    const f32x4 a = *(LAS f32x4*)(lds + T_NKK + ro), b = *(LAS f32x4*)(lds + T_B + ro), k = *(LAS f32x4*)(lds + T_K + ro), rr = *(LAS f32x4*)(lds + T_R + ro);
    o.a[0] = a.xy; o.a[1] = a.zw; o.b[0] = b.xy; o.b[1] = b.zw; o.k[0] = k.xy; o.k[1] = k.zw; o.r[0] = rr.xy; o.r[1] = rr.zw;
    o.v = *(LAS f2*)(lds + T_V + slot * 256 + rg * 8);
}
template <int RP>
__device__ __forceinline__ void l3_compute(LAS unsigned char* lds, f2 (&S)[2][2], const L3Ops& o, int tt, int cg, int rg, int coff) {
    f2 o2;
#pragma unroll
    for (int r = 0; r < 2; ++r) {
        f2 acc = S[r][0] * o.a[0]; acc = __builtin_elementwise_fma(S[r][1], o.a[1], acc);
        const float u = allreduce16(acc.x + acc.y);
        const f2 uu = {u, u}, vv = {o.v[r], o.v[r]};
        S[r][0] = __builtin_elementwise_fma(o.b[0], uu, S[r][0]); S[r][1] = __builtin_elementwise_fma(o.b[1], uu, S[r][1]);
        S[r][0] = __builtin_elementwise_fma(o.k[0], vv, S[r][0]); S[r][1] = __builtin_elementwise_fma(o.k[1], vv, S[r][1]);
        f2 e = S[r][0] * o.r[0]; e = __builtin_elementwise_fma(S[r][1], o.r[1], e);
        o2[r] = allreduce16(e.x + e.y);
    }
    if (cg == 0) *(LAS f2*)(lds + T_OUT + tt * 256 + rg * 8) = o2;
    if ((tt % RP) == RP - 1) {
        const f32x4 g = *(LAS f32x4*)(lds + T_W + tt * 256 + coff);
        const f2 e0 = {__expf(g.x), __expf(g.y)}, e1 = {__expf(g.z), __expf(g.w)};
        S[0][0] *= e0; S[0][1] *= e1; S[1][0] *= e0; S[1][1] *= e1;
    }
}
template <int RP>
__device__ __forceinline__ void l3_steps(LAS unsigned char* lds, f2 (&S)[2][2], int cg, int rg, int t0, int t1) {
    const int coff = cg * 16;
    L3Ops A, B;
    l3_load(lds, t0, coff, rg, A);
#pragma unroll 1
    for (int tt = t0; tt < t1; tt += 2) {
        l3_load(lds, tt + 1, coff, rg, B);
        asm volatile("" ::: "memory");
        l3_compute<RP>(lds, S, A, tt, cg, rg, coff);
        l3_load(lds, tt + 2 < 64 ? tt + 2 : 63, coff, rg, A);
        asm volatile("" ::: "memory");
        l3_compute<RP>(lds, S, B, tt + 1, cg, rg, coff);
    }
}
template <class RowFn>
__device__ __forceinline__ void post_block(const Args& a, LAS unsigned char* lds, int h, const RowFn& rowfn, int tid) {
    const int slot = tid >> 3, part = tid & 7, ch8 = part * 8, c8 = h * HD + ch8, toff = slot * 256 + ch8 * 4;
    float o[8], v[8], g[8], lw[8], lb[8];
    ld8l(lds, T_OUT + toff, o); ld8l(lds, T_V + toff, v); ld8l(lds, T_G + toff, g); ld8f(a.in[I_LNW] + c8, lw); ld8f(a.in[I_LNB] + c8, lb);
    float s = 0.f;
#pragma unroll
    for (int j = 0; j < 8; ++j) s += o[j];
    const float mean = allreduce8(s) * (1.f / 64.f);
    float q = 0.f;
#pragma unroll
    for (int j = 0; j < 8; ++j) { o[j] -= mean; q += o[j] * o[j]; }
    const float rstd = 1.0f / sqrtf(allreduce8(q) * (1.f / 64.f) + GN_EPS);
    const float bonus = *(LAS float*)(lds + T_BONUS + slot * 4);
    float res[8];
#pragma unroll
    for (int j = 0; j < 8; ++j) res[j] = (o[j] * rstd * lw[j] + lb[j] + bonus * v[j]) * g[j];
    const long m = rowfn(slot);
    if (m >= 0) { v4u w; w.x = pk2(res[0], res[1]); w.y = pk2(res[2], res[3]); w.z = pk2(res[4], res[5]); w.w = pk2(res[6], res[7]);
        *(v4u*)((bf16*)(a.ws + WS_MIX) + (size_t)m * DM + c8) = w; }
}

__device__ __forceinline__ void l1_unit(const Args& a, LAS unsigned char* lds, int h, int s, int tid) {
    const bf16* P = (const bf16*)(a.ws + WS_P);
    const int cg = tid & 7, rp = tid >> 3;
    const bool is_state = __builtin_amdgcn_readfirstlane(tid >> 6) < 4;
    f2 S[2][4];
#pragma unroll
    for (int r = 0; r < 2; ++r)
#pragma unroll
        for (int q = 0; q < 4; ++q) { S[r][q] = (f2){0.f, 0.f}; if (!is_state) { const int d = (2 * rp + r - 64) - (8 * cg + 2 * q); if (d >= 0 && d < 2) S[r][q][d] = 1.0f; } }
    PrepRegs R; LoraFrags LF; lora_frags_load<true>(a, h, tid, LF);
    prep_consts_fill(a, lds, h, tid);
    __syncthreads();
    { const int mb = s * SEGLEN; auto src0 = [&](int slot) -> SlotSrc { const int m = mb + slot; SlotSrc r; r.cur = P + (size_t)m * PPITCH; r.prevb = m > 0 ? r.cur - PPITCH : nullptr; r.prevf = nullptr; return r; };
      prep_issue<true>(h, src0, tid, R); }
    for (int blk = 0; blk < NBLK; ++blk) {
        const int m0 = s * SEGLEN + blk * BLK;
        auto srcfn = [&](int slot) -> SlotSrc { const int m = m0 + slot; SlotSrc r; r.cur = P + (size_t)m * PPITCH; r.prevb = m > 0 ? r.cur - PPITCH : nullptr; r.prevf = nullptr; return r; };
        int tidv = tid; asm volatile("" : "+v"(tidv));
        prep_block<true, false, 64, true, true, true, false>(a, lds, h, srcfn, tidv, R, a.ws + WS_TL + ((size_t)h * (TP / BLK) + (m0 >> 6)) * TL_REC, LF);
        if (blk + 1 < NBLK) { const int m1 = m0 + BLK; auto src1 = [&](int slot) -> SlotSrc { const int m = m1 + slot; SlotSrc r; r.cur = P + (size_t)m * PPITCH; r.prevb = r.cur - PPITCH; r.prevf = nullptr; return r; };
            prep_issue<true>(h, src1, tidv, R); }
        { bf16* up = (bf16*)a.out + ((size_t)h * TP + m0) * 128;
          if (is_state) l1_steps<true, 64>(lds, S, cg, rp, up); else l1_steps<false, 64>(lds, S, cg, rp, up); }
        __syncthreads();
    }
    float* seg = (float*)(a.ws + WS_SEG) + ((size_t)(s * NH + h) * 2) * 4096;
#pragma unroll
    for (int r = 0; r < 2; ++r) { const int row = 2 * rp + r; *(f32x4*)(seg + (size_t)row * 64 + 8 * cg) = (f32x4){S[r][0].x, S[r][0].y, S[r][1].x, S[r][1].y}; *(f32x4*)(seg + (size_t)row * 64 + 8 * cg + 4) = (f32x4){S[r][2].x, S[r][2].y, S[r][3].x, S[r][3].y}; }
}

__device__ __forceinline__ bf16x8 frag_row(LAS unsigned char* tile, int row, int col0) {
    const f32x4 x = *(LAS f32x4*)(tile + row * 256 + col0 * 4), y = *(LAS f32x4*)(tile + row * 256 + col0 * 4 + 16);
    union { bf16x8 v; unsigned u[4]; } f; f.u[0] = pg8::cvt_pk_bf16(x.x, x.y); f.u[1] = pg8::cvt_pk_bf16(x.z, x.w); f.u[2] = pg8::cvt_pk_bf16(y.x, y.y); f.u[3] = pg8::cvt_pk_bf16(y.z, y.w); return f.v;
}
__device__ __forceinline__ void frag_row_hilo(LAS unsigned char* tile, int row, int col0, bf16x8& hi, bf16x8& lo) {
    const f32x4 x = *(LAS f32x4*)(tile + row * 256 + col0 * 4), y = *(LAS f32x4*)(tile + row * 256 + col0 * 4 + 16);
    const float v[8] = {x.x, x.y, x.z, x.w, y.x, y.y, y.z, y.w};
    union { bf16x8 v; unsigned u[4]; } fh, fl;
#pragma unroll
    for (int q = 0; q < 4; ++q) { const unsigned uh = pg8::cvt_pk_bf16(v[2 * q], v[2 * q + 1]); fh.u[q] = uh; fl.u[q] = pg8::cvt_pk_bf16(v[2 * q] - bflo(uh), v[2 * q + 1] - bfhi(uh)); }
    hi = fh.v; lo = fl.v;
}
__device__ __forceinline__ bf16x8 frag_col2(LAS unsigned char* tile, int ra, int rb, int c) {
    float v[8];
#pragma unroll
    for (int q = 0; q < 4; ++q) { v[q] = *(LAS float*)(tile + (ra + q) * 256 + c * 4); v[4 + q] = *(LAS float*)(tile + (rb + q) * 256 + c * 4); }
    union { bf16x8 v; unsigned u[4]; } f;
#pragma unroll
    for (int q = 0; q < 4; ++q) f.u[q] = pg8::cvt_pk_bf16(v[2 * q], v[2 * q + 1]);
    return f.v;
}
constexpr int M_PB = 144;
constexpr int M_RB = 0, M_BB = 9216, M_KB = 18432, M_VB = 27648, M_GB = 36864, M_ULOC = 49152, M_PSEQ = 58368, M_UT = 67584, M_VT = 76800, M_BT = 86016, M_KT = 95232, M_OUT = 104448, M_SST = M_OUT, M_S0 = 120832, M_BONUS = 129024, M_GL = 129280, M_S0F = 130048;
typedef short s16x4_ __attribute__((ext_vector_type(4)));
__device__ __forceinline__ bf16x8 fragt2(LAS unsigned char* tile, int row, int ca, int cb) {
    union { bf16x8 v; s16x4_ h[2]; } f; f.h[0] = *(LAS s16x4_*)(tile + row * M_PB + ca * 2); f.h[1] = *(LAS s16x4_*)(tile + row * M_PB + cb * 2); return f.v;
}
__device__ __forceinline__ bf16x8 fragb(LAS unsigned char* tile, int row, int col0) { return *(LAS bf16x8*)(tile + row * M_PB + col0 * 2); }
__device__ __forceinline__ bf16x8 fragt2s(LAS unsigned char* tile, int row, int ca, int cb) { const int sw = 8 * (row >> 3); return fragt2(tile, row, (ca + sw) & 63, (cb + sw) & 63); }
__device__ __forceinline__ bf16x8 fragbs(LAS unsigned char* tile, int row, int col0) { return fragb(tile, row, (col0 + 8 * (row >> 3)) & 63); }
__device__ __forceinline__ bf16x8 fragb_col2(LAS unsigned char* tile, int ra, int rb, int c) {
    unsigned v[8];
#pragma unroll
    for (int q = 0; q < 4; ++q) { v[q] = *(LAS unsigned short*)(tile + (ra + q) * M_PB + c * 2); v[4 + q] = *(LAS unsigned short*)(tile + (rb + q) * M_PB + c * 2); }
    union { bf16x8 v; unsigned u[4]; } f;
#pragma unroll
    for (int q = 0; q < 4; ++q) f.u[q] = v[2 * q] | (v[2 * q + 1] << 16);
    return f.v;
}
__device__ __forceinline__ bf16x8 l1m_half(LAS unsigned char* p) { union { bf16x8 v; s16x4_ h[2]; } f; f.h[0] = *(LAS s16x4_*)p; f.h[1] = (s16x4_){0, 0, 0, 0}; return f.v; }
__device__ __forceinline__ bf16x8 l1m_pack2(const f32x4 x, const f32x4 y) { union { bf16x8 v; unsigned u[4]; } f; f.u[0] = pg8::cvt_pk_bf16(x[0], x[1]); f.u[1] = pg8::cvt_pk_bf16(x[2], x[3]); f.u[2] = pg8::cvt_pk_bf16(y[0], y[1]); f.u[3] = pg8::cvt_pk_bf16(y[2], y[3]); return f.v; }
__device__ __forceinline__ bf16x8 l1m_pack1(const f32x4 x) { union { bf16x8 v; unsigned u[4]; } f; f.u[0] = pg8::cvt_pk_bf16(x[0], x[1]); f.u[1] = pg8::cvt_pk_bf16(x[2], x[3]); f.u[2] = 0u; f.u[3] = 0u; return f.v; }
__device__ __forceinline__ void l1m_hilo2(const f32x4 x, const f32x4 y, bf16x8& hi, bf16x8& lo) {
    union { bf16x8 v; unsigned u[4]; } fh, fl;
    fh.u[0] = pg8::cvt_pk_bf16(x[0], x[1]); fh.u[1] = pg8::cvt_pk_bf16(x[2], x[3]); fh.u[2] = pg8::cvt_pk_bf16(y[0], y[1]); fh.u[3] = pg8::cvt_pk_bf16(y[2], y[3]);
    fl.u[0] = pg8::cvt_pk_bf16(x[0] - bflo(fh.u[0]), x[1] - bfhi(fh.u[0])); fl.u[1] = pg8::cvt_pk_bf16(x[2] - bflo(fh.u[1]), x[3] - bfhi(fh.u[1]));
    fl.u[2] = pg8::cvt_pk_bf16(y[0] - bflo(fh.u[2]), y[1] - bfhi(fh.u[2])); fl.u[3] = pg8::cvt_pk_bf16(y[2] - bflo(fh.u[3]), y[3] - bfhi(fh.u[3]));
    hi = fh.v; lo = fl.v;
}
__device__ __forceinline__ void l1m_store_c(LAS unsigned char* tile, int pitch, int r0, int col, int fq, const f32x4 v) {
    const unsigned w0 = pg8::cvt_pk_bf16(v[0], v[1]), w1 = pg8::cvt_pk_bf16(v[2], v[3]);
    LAS unsigned short* p = (LAS unsigned short*)(tile + (r0 + 4 * fq) * pitch + col * 2);
    p[0] = (unsigned short)(w0 & 0xffff); p[pitch / 2] = (unsigned short)(w0 >> 16); p[pitch] = (unsigned short)(w1 & 0xffff); p[3 * (pitch / 2)] = (unsigned short)(w1 >> 16);
}
template <int R> struct DinvRows {
    static __device__ __forceinline__ void run(const float (&nrow)[16], float (&x)[16], int c) {
        DinvRows<R - 1>::run(nrow, x, c);
        float acc4[4] = {(R == c) ? 1.f : 0.f, 0.f, 0.f, 0.f};
#pragma unroll
        for (int sc = 0; sc < R; ++sc)
            asm volatile("v_fmac_f32_dpp %0, %1, %2 row_newbcast:%3 row_mask:0xf bank_mask:0xf" : "+v"(acc4[sc & 3]) : "v"(nrow[sc]), "v"(x[sc]), "n"(R));
        x[R] = (acc4[0] + acc4[1]) + (acc4[2] + acc4[3]);
    }
};
template <> struct DinvRows<-1> { static __device__ __forceinline__ void run(const float (&)[16], float (&)[16], int) {} };
#define L1M_TR(dst, base, off) asm volatile("ds_read_b64_tr_b16 %0, %1 offset:%2" : "=&v"(dst) : "v"(base), "i"(off) : "memory")
#define L1M_TRWAIT() do { asm volatile("s_waitcnt lgkmcnt(0)" ::: "memory"); __builtin_amdgcn_sched_barrier(0); } while (0)
__device__ __forceinline__ bf16x8 l1m_join(const s16x4_ lo, const s16x4_ hi) { return (bf16x8){lo[0], lo[1], lo[2], lo[3], hi[0], hi[1], hi[2], hi[3]}; }
#define L1M_MFMA(A, B, C) __builtin_amdgcn_mfma_f32_16x16x32_bf16((A), (B), (C), 0, 0, 0)
__device__ __forceinline__ void l1m_block(LAS unsigned char* lds, int tid, f32x4 (&ST)[4], bf16* up, unsigned char* rec) {
    const int lane = tid & 63, wave = __builtin_amdgcn_readfirstlane(tid >> 6), fr = lane & 15, fq = lane >> 4;
    const int ct = wave & 3; const bool sideC = wave >= 4;
    const f32x4 zero4 = {0.f, 0.f, 0.f, 0.f};
    const unsigned trb4 = (unsigned)(size_t)lds + (4 * fq + (fr >> 2)) * 144 + (fr & 3) * 8, trb8 = (unsigned)(size_t)lds + (8 * fq + (fr >> 2)) * 144 + (fr & 3) * 8;
    {
        bf16x8 af[2], rf[2];
#pragma unroll
        for (int ks = 0; ks < 2; ++ks) { af[ks] = fragb(lds + L_ABF, 16 * ct + fr, 32 * ks + 8 * fq); rf[ks] = fragb(lds + L_RBF, 16 * ct + fr, 32 * ks + 8 * fq); }
        LAS unsigned char* bsrc = lds + (sideC ? L_KBF : L_BBF); LAS unsigned char* dstn = lds + (sideC ? L_ML : L_NL); LAS unsigned char* dstr = lds + (sideC ? L_RK : L_RB);
#pragma unroll
        for (int st = 0; st < 4; ++st) {
            if (st > ct) {
                if (st == ct + 1 && !(ct & 1)) { if (sideC) l1m_store_c(dstn, 144, 16 * ct, 16 * st + fr, fq, zero4); l1m_store_c(dstr, 144, 16 * ct, 16 * st + fr, fq, zero4); }
                continue;
            }
            f32x4 accn = zero4, accr = zero4;
#pragma unroll
            for (int ks = 0; ks < 2; ++ks) { const bf16x8 bf = fragb(bsrc, 16 * st + fr, 32 * ks + 8 * fq); accn = L1M_MFMA(af[ks], bf, accn); accr = L1M_MFMA(rf[ks], bf, accr); }
            if (st == ct) {
#pragma unroll
                for (int rg = 0; rg < 4; ++rg) { const int tl = 4 * fq + rg; accn[rg] = (fr < tl) ? accn[rg] : 0.f; accr[rg] = (fr <= tl) ? accr[rg] : 0.f;
                    if (!sideC) *(LAS float*)(lds + L_ND + ((16 * ct + tl) * 16 + fr) * 4) = accn[rg]; }
            }
            l1m_store_c(dstn, 144, 16 * ct, 16 * st + fr, fq, accn); l1m_store_c(dstr, 144, 16 * ct, 16 * st + fr, fq, accr);
        }
    }
    __syncthreads();
    if (wave == 0) {
        const int k = lane >> 4, c = lane & 15;
        float nrow[16], x[16];
#pragma unroll
        for (int q = 0; q < 4; ++q) { const f32x4 n = *(LAS f32x4*)(lds + L_ND + ((16 * k + c) * 16 + 4 * q) * 4); nrow[4 * q] = n[0]; nrow[4 * q + 1] = n[1]; nrow[4 * q + 2] = n[2]; nrow[4 * q + 3] = n[3]; }
        DinvRows<15>::run(nrow, x, c);
#pragma unroll
        for (int r = 0; r < 16; ++r) *(LAS unsigned short*)(lds + L_DINV + ((16 * k + r) * 16 + c) * 2) = (unsigned short)f2bf(x[r]);
    }
    f32x4 X[4];
    bf16x8 v01, v23;
    f32x4 Sc[4];
    f32x4 Oacc[4];
    if (!sideC) {
#pragma unroll
        for (int k = 0; k < 4; ++k)
#pragma unroll
            for (int rg = 0; rg < 4; ++rg) X[k][rg] = bf2f(*(LAS unsigned short*)(lds + L_ABF + (16 * k + 4 * fq + rg) * 144 + (16 * ct + fr) * 2));
    } else {
        s16x4_ tv[4], tp[4], tk[4][4];
        const unsigned tv8 = trb8 + 32 * ct, tv4 = trb4 + 32 * ct;
        L1M_TR(tv[0], tv8, L_VBF); L1M_TR(tv[1], tv8, L_VBF + 4 * 144); L1M_TR(tv[2], tv8, L_VBF + 32 * 144); L1M_TR(tv[3], tv8, L_VBF + 36 * 144);
#pragma unroll
        for (int blk = 0; blk < 4; ++blk) L1M_TR(tp[blk], tv4, L_VBF + 16 * blk * 144);
#pragma unroll
        for (int jt = 0; jt < 4; ++jt)
#pragma unroll
            for (int blk = 0; blk < 4; ++blk) L1M_TR(tk[jt][blk], trb4, L_KBF + 32 * jt + 16 * blk * 144);
        L1M_TRWAIT();
        const bf16x8 bv[2] = {l1m_join(tv[0], tv[1]), l1m_join(tv[2], tv[3])};
#pragma unroll
        for (int k = 0; k < 4; ++k) { f32x4 acc = zero4;
#pragma unroll
            for (int ks = 0; ks < 2; ++ks) if (32 * ks <= 16 * k + 15) acc = L1M_MFMA(fragb(lds + L_ML, 16 * k + fr, 32 * ks + 8 * fq), bv[ks], acc);
            X[k] = acc; }
        v01 = l1m_join(tp[0], tp[1]); v23 = l1m_join(tp[2], tp[3]);
#pragma unroll
        for (int jt = 0; jt < 4; ++jt) { f32x4 acc = zero4;
            acc = L1M_MFMA(l1m_join(tk[jt][0], tk[jt][1]), v01, acc); acc = L1M_MFMA(l1m_join(tk[jt][2], tk[jt][3]), v23, acc);
            Sc[jt] = acc; }
#pragma unroll
        for (int tt = 0; tt < 4; ++tt) { f32x4 acc = zero4;
            acc = L1M_MFMA(fragt2(lds + L_RK, 16 * tt + fr, 4 * fq, 16 + 4 * fq), v01, acc);
            if (tt >= 2) acc = L1M_MFMA(fragt2(lds + L_RK, 16 * tt + fr, 32 + 4 * fq, 48 + 4 * fq), v23, acc);
            Oacc[tt] = acc; }
    }
    __syncthreads();
    X[0] = L1M_MFMA(l1m_half(lds + L_DINV + ((0 + fr) * 16 + 4 * fq) * 2), l1m_pack1(X[0]), zero4);
    X[1] = L1M_MFMA(l1m_half(lds + L_NL + (16 + fr) * 144 + (4 * fq) * 2), l1m_pack1(X[0]), X[1]);
    X[1] = L1M_MFMA(l1m_half(lds + L_DINV + ((16 + fr) * 16 + 4 * fq) * 2), l1m_pack1(X[1]), zero4);
    const bf16x8 b01 = l1m_pack2(X[0], X[1]);
    X[2] = L1M_MFMA(fragt2(lds + L_NL, 32 + fr, 4 * fq, 16 + 4 * fq), b01, X[2]);
    X[2] = L1M_MFMA(l1m_half(lds + L_DINV + ((32 + fr) * 16 + 4 * fq) * 2), l1m_pack1(X[2]), zero4);
    X[3] = L1M_MFMA(fragt2(lds + L_NL, 48 + fr, 4 * fq, 16 + 4 * fq), b01, X[3]);
    X[3] = L1M_MFMA(l1m_half(lds + L_NL + (48 + fr) * 144 + (32 + 4 * fq) * 2), l1m_pack1(X[2]), X[3]);
    X[3] = L1M_MFMA(l1m_half(lds + L_DINV + ((48 + fr) * 16 + 4 * fq) * 2), l1m_pack1(X[3]), zero4);
    const bf16x8 b23 = l1m_pack2(X[2], X[3]);
#pragma unroll
    for (int tt = 0; tt < 4; ++tt) {
        f32x4 acc = zero4;
        if (!sideC) {
#pragma unroll
            for (int rg = 0; rg < 4; ++rg) acc[rg] = bf2f(*(LAS unsigned short*)(lds + L_RBF + (16 * tt + 4 * fq + rg) * 144 + (16 * ct + fr) * 2)); }
        else acc = Oacc[tt];
        acc = L1M_MFMA(fragt2(lds + L_RB, 16 * tt + fr, 4 * fq, 16 + 4 * fq), b01, acc);
        if (tt >= 2) acc = L1M_MFMA(fragt2(lds + L_RB, 16 * tt + fr, 32 + 4 * fq, 48 + 4 * fq), b23, acc);
        l1m_store_c(lds + (sideC ? L_XO : L_XR), 144, 16 * tt, 16 * ct + fr, fq, acc);
    }
    s16x4_ tb[4][4];
#pragma unroll
    for (int jt = 0; jt < 4; ++jt)
#pragma unroll
        for (int blk = 0; blk < 4; ++blk) L1M_TR(tb[jt][blk], trb4, L_BBF + 32 * jt + 16 * blk * 144);
    L1M_TRWAIT();
#pragma unroll
    for (int jt = 0; jt < 4; ++jt) {
        f32x4 acc = sideC ? Sc[jt] : zero4;
        acc = L1M_MFMA(l1m_join(tb[jt][0], tb[jt][1]), b01, acc);
        acc = L1M_MFMA(l1m_join(tb[jt][2], tb[jt][3]), b23, acc);
        if (!sideC && jt == ct) {
#pragma unroll
            for (int rg = 0; rg < 4; ++rg) acc[rg] += (4 * fq + rg == fr) ? 1.f : 0.f; }
        const f32x4 gl = *(LAS f32x4*)(lds + T_GL + (16 * jt + 4 * fq) * 4);
        acc *= gl;
        Sc[jt] = acc;
        if (!sideC) l1m_store_c(lds + L_PCT, 144, 16 * jt, 16 * ct + fr, fq, acc);
        else *(f32x4*)(rec + 8192 + ((16 * ct + fr) * 64 + 16 * jt + 4 * fq) * 4) = acc;
    }
    __syncthreads();
    {
        bf16x8 sh[2], sl[2];
        l1m_hilo2(ST[0], ST[1], sh[0], sl[0]); l1m_hilo2(ST[2], ST[3], sh[1], sl[1]);
#pragma unroll
        for (int jt = 0; jt < 4; ++jt) {
            f32x4 acc = sideC ? Sc[jt] : zero4;
#pragma unroll
            for (int s2 = 0; s2 < 2; ++s2) { const bf16x8 ap = fragt2(lds + L_PCT, 16 * jt + fr, 32 * s2 + 4 * fq, 32 * s2 + 16 + 4 * fq);
                acc = L1M_MFMA(ap, sh[s2], acc); acc = L1M_MFMA(ap, sl[s2], acc); }
            Sc[jt] = acc;
        }
#pragma unroll
        for (int jt = 0; jt < 4; ++jt) ST[jt] = Sc[jt];
    }
#pragma unroll
    for (int i = 0; i < 2; ++i) { const int e = tid + 512 * i, row = e >> 4, c16 = e & 15; *(v4u*)(up + (size_t)row * 128 + c16 * 8) = *(LAS v4u*)(lds + (c16 < 8 ? L_XO : L_XR) + row * 144 + (c16 & 7) * 16); }
    { const int row = tid >> 3, c16 = tid & 7; *(v4u*)(rec + row * 128 + c16 * 16) = *(LAS v4u*)(lds + L_PCT + row * 144 + c16 * 16); }
}
__device__ __forceinline__ void l1m_unit(const Args& a, LAS unsigned char* lds, int h, int s, int tid) {
    const bf16* P = (const bf16*)(a.ws + WS_P);
    const int lane = tid & 63, wave = __builtin_amdgcn_readfirstlane(tid >> 6), fr0 = lane & 15, fq0 = lane >> 4;
    f32x4 ST[4];
#pragma unroll
    for (int jt = 0; jt < 4; ++jt)
#pragma unroll
        for (int rg = 0; rg < 4; ++rg) ST[jt][rg] = (wave < 4 && jt == (wave & 3) && 4 * fq0 + rg == fr0) ? 1.f : 0.f;
    PrepRegs R; LoraFrags LF; lora_frags_load<true>(a, h, tid, LF);
    prep_consts_fill(a, lds, h, tid);
    __syncthreads();
    { const int mb = s * SEGLEN; auto src0 = [&](int slot) -> SlotSrc { const int m = mb + slot; SlotSrc r; r.cur = P + (size_t)m * PPITCH; r.prevb = m > 0 ? r.cur - PPITCH : nullptr; r.prevf = nullptr; return r; };
      prep_issue<true>(h, src0, tid, R); }
    for (int blk = 0; blk < NBLK; ++blk) {
        const int m0 = s * SEGLEN + blk * BLK;
        auto srcfn = [&](int slot) -> SlotSrc { const int m = m0 + slot; SlotSrc r; r.cur = P + (size_t)m * PPITCH; r.prevb = m > 0 ? r.cur - PPITCH : nullptr; r.prevf = nullptr; return r; };
        int tidv = tid; asm volatile("" : "+v"(tidv));
        prep_block<true, false, 64, true, true, true, true>(a, lds, h, srcfn, tidv, R, a.ws + WS_TL + ((size_t)h * (TP / BLK) + (m0 >> 6)) * TL_REC, LF);
        if (blk + 1 < NBLK) { const int m1 = m0 + BLK; auto src1 = [&](int slot) -> SlotSrc { const int m = m1 + slot; SlotSrc r; r.cur = P + (size_t)m * PPITCH; r.prevb = r.cur - PPITCH; r.prevf = nullptr; return r; };
            prep_issue<true>(h, src1, tidv, R); }
        l1m_block(lds, tidv, ST, (bf16*)a.out + ((size_t)h * TP + m0) * 128, a.ws + WS_TL + ((size_t)h * (TP / BLK) + (m0 >> 6)) * TL_REC);
    }
    __syncthreads();
    float* seg = (float*)(a.ws + WS_SEG) + ((size_t)(s * NH + h) * 2) * 4096;
#pragma unroll
    for (int jt = 0; jt < 4; ++jt) {
        if (wave >= 4) *(f32x4*)(seg + (size_t)(16 * (wave & 3) + fr0) * 64 + 16 * jt + 4 * fq0) = ST[jt];
        else {
            pg8::u32x2 wh, wl; wh.x = pg8::cvt_pk_bf16(ST[jt][0], ST[jt][1]); wh.y = pg8::cvt_pk_bf16(ST[jt][2], ST[jt][3]);
            wl.x = pg8::cvt_pk_bf16(ST[jt][0] - bflo(wh.x), ST[jt][1] - bfhi(wh.x)); wl.y = pg8::cvt_pk_bf16(ST[jt][2] - bflo(wh.y), ST[jt][3] - bfhi(wh.y));
            unsigned char* pmt = (unsigned char*)(seg + 4096) + ((16 * (wave & 3) + fr0) * 64 + 16 * jt + 4 * fq0) * 2;
            *(pg8::u32x2*)pmt = wh; *(pg8::u32x2*)(pmt + 8192) = wl; }
    }
}
struct L3Pre { v4u tl[5]; v4u up[2]; float bon, gl; };
__device__ __forceinline__ void l3m_issue(const Args& a, int h, int m0, int tid, L3Pre& R) {
    const unsigned char* rec = a.ws + WS_TL + ((size_t)h * (TP / BLK) + (m0 >> 6)) * TL_REC;
    const int go = (tid >> 3) * 128 + (tid & 7) * 16;
#pragma unroll
    for (int q = 0; q < 5; ++q) R.tl[q] = *(const v4u*)(rec + 8192 * q + go);
    const bf16* up = (const bf16*)a.out + ((size_t)h * TP + m0) * 128;
#pragma unroll
    for (int i = 0; i < 2; ++i) R.up[i] = *(const v4u*)(up + 8 * (tid + 512 * i));
    R.bon = 0.f; R.gl = 0.f;
    if (tid < 64) { R.bon = *(const float*)(rec + 40960 + tid * 4); R.gl = *(const float*)(rec + 41216 + tid * 4); }
}
__device__ __forceinline__ void l3m_unit(const Args& a, LAS unsigned char* lds, int h, int s, int tid) {
    const int lane = tid & 63, wave = __builtin_amdgcn_readfirstlane(tid >> 6), fr0 = lane & 15, fq0 = lane >> 4;
    const int cg = tid & 15, rg = tid >> 4;
    L3Pre R; l3m_issue(a, h, s * SEGLEN, tid, R);
    f32x4 S[2] = {{0.f, 0.f, 0.f, 0.f}, {0.f, 0.f, 0.f, 0.f}};
    const float* segb = (const float*)(a.ws + WS_SEG);
    for (int sp = 0; sp < s; ++sp) {
        const float* sl = segb + ((size_t)(sp * NH + h) * 2) * 4096; const float* pm = sl + 4096;
        f32x4 acc[2];
#pragma unroll
        for (int r = 0; r < 2; ++r) acc[r] = *(const f32x4*)(sl + (size_t)(2 * rg + r) * 64 + 4 * cg);
        if (sp > 0) {
#pragma unroll
            for (int r = 0; r < 2; ++r) *(LAS f32x4*)(lds + SL_OFF + ((2 * rg + r) * SLP + 4 * cg) * 4) = S[r];
#pragma unroll
            for (int i = 0; i < 2; ++i) { const int e = (tid + 512 * i) * 4; *(LAS f32x4*)(lds + PM_OFF + e * 4) = *(const f32x4*)(pm + e); }
            __syncthreads();
#pragma unroll 4
            for (int l4 = 0; l4 < 16; ++l4) {
                const f32x4 s0 = *(LAS f32x4*)(lds + SL_OFF + ((2 * rg) * SLP + 4 * l4) * 4), s1 = *(LAS f32x4*)(lds + SL_OFF + ((2 * rg + 1) * SLP + 4 * l4) * 4);
#pragma unroll
                for (int j = 0; j < 4; ++j) { const f32x4 p = *(LAS f32x4*)(lds + PM_OFF + ((4 * l4 + j) * 64 + 4 * cg) * 4); acc[0] += p * s0[j]; acc[1] += p * s1[j]; }
            }
            __syncthreads();
        }
        S[0] = acc[0]; S[1] = acc[1];
    }
#pragma unroll
    for (int r = 0; r < 2; ++r) {
        *(LAS f32x4*)(lds + M_SST + ((2 * rg + r) * 64 + 4 * cg) * 4) = S[r];
        *(LAS f32x4*)(lds + M_S0F + ((2 * rg + r) * 64 + 4 * cg) * 4) = S[r];
        pg8::u32x2 w; w.x = pg8::cvt_pk_bf16(S[r].x, S[r].y); w.y = pg8::cvt_pk_bf16(S[r].z, S[r].w);
        *(LAS pg8::u32x2*)(lds + M_S0 + ((2 * rg + r) * 64 + 4 * cg) * 2) = w;
    }
    __syncthreads();
    const int ita = wave & 3, tpa = wave >> 2;
    const int tt = wave >> 1, ih = wave & 1;
    f32x4 Sacc[2];
#pragma unroll
    for (int x = 0; x < 2; ++x)
#pragma unroll
        for (int rg4 = 0; rg4 < 4; ++rg4) Sacc[x][rg4] = *(LAS float*)(lds + M_SST + ((16 * tt + 4 * fq0 + rg4) * 64 + 16 * (2 * ih + x) + fr0) * 4);
    __syncthreads();
    for (int blk = 0; blk < NBLK; ++blk) {
        const int m0 = s * SEGLEN + blk * BLK;
        int fr = fr0, fq = fq0; asm volatile("" : "+v"(fr), "+v"(fq));
        {
            const int slot = tid >> 3, part = tid & 7;
#pragma unroll
            for (int q = 0; q < 5; ++q) *(LAS v4u*)(lds + 9216 * q + slot * M_PB + part * 16) = R.tl[q];
#pragma unroll
            for (int q = 1; q < 4; ++q) {
                LAS unsigned short* tp = (LAS unsigned short*)(lds + (q == 1 ? M_BT : q == 2 ? M_KT : M_VT) + (8 * part) * M_PB + ((slot + 8 * part) & 63) * 2);
                const v4u w = R.tl[q];
                tp[0 * (M_PB / 2)] = (unsigned short)(w.x & 0xffff); tp[1 * (M_PB / 2)] = (unsigned short)(w.x >> 16);
                tp[2 * (M_PB / 2)] = (unsigned short)(w.y & 0xffff); tp[3 * (M_PB / 2)] = (unsigned short)(w.y >> 16);
                tp[4 * (M_PB / 2)] = (unsigned short)(w.z & 0xffff); tp[5 * (M_PB / 2)] = (unsigned short)(w.z >> 16);
                tp[6 * (M_PB / 2)] = (unsigned short)(w.w & 0xffff); tp[7 * (M_PB / 2)] = (unsigned short)(w.w >> 16);
            }
#pragma unroll
            for (int i = 0; i < 2; ++i) { const int e = tid + 512 * i, sl2 = e >> 4, c = e & 15; *(LAS v4u*)(lds + (c < 8 ? M_ULOC : M_PSEQ) + sl2 * M_PB + (c & 7) * 16) = R.up[i]; }
            if (tid < 64) { *(LAS float*)(lds + M_BONUS + tid * 4) = R.bon; *(LAS float*)(lds + M_GL + tid * 4) = R.gl; }
        }
        __syncthreads();
        if (blk + 1 < NBLK) l3m_issue(a, h, m0 + BLK, tid, R);
        bf16x8 sbh[2], sbl[2];
#pragma unroll
        for (int ks = 0; ks < 2; ++ks) frag_row_hilo(lds + M_S0F, 16 * ita + fr, 32 * ks + 8 * fq, sbh[ks], sbl[ks]);
#pragma unroll
        for (int x = 0; x < 2; ++x) {
            const int ta = 2 * tpa + x;
            f32x4 acc;
#pragma unroll
            for (int rg4 = 0; rg4 < 4; ++rg4) acc[rg4] = bf2f(*(LAS unsigned short*)(lds + M_ULOC + (16 * ta + 4 * fq + rg4) * M_PB + (16 * ita + fr) * 2));
#pragma unroll
            for (int ks = 0; ks < 2; ++ks) {
                const bf16x8 ap = fragb(lds + M_PSEQ, 16 * ta + fr, 32 * ks + 8 * fq);
                acc = __builtin_amdgcn_mfma_f32_16x16x32_bf16(ap, sbh[ks], acc, 0, 0, 0);
                acc = __builtin_amdgcn_mfma_f32_16x16x32_bf16(ap, sbl[ks], acc, 0, 0, 0);
            }
            { pg8::u32x2 w; w.x = pk2(acc[0], acc[1]); w.y = pk2(acc[2], acc[3]); *(LAS pg8::u32x2*)(lds + M_UT + (16 * ita + fr) * M_PB + (16 * ta + 4 * fq) * 2) = w; }
        }
        __syncthreads();
        bf16x8 rbf[2];
#pragma unroll
        for (int ks = 0; ks < 2; ++ks) rbf[ks] = fragb(lds + M_RB, 16 * tt + fr, 32 * ks + 8 * fq);
        float pb[4][4], pk[4][4];
#pragma unroll
        for (int st = 0; st < 4; ++st) {
            f32x4 accb = {0.f, 0.f, 0.f, 0.f}, acck = {0.f, 0.f, 0.f, 0.f};
            if (st <= tt) {
#pragma unroll
                for (int ks = 0; ks < 2; ++ks) {
                    accb = __builtin_amdgcn_mfma_f32_16x16x32_bf16(fragb(lds + M_BB, 16 * st + fr, 32 * ks + 8 * fq), rbf[ks], accb, 0, 0, 0);
                    acck = __builtin_amdgcn_mfma_f32_16x16x32_bf16(fragb(lds + M_KB, 16 * st + fr, 32 * ks + 8 * fq), rbf[ks], acck, 0, 0, 0);
                }
            }
#pragma unroll
            for (int rg4 = 0; rg4 < 4; ++rg4) { const bool ok = (16 * st + 4 * fq + rg4) <= (16 * tt + fr); pb[st][rg4] = ok ? accb[rg4] : 0.f; pk[st][rg4] = ok ? acck[rg4] : 0.f; }
        }
#pragma unroll
        for (int x = 0; x < 2; ++x) {
            const int it = 2 * ih + x;
            f32x4 acc = {0.f, 0.f, 0.f, 0.f};
#pragma unroll
            for (int p2 = 0; p2 < 2; ++p2) {
                if (2 * p2 <= tt) {
                    union { bf16x8 v; unsigned u[4]; } afb, afk;
                    afb.u[0] = pg8::cvt_pk_bf16(pb[2 * p2][0], pb[2 * p2][1]); afb.u[1] = pg8::cvt_pk_bf16(pb[2 * p2][2], pb[2 * p2][3]); afb.u[2] = pg8::cvt_pk_bf16(pb[2 * p2 + 1][0], pb[2 * p2 + 1][1]); afb.u[3] = pg8::cvt_pk_bf16(pb[2 * p2 + 1][2], pb[2 * p2 + 1][3]);
                    afk.u[0] = pg8::cvt_pk_bf16(pk[2 * p2][0], pk[2 * p2][1]); afk.u[1] = pg8::cvt_pk_bf16(pk[2 * p2][2], pk[2 * p2][3]); afk.u[2] = pg8::cvt_pk_bf16(pk[2 * p2 + 1][0], pk[2 * p2 + 1][1]); afk.u[3] = pg8::cvt_pk_bf16(pk[2 * p2 + 1][2], pk[2 * p2 + 1][3]);
                    acc = __builtin_amdgcn_mfma_f32_16x16x32_bf16(afb.v, fragt2(lds + M_UT, 16 * it + fr, 32 * p2 + 4 * fq, 32 * p2 + 16 + 4 * fq), acc, 0, 0, 0);
                    acc = __builtin_amdgcn_mfma_f32_16x16x32_bf16(afk.v, fragt2s(lds + M_VT, 16 * it + fr, 32 * p2 + 4 * fq, 32 * p2 + 16 + 4 * fq), acc, 0, 0, 0);
                }
            }
#pragma unroll
            for (int ks = 0; ks < 2; ++ks) acc = __builtin_amdgcn_mfma_f32_16x16x32_bf16(rbf[ks], *(LAS bf16x8*)(lds + M_S0 + ((16 * it + fr) * 64 + 32 * ks + 8 * fq) * 2), acc, 0, 0, 0);
#pragma unroll
            for (int rg4 = 0; rg4 < 4; ++rg4) *(LAS float*)(lds + M_OUT + (16 * tt + 4 * fq + rg4) * 256 + (16 * it + fr) * 4) = acc[rg4];
        }
        {
            bf16x8 au[2], av[2];
#pragma unroll
            for (int ks = 0; ks < 2; ++ks) { au[ks] = fragb(lds + M_UT, 16 * tt + fr, 32 * ks + 8 * fq); av[ks] = fragbs(lds + M_VT, 16 * tt + fr, 32 * ks + 8 * fq); }
#pragma unroll
            for (int x = 0; x < 2; ++x) { const int tj = 2 * ih + x;
#pragma unroll
                for (int ks = 0; ks < 2; ++ks) {
                    Sacc[x] = __builtin_amdgcn_mfma_f32_16x16x32_bf16(au[ks], fragbs(lds + M_BT, 16 * tj + fr, 32 * ks + 8 * fq), Sacc[x], 0, 0, 0);
                    Sacc[x] = __builtin_amdgcn_mfma_f32_16x16x32_bf16(av[ks], fragbs(lds + M_KT, 16 * tj + fr, 32 * ks + 8 * fq), Sacc[x], 0, 0, 0);
                }
            }
        }
        __syncthreads();
#pragma unroll
        for (int x = 0; x < 2; ++x) { const int tj = 2 * ih + x; const float gl = *(LAS float*)(lds + M_GL + (16 * tj + fr) * 4);
            Sacc[x] *= gl;
#pragma unroll
            for (int rg4 = 0; rg4 < 4; ++rg4) { *(LAS unsigned short*)(lds + M_S0 + ((16 * tt + 4 * fq + rg4) * 64 + 16 * tj + fr) * 2) = (unsigned short)f2bf(Sacc[x][rg4]);
                *(LAS float*)(lds + M_S0F + ((16 * tt + 4 * fq + rg4) * 64 + 16 * tj + fr) * 4) = Sacc[x][rg4]; }
        }
        {
            const int slot = tid >> 3, part = tid & 7, c8 = h * HD + part * 8;
            float o[8], v[8], g[8], lw[8], lb[8];
            ld8l(lds, M_OUT + slot * 256 + part * 32, o); ld8f(a.in[I_LNW] + c8, lw); ld8f(a.in[I_LNB] + c8, lb);
            { const v4u wv = *(LAS v4u*)(lds + M_VB + slot * M_PB + part * 16), wg = *(LAS v4u*)(lds + M_GB + slot * M_PB + part * 16);
              v[0] = bflo(wv.x); v[1] = bfhi(wv.x); v[2] = bflo(wv.y); v[3] = bfhi(wv.y); v[4] = bflo(wv.z); v[5] = bfhi(wv.z); v[6] = bflo(wv.w); v[7] = bfhi(wv.w);
              g[0] = bflo(wg.x); g[1] = bfhi(wg.x); g[2] = bflo(wg.y); g[3] = bfhi(wg.y); g[4] = bflo(wg.z); g[5] = bfhi(wg.z); g[6] = bflo(wg.w); g[7] = bfhi(wg.w); }
            float sm = 0.f;
#pragma unroll
            for (int j = 0; j < 8; ++j) sm += o[j];
            const float mean = allreduce8(sm) * (1.f / 64.f);
            float q = 0.f;
#pragma unroll
            for (int j = 0; j < 8; ++j) { o[j] -= mean; q += o[j] * o[j]; }
            const float rstd = 1.0f / sqrtf(allreduce8(q) * (1.f / 64.f) + GN_EPS);
            const float bonus = *(LAS float*)(lds + M_BONUS + slot * 4);
            v4u w; float res[8];
#pragma unroll
            for (int j = 0; j < 8; ++j) res[j] = (o[j] * rstd * lw[j] + lb[j] + bonus * v[j]) * g[j];
            w.x = pk2(res[0], res[1]); w.y = pk2(res[2], res[3]); w.z = pk2(res[4], res[5]); w.w = pk2(res[6], res[7]);
            *(v4u*)((bf16*)(a.ws + WS_MIX) + (size_t)(m0 + slot) * DM + c8) = w;
        }
        __syncthreads();
    }
    if (s == SEGS - 1) {
#pragma unroll
        for (int x = 0; x < 2; ++x)
#pragma unroll
            for (int rg4 = 0; rg4 < 4; ++rg4) a.out[O_PST + ((size_t)h * HD + 16 * tt + 4 * fq0 + rg4) * HD + 16 * (2 * ih + x) + fr0] = Sacc[x][rg4];
    }
}

constexpr int S_VB = 0, S_GB = 9216, S_OR = 18432, S_ORP = 272, S_PCT = 35840, S_BUF = 45056, S_OUT = 90112, S_S0F = 106496, S_S0B = 18432, S_BON = 143360, S_LN = 143872;
struct L3sPre { v4u pct, v, g, orr[2]; f32x4 sc[2]; float bon; };
__device__ __forceinline__ void l3s_issue(const Args& a, int h, int m0, int tid, L3sPre& R) {
    const unsigned char* rec = a.ws + WS_TL + ((size_t)h * (TP / BLK) + (m0 >> 6)) * TL_REC;
    const int go = (tid >> 3) * 128 + (tid & 7) * 16;
    R.pct = *(const v4u*)(rec + go); R.v = *(const v4u*)(rec + 24576 + go); R.g = *(const v4u*)(rec + 32768 + go);
    const bf16* up = (const bf16*)a.out + ((size_t)h * TP + m0) * 128;
#pragma unroll
    for (int i = 0; i < 2; ++i) R.orr[i] = *(const v4u*)(up + 8 * (tid + 512 * i));
    const int lane = tid & 63, wave = tid >> 6, fr = lane & 15, fq = lane >> 4, it = wave & 3, jh = wave >> 2;
#pragma unroll
    for (int x = 0; x < 2; ++x) R.sc[x] = *(const f32x4*)(rec + 8192 + ((16 * it + fr) * 64 + 16 * (2 * jh + x) + 4 * fq) * 4);
    R.bon = 0.f; if (tid < 64) R.bon = *(const float*)(rec + 40960 + tid * 4);
}
__device__ __forceinline__ void l3s_unit(const Args& a, LAS unsigned char* lds, int h, int s, int tid) {
    const int lane = tid & 63, wave = __builtin_amdgcn_readfirstlane(tid >> 6), fr0 = lane & 15, fq0 = lane >> 4;
    L3sPre R; l3s_issue(a, h, s * SEGLEN, tid, R);
    if (tid < 128) *(LAS float*)(lds + S_LN + tid * 4) = a.in[tid < 64 ? I_LNW : I_LNB][h * HD + (tid & 63)];
    const int itc = wave & 3, jh = wave >> 2;
    const float* segb = (const float*)(a.ws + WS_SEG);
    {
        const int e0 = tid * 4, e1 = (tid + 512) * 4;
        int cb = (s > 0 ? s - 1 : 0) & 1;
        {
            f32x4 v0 = {0.f, 0.f, 0.f, 0.f}, v1 = {0.f, 0.f, 0.f, 0.f};
            if (s > 0) { const float* sl = segb + ((size_t)(0 * NH + h) * 2) * 4096; v0 = *(const f32x4*)(sl + e0); v1 = *(const f32x4*)(sl + e1); }
#pragma unroll
            for (int i = 0; i < 2; ++i) { const f32x4 v = i ? v1 : v0; const int e = i ? e1 : e0, row = e >> 6, col = e & 63;
                pg8::u32x2 wh, wl; wh.x = pg8::cvt_pk_bf16(v[0], v[1]); wh.y = pg8::cvt_pk_bf16(v[2], v[3]);
                wl.x = pg8::cvt_pk_bf16(v[0] - bflo(wh.x), v[1] - bfhi(wh.x)); wl.y = pg8::cvt_pk_bf16(v[2] - bflo(wh.y), v[3] - bfhi(wh.y));
                *(LAS pg8::u32x2*)(lds + S_S0F + cb * S_S0B + row * M_PB + col * 2) = wh; *(LAS pg8::u32x2*)(lds + S_S0F + cb * S_S0B + 9216 + row * M_PB + col * 2) = wl; }
        }
        v4u pmh, pml; f32x4 sl2[2];
        const int prow = tid >> 3, ppc = tid & 7;
        auto chain_load = [&](int sp) { const float* sl = segb + ((size_t)(sp * NH + h) * 2) * 4096; const unsigned char* pmt = (const unsigned char*)(sl + 4096);
            pmh = *(const v4u*)(pmt + prow * 128 + ppc * 16); pml = *(const v4u*)(pmt + 8192 + prow * 128 + ppc * 16);
#pragma unroll
            for (int x = 0; x < 2; ++x) sl2[x] = *(const f32x4*)(sl + (size_t)(16 * itc + fr0) * 64 + 16 * (2 * jh + x) + 4 * fq0); };
        if (s > 1) chain_load(1);
        const unsigned trl = (unsigned)(size_t)lds + (8 * fq0 + (fr0 >> 2)) * M_PB + (fr0 & 3) * 8 + 32 * (2 * jh);
        for (int sp = 1; sp < s; ++sp) {
            LAS unsigned char* pmb = lds + (sp & 1) * 18432;
            *(LAS v4u*)(pmb + prow * M_PB + ppc * 16) = pmh; *(LAS v4u*)(pmb + 9216 + prow * M_PB + ppc * 16) = pml;
            f32x4 acc[2] = {sl2[0], sl2[1]};
            __syncthreads();
            if (sp + 1 < s) chain_load(sp + 1);
            LAS unsigned char* s0c = lds + S_S0F + cb * S_S0B; LAS unsigned char* s0n = lds + S_S0F + (cb ^ 1) * S_S0B;
            bf16x8 bh[2], bl[2];
#pragma unroll
            for (int ks = 0; ks < 2; ++ks) { bh[ks] = fragb(s0c, 16 * itc + fr0, 32 * ks + 8 * fq0); bl[ks] = fragb(s0c + 9216, 16 * itc + fr0, 32 * ks + 8 * fq0); }
            const unsigned trb = trl + (sp & 1) * 18432;
            s16x4_ th[2][2][2], tlo[2][2][2];
#pragma unroll
            for (int x = 0; x < 2; ++x)
#pragma unroll
                for (int ks = 0; ks < 2; ++ks)
#pragma unroll
                    for (int hf = 0; hf < 2; ++hf) { L1M_TR(th[x][ks][hf], trb, (32 * ks + 4 * hf) * 144 + 32 * x); L1M_TR(tlo[x][ks][hf], trb, 9216 + (32 * ks + 4 * hf) * 144 + 32 * x); }
            L1M_TRWAIT();
#pragma unroll
            for (int x = 0; x < 2; ++x) {
#pragma unroll
                for (int ks = 0; ks < 2; ++ks) { const bf16x8 ah = l1m_join(th[x][ks][0], th[x][ks][1]), al = l1m_join(tlo[x][ks][0], tlo[x][ks][1]);
                    acc[x] = __builtin_amdgcn_mfma_f32_16x16x32_bf16(ah, bh[ks], acc[x], 0, 0, 0); acc[x] = __builtin_amdgcn_mfma_f32_16x16x32_bf16(ah, bl[ks], acc[x], 0, 0, 0); acc[x] = __builtin_amdgcn_mfma_f32_16x16x32_bf16(al, bh[ks], acc[x], 0, 0, 0); }
                pg8::u32x2 wh, wl; wh.x = pg8::cvt_pk_bf16(acc[x][0], acc[x][1]); wh.y = pg8::cvt_pk_bf16(acc[x][2], acc[x][3]);
                wl.x = pg8::cvt_pk_bf16(acc[x][0] - bflo(wh.x), acc[x][1] - bfhi(wh.x)); wl.y = pg8::cvt_pk_bf16(acc[x][2] - bflo(wh.y), acc[x][3] - bfhi(wh.y));
                *(LAS pg8::u32x2*)(s0n + (16 * itc + fr0) * M_PB + (16 * (2 * jh + x) + 4 * fq0) * 2) = wh; *(LAS pg8::u32x2*)(s0n + 9216 + (16 * itc + fr0) * M_PB + (16 * (2 * jh + x) + 4 * fq0) * 2) = wl;
            }
            cb ^= 1;
        }
        __syncthreads();
    }
    const int tt = wave >> 1, ih = wave & 1;
    for (int blk = 0; blk < NBLK; ++blk) {
        const int m0 = s * SEGLEN + blk * BLK;
        int fr = fr0, fq = fq0; asm volatile("" : "+v"(fr), "+v"(fq));
        LAS unsigned char* tb = lds + (blk & 1) * S_BUF;
        LAS unsigned char* s0c = lds + S_S0F + (blk & 1) * S_S0B; LAS unsigned char* s0n = lds + S_S0F + ((blk + 1) & 1) * S_S0B;
        {
            const int slot = tid >> 3, part = tid & 7;
            *(LAS v4u*)(tb + S_VB + slot * M_PB + part * 16) = R.v; *(LAS v4u*)(tb + S_GB + slot * M_PB + part * 16) = R.g; *(LAS v4u*)(tb + S_PCT + slot * M_PB + part * 16) = R.pct;
#pragma unroll
            for (int i = 0; i < 2; ++i) { const int e = tid + 512 * i; *(LAS v4u*)(tb + S_OR + (e >> 4) * S_ORP + (e & 15) * 16) = R.orr[i]; }
            if (tid < 64) *(LAS float*)(lds + S_BON + (blk & 1) * 256 + tid * 4) = R.bon;
        }
        const f32x4 sc0 = R.sc[0], sc1 = R.sc[1];
        __syncthreads();
        if (blk + 1 < NBLK) l3s_issue(a, h, m0 + BLK, tid, R);
        {
            bf16x8 ar[2];
#pragma unroll
            for (int ks = 0; ks < 2; ++ks) ar[ks] = *(LAS bf16x8*)(tb + S_OR + (16 * tt + fr) * S_ORP + (64 + 32 * ks + 8 * fq) * 2);
#pragma unroll
            for (int x = 0; x < 2; ++x) {
                const int it = 2 * ih + x;
                f32x4 acc;
#pragma unroll
                for (int rg4 = 0; rg4 < 4; ++rg4) acc[rg4] = bf2f(*(LAS unsigned short*)(tb + S_OR + (16 * tt + 4 * fq + rg4) * S_ORP + (16 * it + fr) * 2));
#pragma unroll
                for (int ks = 0; ks < 2; ++ks) { const bf16x8 bh = fragb(s0c, 16 * it + fr, 32 * ks + 8 * fq), bl = fragb(s0c + 9216, 16 * it + fr, 32 * ks + 8 * fq);
                    acc = __builtin_amdgcn_mfma_f32_16x16x32_bf16(ar[ks], bh, acc, 0, 0, 0); acc = __builtin_amdgcn_mfma_f32_16x16x32_bf16(ar[ks], bl, acc, 0, 0, 0); }
#pragma unroll
                for (int rg4 = 0; rg4 < 4; ++rg4) *(LAS float*)(lds + S_OUT + (16 * tt + 4 * fq + rg4) * 256 + (16 * it + fr) * 4) = acc[rg4];
            }
        }
        {
            bf16x8 bh[2], bl[2];
#pragma unroll
            for (int ks = 0; ks < 2; ++ks) { bh[ks] = fragb(s0c, 16 * itc + fr, 32 * ks + 8 * fq); bl[ks] = fragb(s0c + 9216, 16 * itc + fr, 32 * ks + 8 * fq); }
#pragma unroll
            for (int x = 0; x < 2; ++x) {
                const int jt = 2 * jh + x;
                f32x4 acc = x == 0 ? sc0 : sc1;
#pragma unroll
                for (int ks = 0; ks < 2; ++ks) { const bf16x8 ap = fragb(tb + S_PCT, 16 * jt + fr, 32 * ks + 8 * fq);
                    acc = __builtin_amdgcn_mfma_f32_16x16x32_bf16(ap, bh[ks], acc, 0, 0, 0); acc = __builtin_amdgcn_mfma_f32_16x16x32_bf16(ap, bl[ks], acc, 0, 0, 0); }
                {
                    pg8::u32x2 wh, wl; wh.x = pg8::cvt_pk_bf16(acc[0], acc[1]); wh.y = pg8::cvt_pk_bf16(acc[2], acc[3]);
                    wl.x = pg8::cvt_pk_bf16(acc[0] - bflo(wh.x), acc[1] - bfhi(wh.x)); wl.y = pg8::cvt_pk_bf16(acc[2] - bflo(wh.y), acc[3] - bfhi(wh.y));
                    *(LAS pg8::u32x2*)(s0n + (16 * itc + fr) * M_PB + (16 * jt + 4 * fq) * 2) = wh; *(LAS pg8::u32x2*)(s0n + 9216 + (16 * itc + fr) * M_PB + (16 * jt + 4 * fq) * 2) = wl; }
                if (s == SEGS - 1 && blk == NBLK - 1) *(f32x4*)(a.out + O_PST + (size_t)h * HD * HD + (16 * itc + fr) * 64 + 16 * jt + 4 * fq) = acc;
            }
        }
        __syncthreads();
        {
            const int slot = tid >> 3, part = tid & 7, c8 = h * HD + part * 8;
            float o[8], v[8], g[8], lw[8], lb[8];
            ld8l(lds, S_OUT + slot * 256 + part * 32, o); ld8l(lds, S_LN + part * 32, lw); ld8l(lds, S_LN + 256 + part * 32, lb);
            { const v4u wv = *(LAS v4u*)(tb + S_VB + slot * M_PB + part * 16), wg = *(LAS v4u*)(tb + S_GB + slot * M_PB + part * 16);
              v[0] = bflo(wv.x); v[1] = bfhi(wv.x); v[2] = bflo(wv.y); v[3] = bfhi(wv.y); v[4] = bflo(wv.z); v[5] = bfhi(wv.z); v[6] = bflo(wv.w); v[7] = bfhi(wv.w);
              g[0] = bflo(wg.x); g[1] = bfhi(wg.x); g[2] = bflo(wg.y); g[3] = bfhi(wg.y); g[4] = bflo(wg.z); g[5] = bfhi(wg.z); g[6] = bflo(wg.w); g[7] = bfhi(wg.w); }
            float sm = 0.f;
#pragma unroll
            for (int j = 0; j < 8; ++j) sm += o[j];
            const float mean = allreduce8(sm) * (1.f / 64.f);
            float q = 0.f;
#pragma unroll
            for (int j = 0; j < 8; ++j) { o[j] -= mean; q += o[j] * o[j]; }
            const float rstd = 1.0f / sqrtf(allreduce8(q) * (1.f / 64.f) + GN_EPS);
            const float bonus = *(LAS float*)(lds + S_BON + (blk & 1) * 256 + slot * 4);
            v4u w; float res[8];
#pragma unroll
            for (int j = 0; j < 8; ++j) res[j] = (o[j] * rstd * lw[j] + lb[j] + bonus * v[j]) * g[j];
            w.x = pk2(res[0], res[1]); w.y = pk2(res[2], res[3]); w.z = pk2(res[4], res[5]); w.w = pk2(res[6], res[7]);
            *(v4u*)((bf16*)(a.ws + WS_MIX) + (size_t)(m0 + slot) * DM + c8) = w;
        }
    }
    __syncthreads();
}

__device__ __forceinline__ void sample_unit(const Args& a, LAS unsigned char* lds, int h, int bg, int tid) {
    const bf16* P = (const bf16*)(a.ws + WS_P);
    const int cg = tid & 15, rg = tid >> 4;
    auto srcfn = [&](int slot) -> SlotSrc { const int b = bg * 16 + (slot >> 2), t = slot & 3; const int m = TP + b * TS + t; SlotSrc r; r.cur = P + (size_t)m * PPITCH;
        r.prevb = t > 0 ? r.cur - PPITCH : nullptr; r.prevf = t > 0 ? nullptr : a.in[I_SHIFT] + (size_t)b * RCOLS; return r; };
    { PrepRegs R0; LoraFrags LF0; prep_block<true, true, 4, false, false, false, false>(a, lds, h, srcfn, tid, R0, nullptr, LF0); }
    f32x4 Sn[2];
    { const float* sp = a.in[I_STATE] + (((size_t)(bg * 16) * NH + h) * HD) * HD;
#pragma unroll
      for (int r = 0; r < 2; ++r) Sn[r] = *(const f32x4*)(sp + (size_t)(2 * rg + r) * HD + 4 * cg); }
    for (int bl = 0; bl < 16; ++bl) {
        const int b = bg * 16 + bl;
        f2 Sp[2][2] = {{Sn[0].xy, Sn[0].zw}, {Sn[1].xy, Sn[1].zw}};
        if (bl < 15) { const float* sp = a.in[I_STATE] + (((size_t)(b + 1) * NH + h) * HD) * HD;
#pragma unroll
            for (int r = 0; r < 2; ++r) Sn[r] = *(const f32x4*)(sp + (size_t)(2 * rg + r) * HD + 4 * cg); }
        l3_steps<4>(lds, Sp, cg, rg, 4 * bl, 4 * bl + 4);
        float* so = a.out + O_SST + (((size_t)b * NH + h) * HD) * HD;
#pragma unroll
        for (int r = 0; r < 2; ++r) *(f32x4*)(so + (size_t)(2 * rg + r) * HD + 4 * cg) = (f32x4){Sp[r][0].x, Sp[r][0].y, Sp[r][1].x, Sp[r][1].y};
    }
    __syncthreads();
    post_block(a, lds, h, [&](int slot) -> long { return TP + (bg * 16 + (slot >> 2)) * TS + (slot & 3); }, tid);
    __syncthreads();
}
}

namespace at {
constexpr int KTPB = 144;
constexpr int P_KEYS = 208, P_VTPB = 432;
constexpr int P_KT = 0, P_VT = P_KT + P_KEYS * KTPB, P_END = P_VT + 64 * P_VTPB;
constexpr int S_KEYS = 160, S_VTPB = 336;
constexpr int S_KT = 0, S_VT = S_KEYS * KTPB, S_STRIDE = S_VT + 64 * S_VTPB;
static_assert(P_END <= 131072 && 2 * S_STRIDE <= 131072, "attention LDS map");
typedef short s16x4 __attribute__((ext_vector_type(4)));

__device__ __forceinline__ void attn_wave16(LAS unsigned char* kt, LAS unsigned char* vt, int vtpb, int kt0, const bf16x8 (&qf)[2], int qrel, float slope, float sink, int kmin, f32x4 (&o)[4], int lane) {
    const int fr = lane & 15, fq = lane >> 4;
    float p[10][4];
    float mx = -INFINITY;
#pragma unroll
    for (int tl = 0; tl < 9; ++tl) {
        f32x4 acc = {0.f, 0.f, 0.f, 0.f};
#pragma unroll
        for (int ks = 0; ks < 2; ++ks) {
            const bf16x8 kf = *(LAS bf16x8*)(kt + ((kt0 + tl) * 16 + fr) * KTPB + (32 * ks + 8 * fq) * 2);
            acc = __builtin_amdgcn_mfma_f32_16x16x32_bf16(kf, qf[ks], acc, 0, 0, 0);
        }
#pragma unroll
        for (int rg = 0; rg < 4; ++rg) {
            const int kidx = (kt0 + tl) * 16 + 4 * fq + rg, dist = qrel - kidx;
            bool ok = kidx >= kmin;
            if (tl == 0 || tl == 8) ok = ok && dist >= 0 && dist < WIN;
            const float s = ok ? acc[rg] * 0.125f - slope * (float)dist : -INFINITY;
            p[tl][rg] = s; mx = fmaxf(mx, s);
        }
    }
#pragma unroll
    for (int rg = 0; rg < 4; ++rg) p[9][rg] = -INFINITY;
    mx = fmaxf(mx, __shfl_xor(mx, 16)); mx = fmaxf(mx, __shfl_xor(mx, 32));
    mx = fmaxf(mx, sink);
    float sum = 0.f;
#pragma unroll
    for (int tl = 0; tl < 10; ++tl)
#pragma unroll
        for (int rg = 0; rg < 4; ++rg) { const float e = __expf(p[tl][rg] - mx); p[tl][rg] = e; sum += e; }
    sum += __shfl_xor(sum, 16); sum += __shfl_xor(sum, 32);
    const float inv = 1.0f / (sum + __expf(sink - mx));
#pragma unroll
    for (int dt = 0; dt < 4; ++dt) o[dt] = (f32x4){0.f, 0.f, 0.f, 0.f};
#pragma unroll
    for (int pr = 0; pr < 5; ++pr) {
        union { bf16x8 v; unsigned u[4]; } af;
        af.u[0] = pk2(p[2 * pr][0] * inv, p[2 * pr][1] * inv); af.u[1] = pk2(p[2 * pr][2] * inv, p[2 * pr][3] * inv);
        af.u[2] = pk2(p[2 * pr + 1][0] * inv, p[2 * pr + 1][1] * inv); af.u[3] = pk2(p[2 * pr + 1][2] * inv, p[2 * pr + 1][3] * inv);
#pragma unroll
        for (int dt = 0; dt < 4; ++dt) {
            LAS unsigned char* vp = vt + (16 * dt + fr) * vtpb + ((kt0 + 2 * pr) * 16 + 4 * fq) * 2;
            union { bf16x8 v; s16x4 h[2]; } bfv;
            bfv.h[0] = *(LAS s16x4*)vp; bfv.h[1] = *(LAS s16x4*)(vp + 32);
            o[dt] = __builtin_amdgcn_mfma_f32_16x16x32_bf16(af.v, bfv.v, o[dt], 0, 0, 0);
        }
    }
}

struct KVRegs { v4u k[4], v[4]; };
constexpr int P_OST = P_END;
static_assert(P_OST + 8 * 4096 <= 131072, "attention LDS map (O stage)");
__device__ __forceinline__ void kv_issue(const Args& a, int qb, int kvh, int tid, KVRegs& R) {
    const bf16* P = (const bf16*)(a.ws + WS_P);
    const int tok0 = qb * 64 - 128;
#pragma unroll
    for (int i = 0; i < 4; ++i) {
        const int idx = tid + 512 * i, row = idx >> 3, ch = idx & 7, tok = tok0 + row;
        R.k[i] = (v4u){0u, 0u, 0u, 0u}; R.v[i] = (v4u){0u, 0u, 0u, 0u};
        if (idx < P_KEYS * 8 && tok >= 0 && row < 192) { const bf16* pr = P + (size_t)tok * PPITCH + kvh * HD + 8 * ch; R.k[i] = *(const v4u*)(pr + C_SK); R.v[i] = *(const v4u*)(pr + C_SV); }
    }
}
__device__ __forceinline__ void prompt_unit(const Args& a, LAS unsigned char* lds, int qb, int kvh, int tid, KVRegs& R, int nqb, int nkvh) {
    const bf16* P = (const bf16*)(a.ws + WS_P);
    bf16* MIX = (bf16*)(a.ws + WS_MIX);
    const int lane = tid & 63, wave = __builtin_amdgcn_readfirstlane(tid >> 6), fr = lane & 15, fq = lane >> 4;
    const int q0 = qb * 64, tok0 = q0 - 128;
#pragma unroll
    for (int i = 0; i < 4; ++i) {
        const int idx = tid + 512 * i;
        if (idx < P_KEYS * 8) {
            const int row = idx >> 3, ch = idx & 7;
            const v4u kv = R.k[i], vv = R.v[i];
            *(LAS v4u*)(lds + P_KT + row * KTPB + ch * 16) = kv;
            LAS unsigned short* vt = (LAS unsigned short*)(lds + P_VT + (8 * ch) * P_VTPB + row * 2);
            vt[0 * (P_VTPB / 2)] = (unsigned short)(vv.x & 0xffff); vt[1 * (P_VTPB / 2)] = (unsigned short)(vv.x >> 16);
            vt[2 * (P_VTPB / 2)] = (unsigned short)(vv.y & 0xffff); vt[3 * (P_VTPB / 2)] = (unsigned short)(vv.y >> 16);
            vt[4 * (P_VTPB / 2)] = (unsigned short)(vv.z & 0xffff); vt[5 * (P_VTPB / 2)] = (unsigned short)(vv.z >> 16);
            vt[6 * (P_VTPB / 2)] = (unsigned short)(vv.w & 0xffff); vt[7 * (P_VTPB / 2)] = (unsigned short)(vv.w >> 16);
        }
    }
    const int g = wave >> 1, half = wave & 1, h = kvh * 4 + g;
    bf16x8 qf[2][2];
#pragma unroll
    for (int i = 0; i < 2; ++i)
#pragma unroll
        for (int ks = 0; ks < 2; ++ks) qf[i][ks] = *(const bf16x8*)(P + (size_t)(q0 + 32 * half + 16 * i + fr) * PPITCH + C_Q + h * HD + 32 * ks + 8 * fq);
    __syncthreads();
    if (nqb >= 0) kv_issue(a, nqb, nkvh, tid, R);
    const float slope = exp2f(-0.5f * (float)(h + 1)), sink = a.in[I_SINK][h];
    const int kmin = tok0 < 0 ? -tok0 : 0;
    LAS unsigned char* ost = lds + P_OST + wave * 4096;
#pragma unroll 1
    for (int i = 0; i < 2; ++i) {
        const int ql = 32 * half + 16 * i, qa = q0 + ql;
        f32x4 o[4];
        if (i == 0) attn_wave16(lds + P_KT, lds + P_VT, P_VTPB, ql >> 4, qf[0], ql + 128 + fr, slope, sink, kmin, o, lane);
        else attn_wave16(lds + P_KT, lds + P_VT, P_VTPB, ql >> 4, qf[1], ql + 128 + fr, slope, sink, kmin, o, lane);
#pragma unroll
        for (int dt = 0; dt < 4; ++dt)
#pragma unroll
            for (int rg = 0; rg < 4; ++rg) *(LAS unsigned short*)(ost + (4 * fq + rg) * 128 + (16 * dt + fr) * 2) = (unsigned short)f2bf(o[dt][rg]);
        asm volatile("s_waitcnt lgkmcnt(0)" ::: "memory");
#pragma unroll
        for (int c2 = 0; c2 < 2; ++c2) { const int row = lane >> 2, c = (lane & 3) + 4 * c2;
            const v4u w = *(LAS v4u*)(ost + row * 128 + c * 16);
            *(v4u*)(MIX + (size_t)(qa + row) * DM + CW + h * HD + 8 * c) = w; }
        asm volatile("s_waitcnt lgkmcnt(0)" ::: "memory");
    }
    __syncthreads();
}

__device__ __forceinline__ void sample_unit(const Args& a, LAS unsigned char* lds, int b, int kp, int tid) {
    const bf16* P = (const bf16*)(a.ws + WS_P);
    bf16* MIX = (bf16*)(a.ws + WS_MIX);
    const int lane = tid & 63, wave = __builtin_amdgcn_readfirstlane(tid >> 6), fr = lane & 15, fq = lane >> 4;
    struct SRow { f32x4 k0, k1, v0, v1; };
    auto sload = [&](int i, SRow& r) {
        const int idx = tid + 512 * i;
        const int e = idx / (S_KEYS * 8), rem = idx - e * (S_KEYS * 8), row = rem >> 3, ch = rem & 7, kvh = 2 * kp + e;
        r.k0 = (f32x4){0.f, 0.f, 0.f, 0.f}; r.k1 = r.k0; r.v0 = r.k0; r.v1 = r.k0;
        if (row < WIN) {
            const size_t src = (((size_t)b * WIN + row) * KVH + kvh) * HD + 8 * ch;
            r.k0 = *(const f32x4*)(a.in[I_CK] + src); r.k1 = *(const f32x4*)(a.in[I_CK] + src + 4); r.v0 = *(const f32x4*)(a.in[I_CV] + src); r.v1 = *(const f32x4*)(a.in[I_CV] + src + 4);
        } else if (row < WIN + TS) {
            const bf16* pr = P + (size_t)(TP + b * TS + row - WIN) * PPITCH + kvh * HD + 8 * ch;
            float kf[8], vf[8]; rw::ld8bf(pr + C_SK, kf); rw::ld8bf(pr + C_SV, vf);
            r.k0 = (f32x4){kf[0], kf[1], kf[2], kf[3]}; r.k1 = (f32x4){kf[4], kf[5], kf[6], kf[7]}; r.v0 = (f32x4){vf[0], vf[1], vf[2], vf[3]}; r.v1 = (f32x4){vf[4], vf[5], vf[6], vf[7]};
        }
    };
    auto sstore = [&](int i, const SRow& r) {
        const int idx = tid + 512 * i;
        const int e = idx / (S_KEYS * 8), rem = idx - e * (S_KEYS * 8), row = rem >> 3, ch = rem & 7, kvh = 2 * kp + e;
        if (row >= TS && row < WIN + TS) {
            const size_t dst = (((size_t)b * WIN + row - TS) * KVH + kvh) * HD + 8 * ch;
            *(f32x4*)(a.out + O_SCK + dst) = r.k0; *(f32x4*)(a.out + O_SCK + dst + 4) = r.k1;
            *(f32x4*)(a.out + O_SCV + dst) = r.v0; *(f32x4*)(a.out + O_SCV + dst + 4) = r.v1;
        }
        LAS unsigned char* base = lds + e * S_STRIDE;
        v4u kw; kw.x = pk2(r.k0[0], r.k0[1]); kw.y = pk2(r.k0[2], r.k0[3]); kw.z = pk2(r.k1[0], r.k1[1]); kw.w = pk2(r.k1[2], r.k1[3]);
        *(LAS v4u*)(base + S_KT + row * KTPB + ch * 16) = kw;
        LAS unsigned short* vt = (LAS unsigned short*)(base + S_VT + (8 * ch) * S_VTPB + row * 2);
        const unsigned w0 = pk2(r.v0[0], r.v0[1]), w1 = pk2(r.v0[2], r.v0[3]), w2 = pk2(r.v1[0], r.v1[1]), w3 = pk2(r.v1[2], r.v1[3]);
        vt[0 * (S_VTPB / 2)] = (unsigned short)(w0 & 0xffff); vt[1 * (S_VTPB / 2)] = (unsigned short)(w0 >> 16); vt[2 * (S_VTPB / 2)] = (unsigned short)(w1 & 0xffff); vt[3 * (S_VTPB / 2)] = (unsigned short)(w1 >> 16);
        vt[4 * (S_VTPB / 2)] = (unsigned short)(w2 & 0xffff); vt[5 * (S_VTPB / 2)] = (unsigned short)(w2 >> 16); vt[6 * (S_VTPB / 2)] = (unsigned short)(w3 & 0xffff); vt[7 * (S_VTPB / 2)] = (unsigned short)(w3 >> 16);
    };
    {
        SRow ra, rb;
        sload(0, ra);
#pragma unroll 1
        for (int i = 0; i < 4; i += 2) { sload(i + 1, rb); sstore(i, ra); sload(i + 2, ra); sstore(i + 1, rb); }
        sstore(4, ra);
    }
    __syncthreads();
    if (wave < 2) {
        const int kvh = 2 * kp + wave, g = fr >> 2, t = fr & 3, h = kvh * 4 + g, m = TP + b * TS + t;
        const float slope = exp2f(-0.5f * (float)(h + 1)), sink = a.in[I_SINK][h];
        bf16x8 qf[2];
#pragma unroll
        for (int ks = 0; ks < 2; ++ks) qf[ks] = *(const bf16x8*)(P + (size_t)m * PPITCH + C_Q + h * HD + 32 * ks + 8 * fq);
        f32x4 o[4];
        LAS unsigned char* base = lds + wave * S_STRIDE;
        attn_wave16(base + S_KT, base + S_VT, S_VTPB, 0, qf, t + WIN, slope, sink, 0, o, lane);
#pragma unroll
        for (int dt = 0; dt < 4; ++dt)
#pragma unroll
            for (int rg = 0; rg < 4; ++rg) { const int r = 4 * fq + rg, hh = kvh * 4 + (r >> 2), mm = TP + b * TS + (r & 3);
                MIX[(size_t)mm * DM + CW + hh * HD + 16 * dt + fr] = (bf16)f2bf(o[dt][rg]); }
    }
    __syncthreads();
}

__device__ __forceinline__ void copies(const Args& a, size_t gt, size_t gs) {
    const bf16* P = (const bf16*)(a.ws + WS_P);
    for (size_t i = gt; i < RCOLS; i += gs) a.out[O_PSH + i] = bf2f(P[(size_t)(TP - 1) * PPITCH + i]);
    for (size_t i = gt; i < (size_t)NB * RCOLS; i += gs) { const int b = i / RCOLS, cc = i % RCOLS; a.out[O_SSH + i] = bf2f(P[(size_t)(TP + b * TS + TS - 1) * PPITCH + cc]); }
    for (size_t i = gt; i < (size_t)WIN * KVW; i += gs) { const int w = i / KVW, cc = i % KVW; const size_t row = (size_t)(TP - WIN + w) * PPITCH;
        a.out[O_PCK + i] = bf2f(P[row + C_SK + cc]); a.out[O_PCV + i] = bf2f(P[row + C_SV + cc]); }
}
}
enum { PH_PRO = 0, PH_GIN = 1, PH_L1 = 2, PH_L3 = 3, PH_GOUT = 4, PH_GGU = 5, PH_GDN = 6, PH_FIN = 7, PH_N = 8 };
struct OneUnit {
    int pm, pn;
    __device__ __forceinline__ bool next(int i, pg8::Unit& u) const { if (i) return false; u.pm = pm; u.pn = pn; u.ks = 0; return true; }
    __device__ __forceinline__ void a_ready(const pg8::Unit&) const {}
    __device__ __forceinline__ void done(const pg8::Unit&) const {}
};
struct FlagOrder {
    pg8::StaticOrder so; unsigned* flag; unsigned* tmo; unsigned want; int pm_from;
    __device__ __forceinline__ bool next(int i, pg8::Unit& u) const { return so.next(i, u); }
    __device__ __forceinline__ void a_ready(const pg8::Unit& u) const {
        if (u.pm >= pm_from) {
            unsigned sp = 0u;
            while (xb_ld(flag) < want) { __builtin_amdgcn_s_sleep(1); if ((++sp & 255u) == 0u) { if (xb_ld(tmo)) break; if (sp > XB_SPIN_CAP) { atomicAdd(tmo, 1u); break; } } }
            __builtin_amdgcn_fence(__ATOMIC_ACQUIRE, "agent");
        }
    }
    __device__ __forceinline__ void done(const pg8::Unit&) const {}
};
constexpr int OUT_TAIL_UNITS = 2 * (DM / pg8::BM);
static_assert(M - TP == 2 * pg8::BM, "out-projection tail: two sample-row panels");
__global__ void __launch_bounds__(NWAVES * 64, 2) mk_fwd(Args args) {
    extern __shared__ __attribute__((aligned(16))) unsigned char lds_raw[];
    LAS unsigned char* lds = (LAS unsigned char*)lds_raw;
    volatile LAS unsigned* MISC = (volatile LAS unsigned*)(lds + MISC_OFF);
    const int tid = threadIdx.x, lane = tid & 63, wave = __builtin_amdgcn_readfirstlane(tid >> 6);
    const int G = gridDim.x; const int bx = blockIdx.x; const int vcu = (G % 8 == 0) ? (bx % 8) * (G / 8) + bx / 8 : bx;
    if (tid < 64) ((LAS unsigned*)(lds + MISC_OFF))[tid] = 0u;
    __syncthreads();
    unsigned char* ws = args.ws;
    XcdBarrier bar = xcd_barrier_post((unsigned*)(ws + WS_CTL) + CW_BAR, MISC + 8);
    const int lo = args.ph_lo, hi = args.ph_hi;
#define IN(k) (lo <= (k) && (k) < hi)
#define BOTH(k) (IN(k) && IN((k) + 1))
    if (IN(PH_PRO)) { for (int rep = 0; rep < REP_PRO; ++rep) p0_prologue(args, lds, vcu, G, wave, lane); if (BOTH(PH_PRO)) xcd_barrier(bar); }
    if (IN(PH_GIN)) {
        pg8::Gemm g{(const bf16*)(ws + WS_XN), (const bf16*)(ws + WS_WIN), M, PPITCH, DM, DM}; pg8::StaticOrder S; S.init(M, PPITCH, G, bx);
        pg8::EpiP E{(bf16*)(ws + WS_P), PPITCH};
        for (int rep = 0; rep < REP_GIN; ++rep) pg8::gemm_phase<pg8::EpiP, pg8::StaticOrder, true, true>(lds, g, S, E);
#if LATE_WEIGHTS
        { const int nfull = S.nwg % G;
          if (nfull && bx >= nfull) convert_late_weights(args, lds, (bx - nfull) * NWAVES + wave, (G - nfull) * NWAVES, wave, lane, 0);
          else if (!nfull) convert_late_weights(args, lds, bx * NWAVES + wave, G * NWAVES, wave, lane, 0); }
#endif
        if (BOTH(PH_GIN)) xcd_barrier(bar);
    }
    if (IN(PH_L1)) {
      for (int rep = 0; rep < REP_L1; ++rep) {
        for (int r2 = 0; r2 < REP_L1A; ++r2)
        for (int u = bx; u < 256; u += G) { const int h = u & 15, s = u >> 4; rw::l1m_unit(args, lds, h, s, tid);
        }
        for (int r3 = 0; r3 < REP_L1B; ++r3)
        { at::KVRegs KR; if (bx < 1024) at::kv_issue(args, bx >> 2, bx & 3, tid, KR);
          for (int u = bx; u < 1024; u += G) { const int un = u + G; at::prompt_unit(args, lds, u >> 2, u & 3, tid, KR, un < 1024 ? (un >> 2) : -1, un & 3); } }
        if (G < 256) for (int u = bx; u < 256; u += G) at::sample_unit(args, lds, u >> 1, u & 1, tid);
        at::copies(args, (size_t)bx * 512 + tid, (size_t)G * 512);
      }
        if (BOTH(PH_L1)) xcd_barrier(bar);
    }
    if (IN(PH_L3)) {
      for (int rep = 0; rep < REP_L3; ++rep) {
        for (int r2 = 0; r2 < REP_L3A; ++r2)
        for (int u = bx; u < 256; u += G) { const int h = u & 15, s = u >> 4; rw::l3s_unit(args, lds, h, s, tid); }
        for (int r2 = 0; r2 < REP_L3B; ++r2)
        for (int u = bx; u < 128; u += G) { const int h = u & 15, bg = u >> 4; rw::sample_unit(args, lds, h, bg, tid); }
        for (int r3 = 0; r3 < REP_L1C; ++r3)
        if (rep == 0 && G >= 256 && bx >= 128) for (int u = bx - 128; u < 256; u += G - 128) at::sample_unit(args, lds, u >> 1, u & 1, tid);
      }
        if (BOTH(PH_L3)) xcd_barrier(bar);
    }
    const pg8::Gemm g_out{(const bf16*)(ws + WS_MIX), (const bf16*)(ws + WS_WOUT), M, DM, DM, DM};
    const pg8::EpiOut E_out{args.in[I_XP], args.in[I_XS], TP, (bf16*)(ws + WS_XN), (float*)(ws + WS_SS1), DM};
    if (IN(PH_GOUT)) {
        pg8::StaticOrder S; S.init(TP, DM, G, bx);
        pg8::gemm_phase<pg8::EpiOut, pg8::StaticOrder, true, true>(lds, g_out, S, E_out);
        if (BOTH(PH_GOUT)) xcd_barrier(bar);
    }
    if (IN(PH_GGU)) {
        pg8::Gemm g{(const bf16*)(ws + WS_XN), (const bf16*)(ws + WS_WGU), M, 2 * DFF, DM, DM};
        FlagOrder S; S.so.init(M, 2 * DFF, G, bx); S.flag = (unsigned*)(ws + WS_CTL) + CW_OUTTAIL; S.want = OUT_TAIL_UNITS; S.pm_from = TP / pg8::BM; S.tmo = (unsigned*)(ws + WS_CTL) + CW_BAR + XB_TMO;
        const int nfull = S.so.nwg % G, t0 = (nfull + OUT_TAIL_UNITS <= G) ? nfull : 0;
        for (int t = bx - t0; t >= 0 && t < OUT_TAIL_UNITS; t += G) {
            OneUnit S1; S1.pm = TP / pg8::BM + (t & 1); S1.pn = t >> 1;
            pg8::gemm_phase<pg8::EpiOut, OneUnit, true, true>(lds, g_out, S1, E_out);
            asm volatile("s_waitcnt vmcnt(0)" ::: "memory");
            __syncthreads();
            if (tid == 0) { __builtin_amdgcn_fence(__ATOMIC_RELEASE, "agent"); asm volatile("s_waitcnt vmcnt(0)" ::: "memory"); (void)xb_add(S.flag, 1u); }
        }
        pg8::EpiGU E{(bf16*)(ws + WS_H), DFF, (const float*)(ws + WS_SS1), 1.f / DM, RMS_EPS};
        for (int rep = 0; rep < REP_GGU; ++rep) pg8::gemm_phase<pg8::EpiGU, FlagOrder, true, true>(lds, g, S, E);
#if LATE_WEIGHTS
        { const int c0 = t0 + OUT_TAIL_UNITS;
          if (nfull && bx >= c0) convert_late_weights(args, lds, (bx - c0) * NWAVES + wave, (G - c0) * NWAVES, wave, lane, 1);
          else if (!nfull || c0 >= G) convert_late_weights(args, lds, bx * NWAVES + wave, G * NWAVES, wave, lane, 1); }
#endif
        if (BOTH(PH_GGU)) xcd_barrier(bar);
    }
    if (IN(PH_GDN)) {
        {
            pg8::Gemm g{(const bf16*)(ws + WS_H), (const bf16*)(ws + WS_WDN), M, DM, DFF, DFF}; pg8::StaticOrder S; S.init(M, DM, G, bx); S.lim = GDN_FULL;
            pg8::EpiDown E{(bf16*)(ws + WS_XN), DM};
            pg8::gemm_phase<pg8::EpiDown, pg8::StaticOrder, true, true>(lds, g, S, E);
        }
        {
            pg8::Gemm g{(const bf16*)(ws + WS_H), (const bf16*)(ws + WS_WDN), M, DM, DFF / GDN_NSL, DFF}; pg8::SplitOrder S; S.so.init(M, DM, G, bx); S.base = GDN_FULL; S.nsl = GDN_NSL;
            pg8::EpiSlab E{(float*)(ws + WS_SLAB), nullptr, GDN_FULL, GDN_NSL, DM / 256, M / 256, (M / 256) * (DM / 256)};
            pg8::gemm_phase<pg8::EpiSlab, pg8::SplitOrder, true, true>(lds, g, S, E);
        }
        if (BOTH(PH_GDN)) xcd_barrier(bar);
    }
    if (IN(PH_FIN)) { final_norm(args, vcu, G, wave, lane); }
#undef IN
#undef BOTH
}

extern "C" void kernel_launch(void* const* d_in, const int* in_sizes, int n_in, void* d_out, int out_size, void* d_ws, size_t ws_size, hipStream_t stream) {
    static int grid = 0;
    if (grid == 0) {
        if (n_in != 26 || (size_t)out_size != O_END || ws_size < WS_END) { fprintf(stderr, "kernel_launch: unexpected shapes: n_in %d out %d ws %zu\n", n_in, out_size, ws_size); grid = -1; return; }
        int dev = 0, cus = 0, per_cu = 0;
        if (hipGetDevice(&dev) != hipSuccess || hipDeviceGetAttribute(&cus, hipDeviceAttributeMultiprocessorCount, dev) != hipSuccess) { grid = -1; return; }
        if (hipFuncSetAttribute((const void*)mk_fwd, hipFuncAttributeMaxDynamicSharedMemorySize, LDS_BYTES) != hipSuccess) { grid = -1; return; }
        if (hipOccupancyMaxActiveBlocksPerMultiprocessor(&per_cu, (const void*)mk_fwd, NWAVES * 64, LDS_BYTES) != hipSuccess || per_cu < 1) { fprintf(stderr, "kernel_launch: occupancy query says %d\n", per_cu); per_cu = 1; }
        (void)hipGetLastError();
        grid = cus;
    }
    if (grid < 0) return;
    (void)hipMemsetAsync((char*)d_ws + WS_CTL, 0, CTL_ZERO_BYTES, stream);
    Args a{};
    for (int i = 0; i < 26; ++i) a.in[i] = (const float*)d_in[i];
    a.out = (float*)d_out; a.ws = (unsigned char*)d_ws;
#if MK_ONE_LAUNCH
    a.ph_lo = 0; a.ph_hi = PH_N;
    hipLaunchKernelGGL(mk_fwd, dim3(grid), dim3(NWAVES * 64), LDS_BYTES, stream, a);
#else
    a.ph_lo = PH_PRO; a.ph_hi = PH_GIN + 1;
    hipLaunchKernelGGL(mk_fwd, dim3(grid), dim3(NWAVES * 64), LDS_BYTES, stream, a);
    (void)hipMemsetAsync((char*)d_ws + WS_CTL, 0, CTL_ZERO_BYTES, stream);
    a.ph_lo = PH_L1; a.ph_hi = PH_N;
    hipLaunchKernelGGL(mk_fwd, dim3(grid), dim3(NWAVES * 64), LDS_BYTES, stream, a);
#endif
}
```

```cpp
#define MK_ONE_LAUNCH 1
#define REP_PRO 1
#define REP_GIN 1
#define REP_L1 1
#define REP_L3 1
#define REP_GGU 1
#define REP_L1A 1
#define REP_L1B 1
#define REP_L1C 1
#define REP_L3A 1
#define REP_L3B 1
#define REP_PREP 1
#define REP_STA 1
#define REP_STBC 1
#define LATE_WEIGHTS 1
#include <hip/hip_runtime.h>
#include <cstdio>
#include <cstdint>
namespace pg8 {
#define PG8_LAS __attribute__((address_space(3)))
typedef unsigned short bf16_t;
typedef short bf16x8 __attribute__((ext_vector_type(8)));
typedef float f32x4 __attribute__((ext_vector_type(4)));
typedef unsigned u32x4 __attribute__((ext_vector_type(4)));
constexpr int BM = 256, BK = 64, HALF = 128, HTB = HALF * BK * 2  , STAGE_BYTES = 8 * HTB, NXCD = 8, WGM = 8;

__host__ __device__ __forceinline__ int lds_byte(int r, int c) { const int st = (r >> 4) * 2 + (c >> 5), rr = r & 15, cc = c & 31, ob = rr * 64 + cc * 2; return st * 1024 + (ob ^ (((ob >> 9) & 1) << 5)); }
__host__ __device__ __forceinline__ void stage_rc(int b, int& R, int& C) { const int st = b / 1024, sb = b % 1024, swz = sb ^ (((sb >> 9) & 1) << 5); R = (st >> 1) * 16 + swz / 64; C = (st & 1) * 32 + (swz % 64) / 2; }
__host__ __device__ __forceinline__ int perm32(int rho) { const int n = rho >> 4, i = rho & 15; return 8 * (i >> 2) + 4 * n + (i & 3); }

struct Unit { int pm, pn, ks; };
struct Gemm { const bf16_t* A; const bf16_t* Bt; int M, N, K, ld; };

struct StaticOrder {
    int nM, nN, nwg, G, c, lim;
    __host__ __device__ void init(int M, int N, int G_, int c_) { nM = M / BM; nN = N / BM; nwg = nM * nN; G = G_; c = c_; lim = nwg; }
    __host__ __device__ void unit_of(int L, Unit& u) const {
        int wgid = L; { const int q = nwg / NXCD, r = nwg % NXCD, xcd = wgid % NXCD, off = wgid / NXCD; wgid = (xcd < r ? xcd * (q + 1) : r * (q + 1) + (xcd - r) * q) + off; }
        const int nig = WGM * nN, gid = wgid / nig, fm = gid * WGM, gsz = (nM - fm) < WGM ? (nM - fm) : WGM;
        u.pm = fm + ((wgid % nig) % gsz); u.pn = (wgid % nig) / gsz; u.ks = 0;
    }
    __host__ __device__ bool next(int i, Unit& u) const {
        const long L = (long)i * G + c; if (L >= lim) return false;
        u.ks = 0;
        int wgid = (int)L; { const int q = nwg / NXCD, r = nwg % NXCD, xcd = wgid % NXCD, off = wgid / NXCD; wgid = (xcd < r ? xcd * (q + 1) : r * (q + 1) + (xcd - r) * q) + off; }
        const int nig = WGM * nN, gid = wgid / nig, fm = gid * WGM, gsz = (nM - fm) < WGM ? (nM - fm) : WGM;
        u.pm = fm + ((wgid % nig) % gsz); u.pn = (wgid % nig) / gsz; return true;
    }
    __device__ __forceinline__ void a_ready(const Unit&) const {}
    __device__ __forceinline__ void done(const Unit&) const {}
};
struct ColumnOrder {
    int first, stride, nM, pn;
    __host__ __device__ bool next(int i, Unit& u) const { if (first < 0) return false; const int k = first + i * stride; if (k >= nM) return false; u.pm = k; u.pn = pn; u.ks = 0; return true; }
    __device__ __forceinline__ void a_ready(const Unit&) const {}
    __device__ __forceinline__ void done(const Unit&) const {}
};
struct SplitOrder {
    StaticOrder so; int base, nsl;
    __host__ __device__ bool next(int i, Unit& u) const {
        const long q = (long)i * so.G + so.c; if (q >= (long)(so.nwg - base) * nsl) return false;
        so.unit_of(base + (int)(q / nsl), u); u.ks = (int)(q % nsl); return true;
    }
    __device__ __forceinline__ void a_ready(const Unit&) const {}
    __device__ __forceinline__ void done(const Unit&) const {}
};

typedef __bf16 bf16x2_t __attribute__((ext_vector_type(2)));
typedef float f32x2_t __attribute__((ext_vector_type(2)));
__device__ __forceinline__ unsigned cvt_pk_bf16(float lo, float hi) { const f32x2_t v = {lo, hi}; return __builtin_bit_cast(unsigned, __builtin_convertvector(v, bf16x2_t)); }
typedef unsigned u32x2 __attribute__((ext_vector_type(2)));

struct EpiP {
    static constexpr bool PERM = true, AFTER_DRAIN = false;
    bf16_t* O; int ldc;
    __device__ __forceinline__ void operator()(const f32x4 (&acc)[2][2][4][2], const Unit& u, int wr, int wc, int fr, int fq) const {
        const int row0 = u.pm * BM + wr * 64 + fr, col0 = u.pn * BM + wc * 32 + 8 * fq;
#pragma unroll
        for (int ai = 0; ai < 2; ++ai)
#pragma unroll
            for (int m = 0; m < 4; ++m) { bf16_t* rowp = O + (size_t)(row0 + ai * HALF + m * 16) * ldc + col0;
#pragma unroll
                for (int bj = 0; bj < 2; ++bj) { const f32x4 v0 = acc[ai][bj][m][0], v1 = acc[ai][bj][m][1];
                    u32x4 w; w.x = cvt_pk_bf16(v0[0], v0[1]); w.y = cvt_pk_bf16(v0[2], v0[3]); w.z = cvt_pk_bf16(v1[0], v1[1]); w.w = cvt_pk_bf16(v1[2], v1[3]);
                    *(u32x4*)(rowp + bj * HALF) = w; } }
    }
};
struct EpiOut {
    static constexpr bool PERM = true, AFTER_DRAIN = false;
    const float* base0; const float* base1; int split; bf16_t* xb; float* ss; int ldc;
    __device__ __forceinline__ void operator()(const f32x4 (&acc)[2][2][4][2], const Unit& u, int wr, int wc, int fr, int fq) const {
        const int row0 = u.pm * BM + wr * 64 + fr, col0 = u.pn * BM + wc * 32 + 8 * fq;
#pragma unroll
        for (int ai = 0; ai < 2; ++ai)
#pragma unroll
            for (int m = 0; m < 4; ++m) {
                const int row = row0 + ai * HALF + m * 16;
                const float* bp = (row < split ? base0 + (size_t)row * ldc : base1 + (size_t)(row - split) * ldc) + col0;
                float s = 0.f;
#pragma unroll
                for (int bj = 0; bj < 2; ++bj) {
                    const f32x4 o0 = *(const f32x4*)(bp + bj * HALF) + acc[ai][bj][m][0], o1 = *(const f32x4*)(bp + bj * HALF + 4) + acc[ai][bj][m][1];
                    s += ((o0[0] * o0[0] + o0[1] * o0[1]) + (o0[2] * o0[2] + o0[3] * o0[3])) + ((o1[0] * o1[0] + o1[1] * o1[1]) + (o1[2] * o1[2] + o1[3] * o1[3]));
                    u32x4 w; w.x = cvt_pk_bf16(o0[0], o0[1]); w.y = cvt_pk_bf16(o0[2], o0[3]); w.z = cvt_pk_bf16(o1[0], o1[1]); w.w = cvt_pk_bf16(o1[2], o1[3]);
                    *(u32x4*)(xb + (size_t)row * ldc + col0 + bj * HALF) = w;
                }
                s += __shfl_xor(s, 16); s += __shfl_xor(s, 32);
                if (fq == 0) atomicAdd(ss + row, s);
            }
    }
};
struct EpiDown {
    static constexpr bool PERM = true, AFTER_DRAIN = false;
    bf16_t* xb; int ldc;
    __device__ __forceinline__ void operator()(const f32x4 (&acc)[2][2][4][2], const Unit& u, int wr, int wc, int fr, int fq) const {
        const int row0 = u.pm * BM + wr * 64 + fr, col0 = u.pn * BM + wc * 32 + 8 * fq;
#pragma unroll
        for (int ai = 0; ai < 2; ++ai)
#pragma unroll
            for (int m = 0; m < 4; ++m) {
                bf16_t* rp = xb + (size_t)(row0 + ai * HALF + m * 16) * ldc + col0;
#pragma unroll
                for (int bj = 0; bj < 2; ++bj) {
                    const u32x4 b = *(const u32x4*)(rp + bj * HALF);
                    const f32x4 v0 = acc[ai][bj][m][0], v1 = acc[ai][bj][m][1];
                    u32x4 w;
                    w.x = cvt_pk_bf16(__builtin_bit_cast(float, b.x << 16) + v0[0], __builtin_bit_cast(float, b.x & 0xffff0000u) + v0[1]);
                    w.y = cvt_pk_bf16(__builtin_bit_cast(float, b.y << 16) + v0[2], __builtin_bit_cast(float, b.y & 0xffff0000u) + v0[3]);
                    w.z = cvt_pk_bf16(__builtin_bit_cast(float, b.z << 16) + v1[0], __builtin_bit_cast(float, b.z & 0xffff0000u) + v1[1]);
                    w.w = cvt_pk_bf16(__builtin_bit_cast(float, b.w << 16) + v1[2], __builtin_bit_cast(float, b.w & 0xffff0000u) + v1[3]);
                    *(u32x4*)(rp + bj * HALF) = w;
                }
            }
    }
};
struct EpiGU {
    static constexpr bool PERM = true, AFTER_DRAIN = false;
    bf16_t* H; int ldh; const float* ss; float inv_n, eps;
    __device__ __forceinline__ void operator()(const f32x4 (&acc)[2][2][4][2], const Unit& u, int wr, int wc, int fr, int fq) const {
        const int row0 = u.pm * BM + wr * 64 + fr, col0 = u.pn * HALF + wc * 32 + 8 * fq;
#pragma unroll
        for (int ai = 0; ai < 2; ++ai)
#pragma unroll
            for (int m = 0; m < 4; ++m) {
                const int row = row0 + ai * HALF + m * 16;
                const float rs = __builtin_amdgcn_rsqf(ss[row] * inv_n + eps);
                float h[8];
#pragma unroll
                for (int n = 0; n < 2; ++n)
#pragma unroll
                    for (int j = 0; j < 4; ++j) {
                        const float g = acc[ai][0][m][n][j] * rs, up = acc[ai][1][m][n][j] * rs;
                        const float sg = __builtin_amdgcn_rcpf(1.0f + __expf(-g));
                        h[n * 4 + j] = g * sg * up;
                    }
                u32x4 w; w.x = cvt_pk_bf16(h[0], h[1]); w.y = cvt_pk_bf16(h[2], h[3]); w.z = cvt_pk_bf16(h[4], h[5]); w.w = cvt_pk_bf16(h[6], h[7]);
                *(u32x4*)(H + (size_t)row * ldh + col0) = w;
            }
    }
};

struct EpiSlab {
    static constexpr bool PERM = false, AFTER_DRAIN = false;
    float* slab; const StaticOrder* so_unused; int base, nsl, nN, nM, nwg;
    __device__ __forceinline__ void operator()(const f32x4 (&acc)[2][2][4][2], const Unit& u, int wr, int wc, int fr, int fq) const {
        bf16_t* sp = (bf16_t*)slab + ((size_t)(tail_index(u) * nsl + u.ks) << 16);
        const int r0 = wr * 64 + fr, c0 = wc * 32 + 4 * fq;
#pragma unroll
        for (int ai = 0; ai < 2; ++ai)
#pragma unroll
            for (int m = 0; m < 4; ++m)
#pragma unroll
                for (int bj = 0; bj < 2; ++bj)
#pragma unroll
                    for (int n = 0; n < 2; ++n) { const f32x4 v = acc[ai][bj][m][n]; u32x2 w; w.x = cvt_pk_bf16(v[0], v[1]); w.y = cvt_pk_bf16(v[2], v[3]);
                        *(u32x2*)(sp + (size_t)(r0 + ai * HALF + m * 16) * 256 + c0 + bj * HALF + n * 16) = w; }
    }
    __device__ __forceinline__ int tail_index(const Unit& u) const {
        StaticOrder so; so.nM = nM; so.nN = nN; so.nwg = nwg; so.G = 0; so.c = 0; so.lim = nwg;
        int t = 0;
        for (int L = base; L < nwg; ++L) { Unit v; so.unit_of(L, v); if (v.pm == u.pm && v.pn == u.pn) t = L - base; }
        return t;
    }
};
template <class Epi, class Sched, bool ALIGN_EPI = false, bool SP2 = false, bool NARROW = false>
__device__ __forceinline__ void gemm_phase(PG8_LAS unsigned char* lds, const Gemm g, const Sched& S, const Epi& E) {
    const int tid = threadIdx.x, wid = __builtin_amdgcn_readfirstlane(tid >> 6), lane = tid & 63, wr = wid >> 2, wc = wid & 3, fr = lane & 15, fq = lane >> 4;
    const int K = g.K, nt = K / BK;
    unsigned voffA[2], voffB[2];
#pragma unroll
    for (int i = 0; i < 2; ++i) { int R, C; stage_rc(tid * 16 + i * 8192, R, C); const int Rb = Epi::PERM ? ((R & ~31) + perm32(R & 31)) : R;
        voffA[i] = (unsigned)(R * g.ld + C) * 2u; voffB[i] = (unsigned)(Rb * g.ld + C) * 2u; }
    const size_t kstep = (size_t)(BK * 2);
    const size_t hstep = (size_t)HALF * g.ld * 2;
    const size_t tstep = 2 * hstep;
    const unsigned ldsw = (unsigned)wid * 1024u;
    const int aoff = lds_byte(wr * 64 + fr, fq * 8), boff = lds_byte(wc * 32 + fr, fq * 8);
#define PG8_SA(b, h) (((b) * 2 + (h)) * HTB)
#define PG8_SB(b, h) ((4 + (b) * 2 + (h)) * HTB)
#define PG8_STAGE(bufoff, gbase, voff) do { _Pragma("unroll") for (int _i = 0; _i < 2; ++_i) \
        __builtin_amdgcn_global_load_lds((const unsigned*)((const char*)(gbase) + (voff)[_i]), (PG8_LAS unsigned*)(lds + (bufoff) + ldsw + _i * 8192), 16, 0, 0); } while (0)
#define PG8_LDA(dst, b, h) do { _Pragma("unroll") for (int m = 0; m < 4; ++m) _Pragma("unroll") for (int k = 0; k < 2; ++k) dst[m][k] = *(const PG8_LAS bf16x8*)(lds + PG8_SA(b, h) + aoff + m * 2048 + k * 1024); } while (0)
#define PG8_LDB(dst, b, h) do { _Pragma("unroll") for (int n = 0; n < 2; ++n) _Pragma("unroll") for (int k = 0; k < 2; ++k) dst[n][k] = *(const PG8_LAS bf16x8*)(lds + PG8_SB(b, h) + boff + n * 2048 + k * 1024); } while (0)
#define PG8_MMA(ai, bj, At, Bt) do { if (NARROW && !((bj) == 0 && wc == 0)) break; __builtin_amdgcn_s_setprio(1); _Pragma("unroll") for (int m = 0; m < 4; ++m) _Pragma("unroll") for (int n = 0; n < 2; ++n) _Pragma("unroll") for (int k = 0; k < 2; ++k) \
        acc[ai][bj][m][n] = __builtin_amdgcn_mfma_f32_16x16x32_bf16(Bt[n][k], At[m][k], acc[ai][bj][m][n], 0, 0, 0); __builtin_amdgcn_s_setprio(0); } while (0)
#define PG8_WAIT_V(n) asm volatile("s_waitcnt vmcnt(" #n ")" ::: "memory")
#define PG8_WAIT_L(n) asm volatile("s_waitcnt lgkmcnt(" #n ")" ::: "memory")
#define PG8_BAR __builtin_amdgcn_s_barrier()
#define PG8_SCHED __builtin_amdgcn_sched_barrier(0)
    Unit cur, nxt; int ui = 0;
    if (!S.next(0, cur)) return;
    f32x4 acc[2][2][4][2];
#pragma unroll
    for (int a = 0; a < 2; ++a)
#pragma unroll
        for (int b = 0; b < 2; ++b)
#pragma unroll
            for (int m = 0; m < 4; ++m)
#pragma unroll
                for (int n = 0; n < 2; ++n) acc[a][b][m][n] = (f32x4){0.f, 0.f, 0.f, 0.f};
    bf16x8 At[4][2], B0[2][2], B1[2][2];
    const size_t sstep = (size_t)K * 2;
    const char* cA = (const char*)g.A + (size_t)cur.pm * tstep + (size_t)cur.ks * sstep; const char* cB = (const char*)g.Bt + (size_t)cur.pn * tstep + (size_t)cur.ks * sstep;
    S.a_ready(cur);
    if constexpr (SP2) {
        PG8_STAGE(PG8_SB(0, 0), cB, voffB); PG8_STAGE(PG8_SB(0, 1), cB + hstep, voffB); PG8_STAGE(PG8_SA(0, 0), cA, voffA); PG8_STAGE(PG8_SA(0, 1), cA + hstep, voffA);
        if (wr == 1) PG8_BAR;
        PG8_WAIT_V(2); PG8_BAR;
        PG8_STAGE(PG8_SB(1, 0), cB + kstep, voffB); PG8_STAGE(PG8_SA(1, 0), cA + kstep, voffA); PG8_STAGE(PG8_SB(1, 1), cB + hstep + kstep, voffB);
        PG8_WAIT_V(6); PG8_BAR;
    } else {
        PG8_STAGE(PG8_SB(0, 0), cB, voffB); PG8_STAGE(PG8_SA(0, 0), cA, voffA); PG8_STAGE(PG8_SB(0, 1), cB + hstep, voffB); PG8_STAGE(PG8_SA(0, 1), cA + hstep, voffA);
        if (wr == 1) PG8_BAR;
        PG8_WAIT_V(4); PG8_BAR;
        PG8_STAGE(PG8_SB(1, 0), cB + kstep, voffB); PG8_STAGE(PG8_SA(1, 0), cA + kstep, voffA); PG8_STAGE(PG8_SB(1, 1), cB + hstep + kstep, voffB);
        PG8_WAIT_V(6); PG8_BAR;
    }
    for (;;) {
        const bool has_next = S.next(ui + 1, nxt);
        const char* nA = has_next ? (const char*)g.A + (size_t)nxt.pm * tstep + (size_t)nxt.ks * sstep : cA; const char* nB = has_next ? (const char*)g.Bt + (size_t)nxt.pn * tstep + (size_t)nxt.ks * sstep : cB;
        for (int t = 0; t < nt; t += 2) {
            const bool last = (t == nt - 2);
            const char* a1 = cA + (size_t)(t + 1) * kstep;
            const char* a2 = last ? nA : cA + (size_t)(t + 2) * kstep; const char* b2 = last ? nB : cB + (size_t)(t + 2) * kstep;
            const char* a3 = a2 + kstep; const char* b3 = b2 + kstep;
            if (last && has_next) S.a_ready(nxt);
            if constexpr (SP2) {
            PG8_LDB(B0, 0, 0); PG8_LDB(B1, 0, 1); PG8_SCHED; PG8_LDA(At, 0, 0); PG8_STAGE(PG8_SA(1, 1), a1 + hstep, voffA);
            PG8_WAIT_V(8); PG8_WAIT_L(0); PG8_BAR; PG8_MMA(0, 0, At, B0); PG8_MMA(0, 1, At, B1); PG8_BAR; PG8_SCHED;
            PG8_LDA(At, 0, 1); PG8_STAGE(PG8_SB(0, 0), b2, voffB); PG8_STAGE(PG8_SB(0, 1), b2 + hstep, voffB); PG8_STAGE(PG8_SA(0, 0), a2, voffA);
            PG8_WAIT_V(8); PG8_WAIT_L(0); PG8_BAR; PG8_MMA(1, 0, At, B0); PG8_MMA(1, 1, At, B1); PG8_BAR; PG8_SCHED;
            PG8_LDB(B0, 1, 0); PG8_LDB(B1, 1, 1); PG8_SCHED; PG8_LDA(At, 1, 0); PG8_STAGE(PG8_SA(0, 1), a2 + hstep, voffA);
            PG8_WAIT_V(8); PG8_WAIT_L(0); PG8_BAR; PG8_MMA(0, 0, At, B0); PG8_MMA(0, 1, At, B1); PG8_BAR; PG8_SCHED;
            PG8_LDA(At, 1, 1); PG8_STAGE(PG8_SB(1, 0), b3, voffB); PG8_STAGE(PG8_SB(1, 1), b3 + hstep, voffB); PG8_STAGE(PG8_SA(1, 0), a3, voffA);
            PG8_WAIT_V(8); PG8_WAIT_L(0); PG8_BAR; PG8_MMA(1, 0, At, B0); PG8_MMA(1, 1, At, B1); PG8_BAR; PG8_SCHED;
            } else {
            PG8_LDB(B0, 0, 0); PG8_SCHED; PG8_LDA(At, 0, 0); PG8_STAGE(PG8_SA(1, 1), a1 + hstep, voffA);
            PG8_WAIT_L(8); PG8_BAR; PG8_WAIT_L(0); PG8_MMA(0, 0, At, B0); PG8_BAR; PG8_SCHED;
            PG8_LDB(B1, 0, 1); PG8_STAGE(PG8_SB(0, 0), b2, voffB);
            PG8_BAR; PG8_WAIT_L(0); PG8_MMA(0, 1, At, B1); PG8_BAR;
            PG8_LDA(At, 0, 1); PG8_STAGE(PG8_SA(0, 0), a2, voffA);
            PG8_BAR; PG8_WAIT_L(0); PG8_MMA(1, 0, At, B0); PG8_BAR; PG8_SCHED;
            PG8_STAGE(PG8_SB(0, 1), b2 + hstep, voffB);
            PG8_WAIT_V(6); PG8_BAR; PG8_MMA(1, 1, At, B1); PG8_BAR;
            PG8_LDB(B0, 1, 0); PG8_SCHED; PG8_LDA(At, 1, 0); PG8_STAGE(PG8_SA(0, 1), a2 + hstep, voffA);
            PG8_WAIT_L(8); PG8_BAR; PG8_WAIT_L(0); PG8_MMA(0, 0, At, B0); PG8_BAR; PG8_SCHED;
            PG8_LDB(B1, 1, 1); PG8_STAGE(PG8_SB(1, 0), b3, voffB);
            PG8_BAR; PG8_WAIT_L(0); PG8_MMA(0, 1, At, B1); PG8_BAR;
            PG8_LDA(At, 1, 1); PG8_STAGE(PG8_SA(1, 0), a3, voffA);
            PG8_BAR; PG8_WAIT_L(0); PG8_MMA(1, 0, At, B0); PG8_BAR; PG8_SCHED;
            PG8_STAGE(PG8_SB(1, 1), b3 + hstep, voffB);
            PG8_WAIT_V(6); PG8_BAR; PG8_MMA(1, 1, At, B1); PG8_BAR;
            }
        }
        if constexpr (ALIGN_EPI) { if (wr == 0) PG8_BAR; }
        if constexpr (!Epi::AFTER_DRAIN) { E(acc, cur, wr, wc, fr, fq); S.done(cur); }
        if (!has_next) break;
#pragma unroll
        for (int a = 0; a < 2; ++a)
#pragma unroll
            for (int b = 0; b < 2; ++b)
#pragma unroll
                for (int m = 0; m < 4; ++m)
#pragma unroll
                    for (int n = 0; n < 2; ++n) acc[a][b][m][n] = (f32x4){0.f, 0.f, 0.f, 0.f};
        cur = nxt; cA = nA; cB = nB; ++ui;
        if constexpr (ALIGN_EPI) { if (wr == 1) PG8_BAR; }
    }
    PG8_WAIT_V(0);
    if constexpr (!ALIGN_EPI) { if (wr == 0) PG8_BAR; }
    PG8_BAR;
    if constexpr (Epi::AFTER_DRAIN) { E.fused(acc, cur, wr, wc, fr, fq, lds, wid, lane); S.done(cur); }
#undef PG8_SA
#undef PG8_SB
#undef PG8_STAGE
#undef PG8_LDA
#undef PG8_LDB
#undef PG8_MMA
#undef PG8_WAIT_V
#undef PG8_WAIT_L
#undef PG8_BAR
#undef PG8_SCHED
}
}

constexpr int NWAVES = 8;
constexpr int DM = 2048, TP = 16384, NB = 128, TS = 4, MS = NB * TS, M = TP + MS;
constexpr int HD = 64, NH = 16, CW = 1024;
constexpr int RCOLS = 3360, INC = 4896, PPITCH = 5120;
constexpr int C_R = 0, C_K = 1024, C_V = 2048, C_XW = 3072, C_XA = 3136, C_XG = 3200, C_Q = 3360, C_SK = 4384, C_SV = 4640;
constexpr int KVH = 4, WIN = 128, KVW = KVH * HD;
constexpr int DFF = 5632;
constexpr float RMS_EPS = 1e-5f, GN_EPS = 64e-5f;
constexpr size_t O_YP = 0, O_YS = 33554432, O_PST = 34603008, O_PSH = 34668544, O_PCK = 34671904, O_PCV = 34704672,
                 O_SST = 34737440, O_SSH = 43126048, O_SCK = 43556128, O_SCV = 47750432, O_END = 51944736;
constexpr size_t MiB = 1u << 20;
constexpr size_t WS_CTL = 0, CTL_ZERO_BYTES = 64 * 1024;
constexpr size_t WS_SS1 = 1 * MiB, WS_SS2 = 1 * MiB + 128 * 1024;
constexpr size_t WS_W2T = 2 * MiB, WS_A2T = 2 * MiB + 128 * 1024, WS_G2T = 2 * MiB + 256 * 1024;
constexpr size_t WS_WIN = 4 * MiB, WS_WOUT = 24 * MiB, WS_WGU = 32 * MiB, WS_WDN = 76 * MiB;
constexpr size_t WS_XN = 98 * MiB, WS_MIX = 164 * MiB, WS_P = 230 * MiB, WS_H = 230 * MiB, WS_SEG = 412 * MiB, WS_SST = 420 * MiB, WS_TL = 424 * MiB, WS_END = 640 * MiB;
constexpr size_t TL_REC = 41472;
static_assert(WS_TL + (size_t)16 * 256 * TL_REC <= WS_END, "ws map (operand records)");
static_assert(WS_WIN + (size_t)PPITCH * DM * 2 <= WS_WOUT && WS_WOUT + (size_t)DM * DM * 2 <= WS_WGU && WS_WGU + (size_t)2 * DFF * DM * 2 <= WS_WDN && WS_WDN + (size_t)DM * DFF * 2 <= WS_XN, "ws map (weights)");
static_assert(WS_XN + (size_t)M * DM * 2 <= WS_MIX && WS_MIX + (size_t)M * DM * 2 <= WS_P && WS_P + (size_t)M * PPITCH * 2 <= WS_SEG && WS_H + (size_t)M * DFF * 2 <= WS_SEG, "ws map (activations)");
constexpr int CW_BAR = 4096, CW_OUTTAIL = 2048;
constexpr int NGIN = 4864;
constexpr int GDN_FULL = 512, GDN_NSL = 11;
constexpr size_t WS_SLAB = 592 * MiB;
static_assert(DFF % (GDN_NSL * 128) == 0, "slab map");
constexpr int RING_BYTES = 131072, LDS_BYTES = 163840, MISC_OFF = LDS_BYTES - 256;

#define GAS __attribute__((address_space(1)))
#define LAS __attribute__((address_space(3)))
typedef unsigned short bf16;
typedef unsigned v4u __attribute__((ext_vector_type(4)));
typedef float f32x4 __attribute__((ext_vector_type(4)));
typedef short bf16x8 __attribute__((ext_vector_type(8)));
#define LDS_WAIT() asm volatile("s_waitcnt lgkmcnt(0)" ::: "memory")
#define VM_WAIT() asm volatile("s_waitcnt vmcnt(0)" ::: "memory")
__device__ __forceinline__ unsigned f2bf(float f) { unsigned u = __builtin_bit_cast(unsigned, f); return (u + 0x7fffu + ((u >> 16) & 1u)) >> 16; }
__device__ __forceinline__ unsigned pk2(float lo, float hi) { return pg8::cvt_pk_bf16(lo, hi); }
__device__ __forceinline__ float bf2f(unsigned short b) { return __builtin_bit_cast(float, (unsigned)b << 16); }
__device__ __forceinline__ float bflo(unsigned w) { return __builtin_bit_cast(float, w << 16); }
__device__ __forceinline__ float bfhi(unsigned w) { return __builtin_bit_cast(float, w & 0xffff0000u); }
__device__ __forceinline__ float sigmoidf_(float x) { return 1.0f / (1.0f + __expf(-x)); }
__device__ __forceinline__ float wave_sum(float v) {
#pragma unroll
    for (int o = 1; o < 64; o <<= 1) v += __shfl_xor(v, o);
    return v;
}
__device__ __forceinline__ float wave_max(float v) {
#pragma unroll
    for (int o = 1; o < 64; o <<= 1) v = fmaxf(v, __shfl_xor(v, o));
    return v;
}

#define XB_TMO      128
#define XB_XCNT(j)  (256  + 64 * (j))
#define XB_XSUB(j)  (1280 + 64 * (j))
#define XB_XGEN(j)  (2304 + 64 * (j))
#define XB_TOP      3328
#define XB_TOPGEN   3392
#define XCD_BAR_WORDS 3456
#define XB_SPIN_CAP (1u << 18)
__device__ __forceinline__ unsigned xb_ld(unsigned* p)              { return __hip_atomic_load(p, __ATOMIC_RELAXED, __HIP_MEMORY_SCOPE_AGENT); }
__device__ __forceinline__ unsigned xb_add(unsigned* p, unsigned v) { return __hip_atomic_fetch_add(p, v, __ATOMIC_RELAXED, __HIP_MEMORY_SCOPE_AGENT); }
__device__ __forceinline__ unsigned xb_xcc_id() { return (unsigned)__builtin_amdgcn_s_getreg((3 << 11) | 20) & 0xFu; }
#define XB_SPIN(cond, bar) do { unsigned _sp = 0; while (cond) { __builtin_amdgcn_s_sleep(1); \
    if ((++_sp & 255u) == 0u) { if (xb_ld(&(bar)[XB_TMO])) break; if (_sp > XB_SPIN_CAP) { atomicAdd(&(bar)[XB_TMO], 1u); break; } } } } while (0)
struct XcdBarrier { unsigned* bar; unsigned x; volatile LAS unsigned* st; };
__device__ __forceinline__ XcdBarrier xcd_barrier_post(unsigned* bar, volatile LAS unsigned* st) {
    XcdBarrier b; b.bar = bar; b.x = xb_xcc_id(); b.st = st;
    if (threadIdx.x == 0) (void)xb_add(&bar[XB_XCNT(b.x)], 1u);
    return b;
}
__device__ __forceinline__ void xcd_barrier_complete(unsigned* bar, unsigned x, unsigned& nloc, unsigned& nx) {
    const unsigned G = gridDim.x * gridDim.y * gridDim.z;
    unsigned sum, cnt, mine, sp = 0u;
    for (;;) {
        sum = 0u; cnt = 0u; mine = 0u;
#pragma unroll
        for (unsigned j = 0; j < 16; ++j) { const unsigned c = xb_ld(&bar[XB_XCNT(j)]); sum += c; cnt += (c > 0u) ? 1u : 0u; mine = (j == x) ? c : mine; }
        if (sum == G) break;
        __builtin_amdgcn_s_sleep(1);
        if ((++sp & 255u) == 0u) { if (xb_ld(&bar[XB_TMO])) break; if (sp > XB_SPIN_CAP) { atomicAdd(&bar[XB_TMO], 1u); break; } }
    }
    nloc = mine > 0u ? mine : 1u; nx = cnt > 0u ? cnt : 1u;
}
__device__ __forceinline__ void xcd_barrier(const XcdBarrier& b) {
    asm volatile("s_waitcnt vmcnt(0)" ::: "memory");
    __syncthreads();
    if (threadIdx.x == 0) {
        unsigned* bar = b.bar;
        __builtin_amdgcn_s_waitcnt(0);
        unsigned nloc = b.st[0], nx = b.st[1];
        if (nloc == 0u) { xcd_barrier_complete(bar, b.x, nloc, nx); b.st[0] = nloc; b.st[1] = nx; }
        const unsigned old = xb_add(&bar[XB_XSUB(b.x)], 1u);
        const unsigned gen = old / nloc;
        if (old + 1u == (gen + 1u) * nloc) {
            __builtin_amdgcn_fence(__ATOMIC_RELEASE, "agent");
            asm volatile("s_waitcnt vmcnt(0)" ::: "memory");
            const unsigned og = xb_add(&bar[XB_TOP], 1u);
            const unsigned tg = og / nx;
            if (og + 1u == (tg + 1u) * nx) xb_add(&bar[XB_TOPGEN], 1u);
            else XB_SPIN(xb_ld(&bar[XB_TOPGEN]) == tg, bar);
            __builtin_amdgcn_fence(__ATOMIC_ACQUIRE, "agent");
            xb_add(&bar[XB_XGEN(b.x)], 1u);
            asm volatile("s_waitcnt vmcnt(0)" ::: "memory");
        } else {
            XB_SPIN(xb_ld(&bar[XB_XGEN(b.x)]) == gen, bar);
            __builtin_amdgcn_fence(__ATOMIC_ACQUIRE, "agent");
            asm volatile("s_waitcnt vmcnt(0)" ::: "memory");
        }
    }
    __syncthreads();
}

struct Args { const float* in[26]; float* out; unsigned char* ws; int ph_lo, ph_hi; };
enum { I_XP = 0, I_XS, I_STATE, I_SHIFT, I_CK, I_CV, I_NATT, I_WIN, I_MU, I_W0, I_W2, I_A0, I_A2, I_G2, I_KK, I_KA, I_RK, I_LNW, I_LNB, I_SINK, I_WOUT, I_NFFN, I_WG, I_WU, I_WD, I_NFIN };

__device__ __forceinline__ void p0_transpose_item(const float* W, int N, bf16* WT, int ldk, int k0, int n0, int row0, int ncols, const float* ksc, LAS float* scr, int lane) {
    const int n4 = lane & 15, kl = lane >> 4;
    f32x4 v[16];
#pragma unroll
    for (int i = 0; i < 16; ++i) { v[i] = (f32x4){0.f, 0.f, 0.f, 0.f}; if (4 * n4 < ncols) v[i] = *(const f32x4*)(W + (size_t)(k0 + 4 * i + kl) * N + n0 + 4 * n4); }
#pragma unroll
    for (int i = 0; i < 16; ++i) { const int k = 4 * i + kl; const float sc = ksc ? ksc[k0 + k] : 1.0f; LAS float* d = scr + k * 65 + 4 * n4;
        d[0] = v[i].x * sc; d[1] = v[i].y * sc; d[2] = v[i].z * sc; d[3] = v[i].w * sc; }
    LDS_WAIT(); asm volatile("" ::: "memory");
    const int c = lane & 7;
#pragma unroll
    for (int j = 0; j < 8; ++j) { const int n = (lane >> 3) + 8 * j; const LAS float* s = scr + (8 * c) * 65 + n;
        v4u o; o.x = pk2(s[0 * 65], s[1 * 65]); o.y = pk2(s[2 * 65], s[3 * 65]); o.z = pk2(s[4 * 65], s[5 * 65]); o.w = pk2(s[6 * 65], s[7 * 65]);
        if (n < ncols) *(GAS v4u*)(WT + (size_t)(row0 + n) * ldk + k0 + 8 * c) = o; }
    LDS_WAIT(); asm volatile("" ::: "memory");
}
__device__ __forceinline__ void convert_late_weights(const Args& a, LAS unsigned char* lds, int gw, int NGW, int wave, int lane, int part) {
    unsigned char* ws = a.ws;
    LAS float* scr = (LAS float*)(lds + wave * 16640);
    constexpr int I_OUT = (DM / 64) * (DM / 64), I_GU = (DM / 64) * (DFF / 64), I_DN = (DFF / 64) * (DM / 64);
    bf16* Wout = (bf16*)(ws + WS_WOUT); bf16* Wgu = (bf16*)(ws + WS_WGU); bf16* Wdn = (bf16*)(ws + WS_WDN);
    const int lo = part == 1 ? I_OUT + 2 * I_GU : 0, hi = part == 0 ? I_OUT + 2 * I_GU : I_OUT + 2 * I_GU + I_DN;
    for (int it = lo + gw; it < hi; it += NGW) {
        int r = it;
        if (r < I_OUT) { const int nblk = DM / 64, kb = r / nblk, nb = r % nblk; p0_transpose_item(a.in[I_WOUT], DM, Wout, DM, 64 * kb, 64 * nb, 64 * nb, 64, nullptr, scr, lane); continue; } r -= I_OUT;
        if (r < 2 * I_GU) { const int s = r / I_GU; r -= s * I_GU; const int nblk = DFF / 64, kb = r / nblk, nb = r % nblk, f0 = 64 * nb;
            p0_transpose_item(a.in[s ? I_WU : I_WG], DFF, Wgu, DM, 64 * kb, f0, 256 * (f0 >> 7) + 128 * s + (f0 & 127), 64, a.in[I_NFFN], scr, lane); continue; } r -= 2 * I_GU;
        { const int nblk = DM / 64, kb = r / nblk, nb = r % nblk; p0_transpose_item(a.in[I_WD], DM, Wdn, DFF, 64 * kb, 64 * nb, 64 * nb, 64, nullptr, scr, lane); }
    }
}
__device__ __forceinline__ void rms_row_to_bf16(const float* xrow, const float* g, bf16* orow, int lane) {
    const GAS f32x4* xr = (const GAS f32x4*)xrow + lane;
    f32x4 v[8]; float s = 0.f;
#pragma unroll
    for (int j = 0; j < 8; ++j) { v[j] = __builtin_nontemporal_load((const f32x4*)&xr[64 * j]); s += (v[j].x * v[j].x + v[j].y * v[j].y) + (v[j].z * v[j].z + v[j].w * v[j].w); }
    const float rs = 1.0f / sqrtf(wave_sum(s) * (1.f / DM) + RMS_EPS);
    GAS unsigned long long* o8 = (GAS unsigned long long*)orow + lane;
#pragma unroll
    for (int j = 0; j < 8; ++j) { const f32x4 gg = *((const f32x4*)g + lane + 64 * j);
        o8[64 * j] = (unsigned long long)pk2(v[j].x * rs * gg.x, v[j].y * rs * gg.y) | ((unsigned long long)pk2(v[j].z * rs * gg.z, v[j].w * rs * gg.w) << 32); }
}

__device__ __forceinline__ void p0_prologue(const Args& a, LAS unsigned char* lds, int vcu, int G, int wave, int lane) {
    unsigned char* ws = a.ws;
    LAS float* scr = (LAS float*)(lds + wave * 16640);
    const int gw = vcu * NWAVES + wave, NGW = G * NWAVES;
    constexpr int NBI = (INC + 63) / 64, I_IN = (DM / 64) * NBI;
    bf16* Win = (bf16*)(ws + WS_WIN);
    for (int it = gw; it < I_IN; it += NGW) { const int kb = it / NBI, nb = it % NBI; p0_transpose_item(a.in[I_WIN], INC, Win, DM, 64 * kb, 64 * nb, 64 * nb, (INC - 64 * nb) < 64 ? (INC - 64 * nb) : 64, nullptr, scr, lane); }
#if !LATE_WEIGHTS
    convert_late_weights(a, lds, gw, NGW, wave, lane, 2);
#endif
    { GAS v4u* z = (GAS v4u*)(Win + (size_t)INC * DM); const int n16 = (PPITCH - INC) * DM * 2 / 16;
      for (int i = gw * 64 + lane; i < n16; i += NGW * 64) z[i] = (v4u){0u, 0u, 0u, 0u}; }
    { float* s1 = (float*)(ws + WS_SS1); float* s2 = (float*)(ws + WS_SS2);
      for (int i = gw * 64 + lane; i < M; i += NGW * 64) { s1[i] = 0.f; s2[i] = 0.f; } }
    { bf16* w2t = (bf16*)(ws + WS_W2T); bf16* a2t = (bf16*)(ws + WS_A2T); bf16* g2t = (bf16*)(ws + WS_G2T);
      for (int i = gw * 64 + lane; i < CW * 64; i += NGW * 64) { const int c = i >> 6, k = i & 63; w2t[i] = (bf16)f2bf(a.in[I_W2][(size_t)k * CW + c]); a2t[i] = (bf16)f2bf(a.in[I_A2][(size_t)k * CW + c]); }
      for (int i = gw * 64 + lane; i < CW * 160; i += NGW * 64) { const int c = i / 160, k = i % 160; g2t[i] = (bf16)f2bf(a.in[I_G2][(size_t)k * CW + c]); } }
    bf16* XN = (bf16*)(ws + WS_XN);
    for (int m = gw; m < M; m += NGW) {
        const float* xr = m < TP ? a.in[I_XP] + (size_t)m * DM : a.in[I_XS] + (size_t)(m - TP) * DM;
        rms_row_to_bf16(xr, a.in[I_NATT], XN + (size_t)m * DM, lane);
    }
}

__device__ __forceinline__ void final_norm(const Args& a, int vcu, int G, int wave, int lane) {
    const int gw = vcu * NWAVES + wave, NGW = G * NWAVES;
    const f32x4* gf = (const f32x4*)a.in[I_NFIN];
    const bf16* slab = (const bf16*)(a.ws + WS_SLAB);
    const bf16* XB = (const bf16*)(a.ws + WS_XN);
    pg8::StaticOrder so; so.init(M, DM, G, 0);
    for (int m = gw; m < M; m += NGW) {
        const pg8::u32x2* xr = (const pg8::u32x2*)(XB + (size_t)m * DM) + lane;
        f32x4 v[8];
#pragma unroll
        for (int j = 0; j < 8; ++j) { const pg8::u32x2 w = xr[64 * j]; v[j] = (f32x4){bflo(w.x), bfhi(w.x), bflo(w.y), bfhi(w.y)}; }
        const int pm = m >> 8, rl = m & 255;
        for (int t = 0; t < so.nwg - GDN_FULL; ++t) {
            pg8::Unit u; so.unit_of(GDN_FULL + t, u);
            if (u.pm == pm) {
                f32x4 s = {0.f, 0.f, 0.f, 0.f};
                for (int ks = 0; ks < GDN_NSL; ++ks) { const pg8::u32x2 w = *(const pg8::u32x2*)(slab + ((size_t)(t * GDN_NSL + ks) << 16) + (size_t)rl * 256 + 4 * lane);
                    s += (f32x4){bflo(w.x), bfhi(w.x), bflo(w.y), bfhi(w.y)}; }
#pragma unroll
                for (int j = 0; j < 8; ++j) if (j == u.pn) v[j] += s;
            }
        }
        float ss = 0.f;
#pragma unroll
        for (int j = 0; j < 8; ++j) ss += (v[j].x * v[j].x + v[j].y * v[j].y) + (v[j].z * v[j].z + v[j].w * v[j].w);
        const float rs = 1.0f / sqrtf(wave_sum(ss) * (1.f / DM) + RMS_EPS);
        GAS f32x4* yr = (GAS f32x4*)(a.out + (size_t)m * DM) + lane;
#pragma unroll
        for (int j = 0; j < 8; ++j) { const f32x4 g = gf[lane + 64 * j]; __builtin_nontemporal_store(v[j] * rs * g, (f32x4*)&yr[64 * j]); }
    }
}

namespace rw {
constexpr int SEGS = 16, SEGLEN = TP / SEGS, BLK = 64, NBLK = SEGLEN / BLK;
constexpr int T_R = 0, T_W = 16384, T_K = 32768, T_V = 49152, T_NKK = 65536, T_B = 81920, T_G = 98304, T_OUT = 114688;
constexpr int TWP = 72, SGP = 168;
constexpr int ST_TW = 114688, ST_XA = ST_TW + 64 * TWP * 2, ST_SG = ST_XA + 64 * TWP * 2, T_BONUS = ST_SG + 64 * SGP * 2, T_END = T_BONUS + 256;
constexpr int T_UO = 114688;
constexpr int T_TOT = 147456;
constexpr int T_ULOC = 131072, T_PSEQ = T_NKK, T_UF = T_W, T_GL = T_BONUS + 256, T_S0 = T_GL + 256, T_SST = T_B;
static_assert(T_S0 + 8192 <= 163840 - 256 && T_TOT + 2048 <= ST_SG + 64 * SGP * 2 && T_ULOC + 16384 <= T_TOT, "rwkv LDS map (L3)");
constexpr int SL_OFF = 0, SLP = 68, PM_OFF = 32768;
static_assert(T_END <= 163840 - 512, "rwkv LDS map");

__device__ __forceinline__ float dpp_add(float x, const int ctrl_sel) {
    int y;
    switch (ctrl_sel) {
        case 0: y = __builtin_amdgcn_update_dpp(0, __builtin_bit_cast(int, x), 0xB1, 0xF, 0xF, true); break;
        case 1: y = __builtin_amdgcn_update_dpp(0, __builtin_bit_cast(int, x), 0x4E, 0xF, 0xF, true); break;
        case 2: y = __builtin_amdgcn_update_dpp(0, __builtin_bit_cast(int, x), 0x141, 0xF, 0xF, true); break;
        default: y = __builtin_amdgcn_update_dpp(0, __builtin_bit_cast(int, x), 0x140, 0xF, 0xF, true); break;
    }
    return x + __builtin_bit_cast(float, y);
}
__device__ __forceinline__ float allreduce16(float x) { x = dpp_add(x, 0); x = dpp_add(x, 1); x = dpp_add(x, 2); x = dpp_add(x, 3); return x; }
__device__ __forceinline__ float allreduce8(float x) { x = dpp_add(x, 0); x = dpp_add(x, 1); x = dpp_add(x, 2); return x; }
__device__ __forceinline__ float dot4(const f32x4 a, const f32x4 b) { return (a.x * b.x + a.y * b.y) + (a.z * b.z + a.w * b.w); }
__device__ __forceinline__ void ld8bf(const bf16* p, float (&o)[8]) { const v4u w = *(const v4u*)p; o[0] = bflo(w.x); o[1] = bfhi(w.x); o[2] = bflo(w.y); o[3] = bfhi(w.y); o[4] = bflo(w.z); o[5] = bfhi(w.z); o[6] = bflo(w.w); o[7] = bfhi(w.w); }
__device__ __forceinline__ void ld8f(const float* p, float (&o)[8]) { const f32x4 a = *(const f32x4*)p, b = *(const f32x4*)(p + 4); o[0] = a.x; o[1] = a.y; o[2] = a.z; o[3] = a.w; o[4] = b.x; o[5] = b.y; o[6] = b.z; o[7] = b.w; }
__device__ __forceinline__ float fast_tanh(float x) { return 1.0f - 2.0f * __builtin_amdgcn_rcpf(1.0f + __expf(2.0f * x)); }
__device__ __forceinline__ float fast_sigmoid(float x) { return __builtin_amdgcn_rcpf(1.0f + __expf(-x)); }

struct SlotSrc { const bf16* cur; const bf16* prevb; const float* prevf; };

__device__ __forceinline__ void shift8(const SlotSrc& s, const float* mu, int col, float (&xs)[8]) {
    float x[8], p[8], m[8];
    ld8bf(s.cur + col, x); ld8f(mu + col, m);
    if (s.prevb) ld8bf(s.prevb + col, p);
    else if (s.prevf) ld8f(s.prevf + col, p);
    else {
#pragma unroll
        for (int j = 0; j < 8; ++j) p[j] = 0.f; }
#pragma unroll
    for (int j = 0; j < 8; ++j) xs[j] = x[j] + m[j] * (p[j] - x[j]);
}
__device__ __forceinline__ void st8(LAS unsigned char* lds, int off, const float (&v)[8]) {
    *(LAS f32x4*)(lds + off) = (f32x4){v[0], v[1], v[2], v[3]}; *(LAS f32x4*)(lds + off + 16) = (f32x4){v[4], v[5], v[6], v[7]};
}
__device__ __forceinline__ void ld8l(LAS unsigned char* lds, int off, float (&v)[8]) {
    const f32x4 a = *(LAS f32x4*)(lds + off), b = *(LAS f32x4*)(lds + off + 16); v[0] = a.x; v[1] = a.y; v[2] = a.z; v[3] = a.w; v[4] = b.x; v[5] = b.y; v[6] = b.z; v[7] = b.w;
}

struct PrepRegs { v4u cur[8], prv[8]; };
template <bool FULL, class SrcFn>
__device__ __forceinline__ void prep_issue(int h, const SrcFn& srcfn, int tid, PrepRegs& R) {
    const int slot = tid >> 3, part = tid & 7, c8 = h * HD + part * 8;
    const SlotSrc s = srcfn(slot);
#pragma unroll
    for (int q = 0; q < 8; ++q) {
        const int col = q == 0 ? C_R + c8 : q == 1 ? C_K + c8 : q == 2 ? C_V + c8 : C_XW + 8 * (part + 8 * (q - 3));
        const bool on = q == 0 ? FULL : q < 3 ? true : (part + 8 * (q - 3)) < (FULL ? 36 : 16);
        R.cur[q] = (v4u){0u, 0u, 0u, 0u}; R.prv[q] = (v4u){0u, 0u, 0u, 0u};
        if (on) { R.cur[q] = *(const v4u*)(s.cur + col); if (s.prevb) R.prv[q] = *(const v4u*)(s.prevb + col);
            else if (s.prevf) { const f32x4 p0 = *(const f32x4*)(s.prevf + col), p1 = *(const f32x4*)(s.prevf + col + 4);
                R.prv[q] = (v4u){pg8::cvt_pk_bf16(p0[0], p0[1]), pg8::cvt_pk_bf16(p0[2], p0[3]), pg8::cvt_pk_bf16(p1[0], p1[1]), pg8::cvt_pk_bf16(p1[2], p1[3])}; } }
    }
}
constexpr int L_XO = 16384, L_XR = 69632;
constexpr int T_TOT2 = 11264;
constexpr int L_ABF = 0, L_DINV = 9216, L_BBF = 32768, L_KBF = 41984, L_VBF = 51200, L_RBF = 60416, L_PCT = 83968, L_NL = 93184, L_ML = 102400, L_RB = 111616, L_RK = 120832, L_ND = 130048, L_XROW = 134144, L_XP = 272;
constexpr int T_CMU = T_S0, T_CKK = T_CMU + 2048, T_CKA = T_CKK + 256, T_CRK = T_CKA + 256, T_CW0 = T_CRK + 256, T_CA0 = T_CW0 + 256;
__device__ __forceinline__ void prep_consts_fill(const Args& a, LAS unsigned char* lds, int h, int tid) {
    { const int q = tid >> 6, part = (tid >> 3) & 7, e = tid & 7;
      const int col = q == 0 ? C_R + h * HD + part * 8 : q == 1 ? C_K + h * HD + part * 8 : q == 2 ? C_V + h * HD + part * 8 : C_XW + 8 * (part + 8 * (q - 3));
      const bool on = q < 3 ? true : (part + 8 * (q - 3)) < 36;
      *(LAS float*)(lds + T_CMU + tid * 4) = on ? a.in[I_MU][col + e] : 0.f; }
    if (tid < 320) { const int arr = tid >> 6, ch = tid & 63; const int idx = arr == 0 ? I_KK : arr == 1 ? I_KA : arr == 2 ? I_RK : arr == 3 ? I_W0 : I_A0;
      *(LAS float*)(lds + T_CKK + tid * 4) = a.in[idx][h * HD + ch]; }
}
struct LoraFrags { bf16x8 bw[2], ba[2], bg[5]; };
template <bool FULL>
__device__ __forceinline__ void lora_frags_load(const Args& a, int h, int tid, LoraFrags& F) {
    const int lane = tid & 63, wave = tid >> 6, fr = lane & 15, fq = lane >> 4, ct = wave & 3;
    const bf16* w2t = (const bf16*)(a.ws + WS_W2T); const bf16* a2t = (const bf16*)(a.ws + WS_A2T); const bf16* g2t = (const bf16*)(a.ws + WS_G2T);
    const int c = h * HD + 16 * ct + fr;
#pragma unroll
    for (int ks = 0; ks < 2; ++ks) { F.bw[ks] = *(const bf16x8*)(w2t + (size_t)c * 64 + ks * 32 + 8 * fq); F.ba[ks] = *(const bf16x8*)(a2t + (size_t)c * 64 + ks * 32 + 8 * fq); }
    if (FULL) {
#pragma unroll
        for (int ks = 0; ks < 5; ++ks) F.bg[ks] = *(const bf16x8*)(g2t + (size_t)c * 160 + ks * 32 + 8 * fq); }
}
template <bool FULL, bool PREVF, int RP, bool PRE, bool STORE, bool HOISTF, bool L1M, class SrcFn>
__device__ __forceinline__ void prep_block(const Args& a, LAS unsigned char* lds, int h, const SrcFn& srcfn, int tid, const PrepRegs& R, unsigned char* rec, LoraFrags& F) {
    const int lane = tid & 63, wave = __builtin_amdgcn_readfirstlane(tid >> 6);
    const float* mu = a.in[I_MU];
    const int fr = lane & 15, fq = lane >> 4;
    float keep_r[8], keep_k[8], keep_kk[8], keep_v[8];
    {
        const int slot = tid >> 3, part = tid & 7, ch8 = part * 8, c8 = h * HD + ch8;
        const SlotSrc s = srcfn(slot);
        constexpr int NV = 8;
        int col[NV]; bool on[NV];
        col[0] = C_R + c8; on[0] = FULL; col[1] = C_K + c8; on[1] = true; col[2] = C_V + c8; on[2] = true;
#pragma unroll
        for (int q = 0; q < 5; ++q) { const int ci = part + 8 * q; col[3 + q] = C_XW + 8 * ci; on[3 + q] = ci < (FULL ? 36 : 16); }
        float kkc[8]; if (HOISTF) ld8l(lds, T_CKK + ch8 * 4, kkc); else ld8f(a.in[I_KK] + c8, kkc);
        const int toff = slot * 256 + ch8 * 4;
        constexpr int GS = 4;
#pragma unroll
        for (int g0 = 0; g0 < NV; g0 += GS) {
            v4u cur[GS], prv[GS]; f32x4 pf[GS][2], mv[GS][2];
#pragma unroll
            for (int qq = 0; qq < GS; ++qq) { const int q = g0 + qq; if (on[q]) { if (PRE) cur[qq] = R.cur[q]; else cur[qq] = *(const v4u*)(s.cur + col[q]); } }
#pragma unroll
            for (int qq = 0; qq < GS; ++qq) { const int q = g0 + qq; if (on[q]) {
                prv[qq] = (v4u){0u, 0u, 0u, 0u};
                if (PRE) prv[qq] = R.prv[q]; else if (s.prevb) prv[qq] = *(const v4u*)(s.prevb + col[q]);
                if (PREVF) { if (s.prevf) { pf[qq][0] = *(const f32x4*)(s.prevf + col[q]); pf[qq][1] = *(const f32x4*)(s.prevf + col[q] + 4); } }
            } }
#pragma unroll
            for (int qq = 0; qq < GS; ++qq) { const int q = g0 + qq; if (on[q]) {
                if (HOISTF) { mv[qq][0] = *(LAS f32x4*)(lds + T_CMU + (q * 8 + part) * 32); mv[qq][1] = *(LAS f32x4*)(lds + T_CMU + (q * 8 + part) * 32 + 16); }
                else { mv[qq][0] = *(const f32x4*)(mu + col[q]); mv[qq][1] = *(const f32x4*)(mu + col[q] + 4); } } }
#pragma unroll
            for (int qq = 0; qq < GS; ++qq) { const int q = g0 + qq; if (on[q]) {
                float x[8], p[8], xs[8];
                x[0] = bflo(cur[qq].x); x[1] = bfhi(cur[qq].x); x[2] = bflo(cur[qq].y); x[3] = bfhi(cur[qq].y); x[4] = bflo(cur[qq].z); x[5] = bfhi(cur[qq].z); x[6] = bflo(cur[qq].w); x[7] = bfhi(cur[qq].w);
                p[0] = bflo(prv[qq].x); p[1] = bfhi(prv[qq].x); p[2] = bflo(prv[qq].y); p[3] = bfhi(prv[qq].y); p[4] = bflo(prv[qq].z); p[5] = bfhi(prv[qq].z); p[6] = bflo(prv[qq].w); p[7] = bfhi(prv[qq].w);
                if (PREVF) { if (s.prevf) { p[0] = pf[qq][0].x; p[1] = pf[qq][0].y; p[2] = pf[qq][0].z; p[3] = pf[qq][0].w; p[4] = pf[qq][1].x; p[5] = pf[qq][1].y; p[6] = pf[qq][1].z; p[7] = pf[qq][1].w; } }
                const float m8[8] = {mv[qq][0].x, mv[qq][0].y, mv[qq][0].z, mv[qq][0].w, mv[qq][1].x, mv[qq][1].y, mv[qq][1].z, mv[qq][1].w};
#pragma unroll
                for (int e = 0; e < 8; ++e) xs[e] = x[e] + m8[e] * (p[e] - x[e]);
                if (q == 0) { if (L1M) {
#pragma unroll
                        for (int e = 0; e < 8; ++e) keep_r[e] = xs[e]; } else st8(lds, T_R + toff, xs); }
                else if (q == 1) { if (L1M) {
#pragma unroll
                        for (int e = 0; e < 8; ++e) { keep_k[e] = xs[e]; keep_kk[e] = xs[e] * kkc[e]; } }
                    else { st8(lds, T_K + toff, xs);
#pragma unroll
                        for (int e = 0; e < 8; ++e) xs[e] *= kkc[e];
                        st8(lds, T_NKK + toff, xs); } }
                else if (q == 2) { if (L1M) {
#pragma unroll
                        for (int e = 0; e < 8; ++e) keep_v[e] = xs[e]; } else st8(lds, T_V + toff, xs); }
                else {
                    const int ci = part + 8 * (q - 3); int off;
                    if (ci < 8) { off = ST_TW + slot * (TWP * 2) + ci * 16;
#pragma unroll
                        for (int e = 0; e < 8; ++e) xs[e] = fast_tanh(xs[e]); }
                    else if (ci < 16) off = ST_XA + slot * (TWP * 2) + (ci - 8) * 16;
                    else { off = ST_SG + slot * (SGP * 2) + (ci - 16) * 16;
#pragma unroll
                        for (int e = 0; e < 8; ++e) xs[e] = fast_sigmoid(xs[e]); }
                    v4u o; o.x = pk2(xs[0], xs[1]); o.y = pk2(xs[2], xs[3]); o.z = pk2(xs[4], xs[5]); o.w = pk2(xs[6], xs[7]);
                    *(LAS v4u*)(lds + off) = o;
                }
            } }
        }
    }
    if (!HOISTF) lora_frags_load<FULL>(a, h, tid, F);
    __syncthreads();
    {
        const int ct = wave & 3, rth = wave >> 2;
        const int ch = 16 * ct + fr, c = h * HD + ch;
        const float w0 = HOISTF ? *(LAS float*)(lds + T_CW0 + ch * 4) : a.in[I_W0][c], a0 = HOISTF ? *(LAS float*)(lds + T_CA0 + ch * 4) : a.in[I_A0][c];
        float wl[2][4];
#pragma unroll
        for (int rt2 = 0; rt2 < 2; ++rt2) {
            const int rt = 2 * rth + rt2;
            bf16x8 atw[2], axa[2], asg[5];
#pragma unroll
            for (int ks = 0; ks < 2; ++ks) {
                atw[ks] = *(LAS bf16x8*)(lds + ST_TW + (16 * rt + fr) * (TWP * 2) + (ks * 32 + 8 * fq) * 2);
                axa[ks] = *(LAS bf16x8*)(lds + ST_XA + (16 * rt + fr) * (TWP * 2) + (ks * 32 + 8 * fq) * 2);
            }
            if (FULL) {
#pragma unroll
                for (int ks = 0; ks < 5; ++ks) asg[ks] = *(LAS bf16x8*)(lds + ST_SG + (16 * rt + fr) * (SGP * 2) + (ks * 32 + 8 * fq) * 2);
            }
            f32x4 accW = {0.f, 0.f, 0.f, 0.f}, accA = {0.f, 0.f, 0.f, 0.f}, accG = {0.f, 0.f, 0.f, 0.f};
#pragma unroll
            for (int ks = 0; ks < 2; ++ks) {
                accW = __builtin_amdgcn_mfma_f32_16x16x32_bf16(atw[ks], F.bw[ks], accW, 0, 0, 0);
                accA = __builtin_amdgcn_mfma_f32_16x16x32_bf16(axa[ks], F.ba[ks], accA, 0, 0, 0);
            }
            if (FULL) {
#pragma unroll
                for (int ks = 0; ks < 5; ++ks) accG = __builtin_amdgcn_mfma_f32_16x16x32_bf16(asg[ks], F.bg[ks], accG, 0, 0, 0);
            }
#pragma unroll
            for (int rg = 0; rg < 4; ++rg) {
                const int slot = 16 * rt + 4 * fq + rg, off = slot * 256 + ch * 4;
                wl[rt2][rg] = -0.60653065971f * fast_sigmoid(w0 + accW[rg]);
                if (!L1M) *(LAS float*)(lds + T_W + off) = wl[rt2][rg];
                *(LAS float*)(lds + T_B + off) = fast_sigmoid(a0 + accA[rg]);
                if (FULL) *(LAS float*)(lds + T_G + off) = accG[rg];
            }
        }
        if (L1M) {
#pragma unroll
            for (int rt2 = 0; rt2 < 2; ++rt2) { wl[rt2][1] += wl[rt2][0]; wl[rt2][2] += wl[rt2][1]; wl[rt2][3] += wl[rt2][2]; }
            const float g0 = wl[0][3], g1 = wl[1][3];
            float s0 = g0, s1 = g1;
            { const float t0 = __shfl_up(s0, 16), t1 = __shfl_up(s1, 16); if (fq >= 1) { s0 += t0; s1 += t1; } }
            { const float t0 = __shfl_up(s0, 32), t1 = __shfl_up(s1, 32); if (fq >= 2) { s0 += t0; s1 += t1; } }
            const float tot0 = __shfl(s0, 48 + fr);
            const float e0 = s0 - g0, e1 = s1 - g1 + tot0;
#pragma unroll
            for (int rg = 0; rg < 4; ++rg) { wl[0][rg] += e0; wl[1][rg] += e1; }
            if (rth == 0 && fq == 3) *(LAS float*)(lds + T_TOT2 + ch * 4) = __expf(wl[1][3]);
#pragma unroll
            for (int rt2 = 0; rt2 < 2; ++rt2)
#pragma unroll
                for (int rg = 0; rg < 4; ++rg) *(LAS float*)(lds + T_W + (16 * (2 * rth + rt2) + 4 * fq + rg) * 256 + ch * 4) = __expf(wl[rt2][rg]);
        }
    }
    __syncthreads();
    if (!L1M) {
        const int ch = tid & 63, so = tid >> 6;
        float c[8]; float run = 0.f;
#pragma unroll
        for (int i2 = 0; i2 < 8; ++i2) { const int slot = 8 * so + i2; if ((slot % RP) == 0) run = 0.f; run += *(LAS float*)(lds + T_W + slot * 256 + ch * 4); c[i2] = run; }
        if (RP > 8) {
            *(LAS float*)(lds + T_TOT + (so * 64 + ch) * 4) = run;
            __syncthreads();
            float pre = 0.f;
#pragma unroll
            for (int q = 0; q < RP / 8 - 1; ++q) { const int so2 = (so / (RP / 8)) * (RP / 8) + q; if (so2 < so) pre += *(LAS float*)(lds + T_TOT + (so2 * 64 + ch) * 4); }
#pragma unroll
            for (int i2 = 0; i2 < 8; ++i2) c[i2] += pre;
        }
#pragma unroll
        for (int i2 = 0; i2 < 8; ++i2) *(LAS float*)(lds + T_W + (8 * so + i2) * 256 + ch * 4) = c[i2];
        __syncthreads();
    }
    {
        const int slot = tid >> 3, part = tid & 7, ch8 = part * 8, c8 = h * HD + ch8, toff = slot * 256 + ch8 * 4;
        float kkr[8], av[8], k[8], ka[8], cu[8], cp[8];
        if (L1M) {
#pragma unroll
            for (int j2 = 0; j2 < 8; ++j2) { kkr[j2] = keep_kk[j2]; k[j2] = keep_k[j2]; } }
        else { ld8l(lds, T_NKK + toff, kkr); ld8l(lds, T_K + toff, k); }
        ld8l(lds, T_B + toff, av); if (HOISTF) ld8l(lds, T_CKA + ch8 * 4, ka); else ld8f(a.in[I_KA] + c8, ka); ld8l(lds, T_W + toff, cu);
        if ((slot % RP) != 0) ld8l(lds, T_W + toff - 256, cp);
        else {
#pragma unroll
            for (int j2 = 0; j2 < 8; ++j2) cp[j2] = L1M ? 1.f : 0.f; }
        if (L1M && slot >= 32) { float t8[8]; ld8l(lds, T_TOT2 + ch8 * 4, t8);
#pragma unroll
            for (int j2 = 0; j2 < 8; ++j2) { cu[j2] *= t8[j2]; if (slot > 32) cp[j2] *= t8[j2]; } }
        float ssq = 0.f;
#pragma unroll
        for (int j2 = 0; j2 < 8; ++j2) ssq += kkr[j2] * kkr[j2];
        ssq = allreduce8(ssq);
        const float inv = 1.0f / fmaxf(sqrtf(ssq), 1e-12f);
        float nk[8], bb[8], kp[8], g1[8];
        float bs = 0.f;
        float r[8], rk[8];
        if (FULL) { if (L1M) {
#pragma unroll
                for (int j2 = 0; j2 < 8; ++j2) r[j2] = keep_r[j2]; } else ld8l(lds, T_R + toff, r);
            if (HOISTF) ld8l(lds, T_CRK + ch8 * 4, rk); else ld8f(a.in[I_RK] + c8, rk); }
        float vv[8], gg[8];
        if (L1M) { ld8l(lds, T_G + toff, gg);
#pragma unroll
            for (int j2 = 0; j2 < 8; ++j2) vv[j2] = keep_v[j2]; }
#pragma unroll
        for (int j2 = 0; j2 < 8; ++j2) {
            const float kk = kkr[j2] * inv; const float kpv = k[j2] * (1.0f + (av[j2] - 1.0f) * ka[j2]);
            g1[j2] = L1M ? cu[j2] : __expf(cu[j2]); const float gi = __builtin_amdgcn_rcpf(g1[j2]), g0 = L1M ? cp[j2] : __expf(cp[j2]);
            if (FULL) bs += r[j2] * kpv * rk[j2];
            nk[j2] = -kk * g0; bb[j2] = kk * av[j2] * gi; kp[j2] = kpv * gi;
        }
        if (!L1M) { st8(lds, T_NKK + toff, nk); st8(lds, T_B + toff, bb); st8(lds, T_K + toff, kp); }
        if (FULL) {
#pragma unroll
            for (int j2 = 0; j2 < 8; ++j2) r[j2] *= g1[j2];
            if (!L1M) st8(lds, T_R + toff, r);
            bs = allreduce8(bs);
            if (part == 0) *(LAS float*)(lds + T_BONUS + slot * 4) = bs;
            if (slot == 63) st8(lds, T_GL + ch8 * 4, g1);
            if (STORE) {
                const int go = slot * 128 + part * 16;
                if (!L1M) { ld8l(lds, T_V + toff, vv); ld8l(lds, T_G + toff, gg); }
                v4u w;
                w.x = pg8::cvt_pk_bf16(r[0], r[1]); w.y = pg8::cvt_pk_bf16(r[2], r[3]); w.z = pg8::cvt_pk_bf16(r[4], r[5]); w.w = pg8::cvt_pk_bf16(r[6], r[7]); if (!L1M) *(v4u*)(rec + go) = w; else *(LAS v4u*)(lds + L_RBF + slot * 144 + part * 16) = w;
                w.x = pg8::cvt_pk_bf16(bb[0], bb[1]); w.y = pg8::cvt_pk_bf16(bb[2], bb[3]); w.z = pg8::cvt_pk_bf16(bb[4], bb[5]); w.w = pg8::cvt_pk_bf16(bb[6], bb[7]); if (!L1M) *(v4u*)(rec + 8192 + go) = w;
                if (L1M) *(LAS v4u*)(lds + L_BBF + slot * 144 + part * 16) = w;
                w.x = pg8::cvt_pk_bf16(kp[0], kp[1]); w.y = pg8::cvt_pk_bf16(kp[2], kp[3]); w.z = pg8::cvt_pk_bf16(kp[4], kp[5]); w.w = pg8::cvt_pk_bf16(kp[6], kp[7]); if (!L1M) *(v4u*)(rec + 16384 + go) = w;
                if (L1M) *(LAS v4u*)(lds + L_KBF + slot * 144 + part * 16) = w;
                w.x = pg8::cvt_pk_bf16(vv[0], vv[1]); w.y = pg8::cvt_pk_bf16(vv[2], vv[3]); w.z = pg8::cvt_pk_bf16(vv[4], vv[5]); w.w = pg8::cvt_pk_bf16(vv[6], vv[7]); *(v4u*)(rec + 24576 + go) = w;
                if (L1M) { *(LAS v4u*)(lds + L_VBF + slot * 144 + part * 16) = w;
                    v4u wa; wa.x = pg8::cvt_pk_bf16(nk[0], nk[1]); wa.y = pg8::cvt_pk_bf16(nk[2], nk[3]); wa.z = pg8::cvt_pk_bf16(nk[4], nk[5]); wa.w = pg8::cvt_pk_bf16(nk[6], nk[7]); *(LAS v4u*)(lds + L_ABF + slot * 144 + part * 16) = wa; }
                w.x = pg8::cvt_pk_bf16(gg[0], gg[1]); w.y = pg8::cvt_pk_bf16(gg[2], gg[3]); w.z = pg8::cvt_pk_bf16(gg[4], gg[5]); w.w = pg8::cvt_pk_bf16(gg[6], gg[7]); *(v4u*)(rec + 32768 + go) = w;
                if (part == 0) *(float*)(rec + 40960 + slot * 4) = bs;
                if (slot == 63) { *(f32x4*)(rec + 41216 + ch8 * 4) = (f32x4){g1[0], g1[1], g1[2], g1[3]}; *(f32x4*)(rec + 41216 + ch8 * 4 + 16) = (f32x4){g1[4], g1[5], g1[6], g1[7]}; }
            }
        }
    }
    __syncthreads();
}

typedef float f2 __attribute__((ext_vector_type(2)));
struct L1Ops { f2 a[4], b[4], k[4]; f2 v; };
template <bool IS_STATE>
__device__ __forceinline__ void l1_load(LAS unsigned char* lds, int slot, int coff, int rp, L1Ops& o) {
    const int ro = slot * 256 + coff;
    const f32x4 a0 = *(LAS f32x4*)(lds + T_NKK + ro), a1 = *(LAS f32x4*)(lds + T_NKK + ro + 16);
    const f32x4 b0 = *(LAS f32x4*)(lds + T_B + ro), b1 = *(LAS f32x4*)(lds + T_B + ro + 16);
    o.a[0] = a0.xy; o.a[1] = a0.zw; o.a[2] = a1.xy; o.a[3] = a1.zw; o.b[0] = b0.xy; o.b[1] = b0.zw; o.b[2] = b1.xy; o.b[3] = b1.zw;
    if (IS_STATE) { const f32x4 k0 = *(LAS f32x4*)(lds + T_K + ro), k1 = *(LAS f32x4*)(lds + T_K + ro + 16); o.k[0] = k0.xy; o.k[1] = k0.zw; o.k[2] = k1.xy; o.k[3] = k1.zw;
        o.v = *(LAS f2*)(lds + T_V + slot * 256 + rp * 8); }
}
template <bool IS_STATE>
__device__ __forceinline__ void l1_compute(f2 (&S)[2][4], const L1Ops& o, bf16* uo, bool wr) {
    f2 u2;
#pragma unroll
    for (int r = 0; r < 2; ++r) {
        f2 acc = S[r][0] * o.a[0]; acc = __builtin_elementwise_fma(S[r][1], o.a[1], acc); acc = __builtin_elementwise_fma(S[r][2], o.a[2], acc); acc = __builtin_elementwise_fma(S[r][3], o.a[3], acc);
        const float u = allreduce8(acc.x + acc.y);
        u2[r] = u;
        const f2 uu = {u, u};
#pragma unroll
        for (int q = 0; q < 4; ++q) S[r][q] = __builtin_elementwise_fma(o.b[q], uu, S[r][q]);
        if (IS_STATE) { const f2 vv = {o.v[r], o.v[r]};
#pragma unroll
            for (int q = 0; q < 4; ++q) S[r][q] = __builtin_elementwise_fma(o.k[q], vv, S[r][q]); }
    }
    if (wr) *(unsigned*)uo = pk2(u2.x, u2.y);
}
template <bool IS_STATE, int NSB>
__device__ __forceinline__ void l1_steps(LAS unsigned char* lds, f2 (&S)[2][4], int cg, int rp, bf16* up) {
    const int coff = cg * 32;
#pragma unroll 1
    for (int sb = 0; sb < 64 / NSB; ++sb) {
        L1Ops A, B;
        l1_load<IS_STATE>(lds, sb * NSB, coff, rp, A);
#pragma unroll 2
        for (int tt = sb * NSB; tt < sb * NSB + NSB; tt += 2) {
            l1_load<IS_STATE>(lds, tt + 1, coff, rp, B);
            asm volatile("" ::: "memory");
            l1_compute<IS_STATE>(S, A, up + tt * 128 + rp * 2, cg == 0);
            l1_load<IS_STATE>(lds, tt + 2 < 64 ? tt + 2 : 63, coff, rp, A);
            asm volatile("" ::: "memory");
            l1_compute<IS_STATE>(S, B, up + (tt + 1) * 128 + rp * 2, cg == 0);
        }
        const f32x4 g0 = *(LAS f32x4*)(lds + T_W + (sb * NSB + NSB - 1) * 256 + coff), g1 = *(LAS f32x4*)(lds + T_W + (sb * NSB + NSB - 1) * 256 + coff + 16);
        const f2 e0 = {__expf(g0.x), __expf(g0.y)}, e1 = {__expf(g0.z), __expf(g0.w)}, e2 = {__expf(g1.x), __expf(g1.y)}, e3 = {__expf(g1.z), __expf(g1.w)};
#pragma unroll
        for (int r = 0; r < 2; ++r) { S[r][0] *= e0; S[r][1] *= e1; S[r][2] *= e2; S[r][3] *= e3; }
    }
}
struct L3Ops { f2 a[2], b[2], k[2], r[2]; f2 v; };
__device__ __forceinline__ void l3_load(LAS unsigned char* lds, int slot, int coff, int rg, L3Ops& o) {
    const int ro = slot * 256 + coff;
    const f32x4 a = *(LAS f32x4*)(lds + T_NKK + ro), b = *(LAS f32x4*)(lds + T_B + ro), k = *(LAS f32x4*)(lds + T_K + ro), rr = *(LAS f32x4*)(lds + T_R + ro);
    o.a[0] = a.xy; o.a[1] = a.zw; o.b[0] = b.xy; o.b[1] = b.zw; o.k[0] = k.xy; o.k[1] = k.zw; o.r[0] = rr.xy; o.r[1] = rr.zw;
    o.v = *(LAS f2*)(lds + T_V + slot * 256 + rg * 8);
}
template <int RP>
__device__ __forceinline__ void l3_compute(LAS unsigned char* lds, f2 (&S)[2][2], const L3Ops& o, int tt, int cg, int rg, int coff) {
    f2 o2;
#pragma unroll
    for (int r = 0; r < 2; ++r) {
        f2 acc = S[r][0] * o.a[0]; acc = __builtin_elementwise_fma(S[r][1], o.a[1], acc);
        const float u = allreduce16(acc.x + acc.y);
        const f2 uu = {u, u}, vv = {o.v[r], o.v[r]};
        S[r][0] = __builtin_elementwise_fma(o.b[0], uu, S[r][0]); S[r][1] = __builtin_elementwise_fma(o.b[1], uu, S[r][1]);
        S[r][0] = __builtin_elementwise_fma(o.k[0], vv, S[r][0]); S[r][1] = __builtin_elementwise_fma(o.k[1], vv, S[r][1]);
        f2 e = S[r][0] * o.r[0]; e = __builtin_elementwise_fma(S[r][1], o.r[1], e);
        o2[r] = allreduce16(e.x + e.y);
    }
    if (cg == 0) *(LAS f2*)(lds + T_OUT + tt * 256 + rg * 8) = o2;
    if ((tt % RP) == RP - 1) {
        const f32x4 g = *(LAS f32x4*)(lds + T_W + tt * 256 + coff);
        const f2 e0 = {__expf(g.x), __expf(g.y)}, e1 = {__expf(g.z), __expf(g.w)};
        S[0][0] *= e0; S[0][1] *= e1; S[1][0] *= e0; S[1][1] *= e1;
    }
}
template <int RP>
__device__ __forceinline__ void l3_steps(LAS unsigned char* lds, f2 (&S)[2][2], int cg, int rg, int t0, int t1) {
    const int coff = cg * 16;
    L3Ops A, B;
    l3_load(lds, t0, coff, rg, A);
#pragma unroll 1
    for (int tt = t0; tt < t1; tt += 2) {
        l3_load(lds, tt + 1, coff, rg, B);
        asm volatile("" ::: "memory");
        l3_compute<RP>(lds, S, A, tt, cg, rg, coff);
        l3_load(lds, tt + 2 < 64 ? tt + 2 : 63, coff, rg, A);
        asm volatile("" ::: "memory");
        l3_compute<RP>(lds, S, B, tt + 1, cg, rg, coff);
    }
}
template <class RowFn>
__device__ __forceinline__ void post_block(const Args& a, LAS unsigned char* lds, int h, const RowFn& rowfn, int tid) {
    const int slot = tid >> 3, part = tid & 7, ch8 = part * 8, c8 = h * HD + ch8, toff = slot * 256 + ch8 * 4;
    float o[8], v[8], g[8], lw[8], lb[8];
    ld8l(lds, T_OUT + toff, o); ld8l(lds, T_V + toff, v); ld8l(lds, T_G + toff, g); ld8f(a.in[I_LNW] + c8, lw); ld8f(a.in[I_LNB] + c8, lb);
    float s = 0.f;
#pragma unroll
    for (int j = 0; j < 8; ++j) s += o[j];
    const float mean = allreduce8(s) * (1.f / 64.f);
    float q = 0.f;
#pragma unroll
    for (int j = 0; j < 8; ++j) { o[j] -= mean; q += o[j] * o[j]; }
    const float rstd = 1.0f / sqrtf(allreduce8(q) * (1.f / 64.f) + GN_EPS);
    const float bonus = *(LAS float*)(lds + T_BONUS + slot * 4);
    float res[8];
#pragma unroll
    for (int j = 0; j < 8; ++j) res[j] = (o[j] * rstd * lw[j] + lb[j] + bonus * v[j]) * g[j];
    const long m = rowfn(slot);
    if (m >= 0) { v4u w; w.x = pk2(res[0], res[1]); w.y = pk2(res[2], res[3]); w.z = pk2(res[4], res[5]); w.w = pk2(res[6], res[7]);
        *(v4u*)((bf16*)(a.ws + WS_MIX) + (size_t)m * DM + c8) = w; }
}

__device__ __forceinline__ void l1_unit(const Args& a, LAS unsigned char* lds, int h, int s, int tid) {
    const bf16* P = (const bf16*)(a.ws + WS_P);
    const int cg = tid & 7, rp = tid >> 3;
    const bool is_state = __builtin_amdgcn_readfirstlane(tid >> 6) < 4;
    f2 S[2][4];
#pragma unroll
    for (int r = 0; r < 2; ++r)
#pragma unroll
        for (int q = 0; q < 4; ++q) { S[r][q] = (f2){0.f, 0.f}; if (!is_state) { const int d = (2 * rp + r - 64) - (8 * cg + 2 * q); if (d >= 0 && d < 2) S[r][q][d] = 1.0f; } }
    PrepRegs R; LoraFrags LF; lora_frags_load<true>(a, h, tid, LF);
    prep_consts_fill(a, lds, h, tid);
    __syncthreads();
    { const int mb = s * SEGLEN; auto src0 = [&](int slot) -> SlotSrc { const int m = mb + slot; SlotSrc r; r.cur = P + (size_t)m * PPITCH; r.prevb = m > 0 ? r.cur - PPITCH : nullptr; r.prevf = nullptr; return r; };
      prep_issue<true>(h, src0, tid, R); }
    for (int blk = 0; blk < NBLK; ++blk) {
        const int m0 = s * SEGLEN + blk * BLK;
        auto srcfn = [&](int slot) -> SlotSrc { const int m = m0 + slot; SlotSrc r; r.cur = P + (size_t)m * PPITCH; r.prevb = m > 0 ? r.cur - PPITCH : nullptr; r.prevf = nullptr; return r; };
        int tidv = tid; asm volatile("" : "+v"(tidv));
        prep_block<true, false, 64, true, true, true, false>(a, lds, h, srcfn, tidv, R, a.ws + WS_TL + ((size_t)h * (TP / BLK) + (m0 >> 6)) * TL_REC, LF);
        if (blk + 1 < NBLK) { const int m1 = m0 + BLK; auto src1 = [&](int slot) -> SlotSrc { const int m = m1 + slot; SlotSrc r; r.cur = P + (size_t)m * PPITCH; r.prevb = r.cur - PPITCH; r.prevf = nullptr; return r; };
            prep_issue<true>(h, src1, tidv, R); }
        { bf16* up = (bf16*)a.out + ((size_t)h * TP + m0) * 128;
          if (is_state) l1_steps<true, 64>(lds, S, cg, rp, up); else l1_steps<false, 64>(lds, S, cg, rp, up); }
        __syncthreads();
    }
    float* seg = (float*)(a.ws + WS_SEG) + ((size_t)(s * NH + h) * 2) * 4096;
#pragma unroll
    for (int r = 0; r < 2; ++r) { const int row = 2 * rp + r; *(f32x4*)(seg + (size_t)row * 64 + 8 * cg) = (f32x4){S[r][0].x, S[r][0].y, S[r][1].x, S[r][1].y}; *(f32x4*)(seg + (size_t)row * 64 + 8 * cg + 4) = (f32x4){S[r][2].x, S[r][2].y, S[r][3].x, S[r][3].y}; }
}

__device__ __forceinline__ bf16x8 frag_row(LAS unsigned char* tile, int row, int col0) {
    const f32x4 x = *(LAS f32x4*)(tile + row * 256 + col0 * 4), y = *(LAS f32x4*)(tile + row * 256 + col0 * 4 + 16);
    union { bf16x8 v; unsigned u[4]; } f; f.u[0] = pg8::cvt_pk_bf16(x.x, x.y); f.u[1] = pg8::cvt_pk_bf16(x.z, x.w); f.u[2] = pg8::cvt_pk_bf16(y.x, y.y); f.u[3] = pg8::cvt_pk_bf16(y.z, y.w); return f.v;
}
__device__ __forceinline__ void frag_row_hilo(LAS unsigned char* tile, int row, int col0, bf16x8& hi, bf16x8& lo) {
    const f32x4 x = *(LAS f32x4*)(tile + row * 256 + col0 * 4), y = *(LAS f32x4*)(tile + row * 256 + col0 * 4 + 16);
    const float v[8] = {x.x, x.y, x.z, x.w, y.x, y.y, y.z, y.w};
    union { bf16x8 v; unsigned u[4]; } fh, fl;
#pragma unroll
    for (int q = 0; q < 4; ++q) { const unsigned uh = pg8::cvt_pk_bf16(v[2 * q], v[2 * q + 1]); fh.u[q] = uh; fl.u[q] = pg8::cvt_pk_bf16(v[2 * q] - bflo(uh), v[2 * q + 1] - bfhi(uh)); }
    hi = fh.v; lo = fl.v;
}
__device__ __forceinline__ bf16x8 frag_col2(LAS unsigned char* tile, int ra, int rb, int c) {
    float v[8];
#pragma unroll
    for (int q = 0; q < 4; ++q) { v[q] = *(LAS float*)(tile + (ra + q) * 256 + c * 4); v[4 + q] = *(LAS float*)(tile + (rb + q) * 256 + c * 4); }
    union { bf16x8 v; unsigned u[4]; } f;
#pragma unroll
    for (int q = 0; q < 4; ++q) f.u[q] = pg8::cvt_pk_bf16(v[2 * q], v[2 * q + 1]);
    return f.v;
}
constexpr int M_PB = 144;
constexpr int M_RB = 0, M_BB = 9216, M_KB = 18432, M_VB = 27648, M_GB = 36864, M_ULOC = 49152, M_PSEQ = 58368, M_UT = 67584, M_VT = 76800, M_BT = 86016, M_KT = 95232, M_OUT = 104448, M_SST = M_OUT, M_S0 = 120832, M_BONUS = 129024, M_GL = 129280, M_S0F = 130048;
typedef short s16x4_ __attribute__((ext_vector_type(4)));
__device__ __forceinline__ bf16x8 fragt2(LAS unsigned char* tile, int row, int ca, int cb) {
    union { bf16x8 v; s16x4_ h[2]; } f; f.h[0] = *(LAS s16x4_*)(tile + row * M_PB + ca * 2); f.h[1] = *(LAS s16x4_*)(tile + row * M_PB + cb * 2); return f.v;
}
__device__ __forceinline__ bf16x8 fragb(LAS unsigned char* tile, int row, int col0) { return *(LAS bf16x8*)(tile + row * M_PB + col0 * 2); }
__device__ __forceinline__ bf16x8 fragt2s(LAS unsigned char* tile, int row, int ca, int cb) { const int sw = 8 * (row >> 3); return fragt2(tile, row, (ca + sw) & 63, (cb + sw) & 63); }
__device__ __forceinline__ bf16x8 fragbs(LAS unsigned char* tile, int row, int col0) { return fragb(tile, row, (col0 + 8 * (row >> 3)) & 63); }
__device__ __forceinline__ bf16x8 fragb_col2(LAS unsigned char* tile, int ra, int rb, int c) {
    unsigned v[8];
#pragma unroll
    for (int q = 0; q < 4; ++q) { v[q] = *(LAS unsigned short*)(tile + (ra + q) * M_PB + c * 2); v[4 + q] = *(LAS unsigned short*)(tile + (rb + q) * M_PB + c * 2); }
    union { bf16x8 v; unsigned u[4]; } f;
#pragma unroll
    for (int q = 0; q < 4; ++q) f.u[q] = v[2 * q] | (v[2 * q + 1] << 16);
    return f.v;
}
__device__ __forceinline__ bf16x8 l1m_half(LAS unsigned char* p) { union { bf16x8 v; s16x4_ h[2]; } f; f.h[0] = *(LAS s16x4_*)p; f.h[1] = (s16x4_){0, 0, 0, 0}; return f.v; }
__device__ __forceinline__ bf16x8 l1m_pack2(const f32x4 x, const f32x4 y) { union { bf16x8 v; unsigned u[4]; } f; f.u[0] = pg8::cvt_pk_bf16(x[0], x[1]); f.u[1] = pg8::cvt_pk_bf16(x[2], x[3]); f.u[2] = pg8::cvt_pk_bf16(y[0], y[1]); f.u[3] = pg8::cvt_pk_bf16(y[2], y[3]); return f.v; }
__device__ __forceinline__ bf16x8 l1m_pack1(const f32x4 x) { union { bf16x8 v; unsigned u[4]; } f; f.u[0] = pg8::cvt_pk_bf16(x[0], x[1]); f.u[1] = pg8::cvt_pk_bf16(x[2], x[3]); f.u[2] = 0u; f.u[3] = 0u; return f.v; }
__device__ __forceinline__ void l1m_hilo2(const f32x4 x, const f32x4 y, bf16x8& hi, bf16x8& lo) {
    union { bf16x8 v; unsigned u[4]; } fh, fl;
    fh.u[0] = pg8::cvt_pk_bf16(x[0], x[1]); fh.u[1] = pg8::cvt_pk_bf16(x[2], x[3]); fh.u[2] = pg8::cvt_pk_bf16(y[0], y[1]); fh.u[3] = pg8::cvt_pk_bf16(y[2], y[3]);
    fl.u[0] = pg8::cvt_pk_bf16(x[0] - bflo(fh.u[0]), x[1] - bfhi(fh.u[0])); fl.u[1] = pg8::cvt_pk_bf16(x[2] - bflo(fh.u[1]), x[3] - bfhi(fh.u[1]));
    fl.u[2] = pg8::cvt_pk_bf16(y[0] - bflo(fh.u[2]), y[1] - bfhi(fh.u[2])); fl.u[3] = pg8::cvt_pk_bf16(y[2] - bflo(fh.u[3]), y[3] - bfhi(fh.u[3]));
    hi = fh.v; lo = fl.v;
}
__device__ __forceinline__ void l1m_store_c(LAS unsigned char* tile, int pitch, int r0, int col, int fq, const f32x4 v) {
    const unsigned w0 = pg8::cvt_pk_bf16(v[0], v[1]), w1 = pg8::cvt_pk_bf16(v[2], v[3]);
    LAS unsigned short* p = (LAS unsigned short*)(tile + (r0 + 4 * fq) * pitch + col * 2);
    p[0] = (unsigned short)(w0 & 0xffff); p[pitch / 2] = (unsigned short)(w0 >> 16); p[pitch] = (unsigned short)(w1 & 0xffff); p[3 * (pitch / 2)] = (unsigned short)(w1 >> 16);
}
template <int R> struct DinvRows {
    static __device__ __forceinline__ void run(const float (&nrow)[16], float (&x)[16], int c) {
        DinvRows<R - 1>::run(nrow, x, c);
        float acc4[4] = {(R == c) ? 1.f : 0.f, 0.f, 0.f, 0.f};
#pragma unroll
        for (int sc = 0; sc < R; ++sc)
            asm volatile("v_fmac_f32_dpp %0, %1, %2 row_newbcast:%3 row_mask:0xf bank_mask:0xf" : "+v"(acc4[sc & 3]) : "v"(nrow[sc]), "v"(x[sc]), "n"(R));
        x[R] = (acc4[0] + acc4[1]) + (acc4[2] + acc4[3]);
    }
};
template <> struct DinvRows<-1> { static __device__ __forceinline__ void run(const float (&)[16], float (&)[16], int) {} };
#define L1M_TR(dst, base, off) asm volatile("ds_read_b64_tr_b16 %0, %1 offset:%2" : "=&v"(dst) : "v"(base), "i"(off) : "memory")
#define L1M_TRWAIT() do { asm volatile("s_waitcnt lgkmcnt(0)" ::: "memory"); __builtin_amdgcn_sched_barrier(0); } while (0)
__device__ __forceinline__ bf16x8 l1m_join(const s16x4_ lo, const s16x4_ hi) { return (bf16x8){lo[0], lo[1], lo[2], lo[3], hi[0], hi[1], hi[2], hi[3]}; }
#define L1M_MFMA(A, B, C) __builtin_amdgcn_mfma_f32_16x16x32_bf16((A), (B), (C), 0, 0, 0)
__device__ __forceinline__ void l1m_block(LAS unsigned char* lds, int tid, f32x4 (&ST)[4], bf16* up, unsigned char* rec) {
    const int lane = tid & 63, wave = __builtin_amdgcn_readfirstlane(tid >> 6), fr = lane & 15, fq = lane >> 4;
    const int ct = wave & 3; const bool sideC = wave >= 4;
    const f32x4 zero4 = {0.f, 0.f, 0.f, 0.f};
    const unsigned trb4 = (unsigned)(size_t)lds + (4 * fq + (fr >> 2)) * 144 + (fr & 3) * 8, trb8 = (unsigned)(size_t)lds + (8 * fq + (fr >> 2)) * 144 + (fr & 3) * 8;
    {
        bf16x8 af[2], rf[2];
#pragma unroll
        for (int ks = 0; ks < 2; ++ks) { af[ks] = fragb(lds + L_ABF, 16 * ct + fr, 32 * ks + 8 * fq); rf[ks] = fragb(lds + L_RBF, 16 * ct + fr, 32 * ks + 8 * fq); }
        LAS unsigned char* bsrc = lds + (sideC ? L_KBF : L_BBF); LAS unsigned char* dstn = lds + (sideC ? L_ML : L_NL); LAS unsigned char* dstr = lds + (sideC ? L_RK : L_RB);
#pragma unroll
        for (int st = 0; st < 4; ++st) {
            if (st > ct) {
                if (st == ct + 1 && !(ct & 1)) { if (sideC) l1m_store_c(dstn, 144, 16 * ct, 16 * st + fr, fq, zero4); l1m_store_c(dstr, 144, 16 * ct, 16 * st + fr, fq, zero4); }
                continue;
            }
            f32x4 accn = zero4, accr = zero4;
#pragma unroll
            for (int ks = 0; ks < 2; ++ks) { const bf16x8 bf = fragb(bsrc, 16 * st + fr, 32 * ks + 8 * fq); accn = L1M_MFMA(af[ks], bf, accn); accr = L1M_MFMA(rf[ks], bf, accr); }
            if (st == ct) {
#pragma unroll
                for (int rg = 0; rg < 4; ++rg) { const int tl = 4 * fq + rg; accn[rg] = (fr < tl) ? accn[rg] : 0.f; accr[rg] = (fr <= tl) ? accr[rg] : 0.f;
                    if (!sideC) *(LAS float*)(lds + L_ND + ((16 * ct + tl) * 16 + fr) * 4) = accn[rg]; }
            }
            l1m_store_c(dstn, 144, 16 * ct, 16 * st + fr, fq, accn); l1m_store_c(dstr, 144, 16 * ct, 16 * st + fr, fq, accr);
        }
    }
    __syncthreads();
    if (wave == 0) {
        const int k = lane >> 4, c = lane & 15;
        float nrow[16], x[16];
#pragma unroll
        for (int q = 0; q < 4; ++q) { const f32x4 n = *(LAS f32x4*)(lds + L_ND + ((16 * k + c) * 16 + 4 * q) * 4); nrow[4 * q] = n[0]; nrow[4 * q + 1] = n[1]; nrow[4 * q + 2] = n[2]; nrow[4 * q + 3] = n[3]; }
        DinvRows<15>::run(nrow, x, c);
#pragma unroll
        for (int r = 0; r < 16; ++r) *(LAS unsigned short*)(lds + L_DINV + ((16 * k + r) * 16 + c) * 2) = (unsigned short)(pg8::cvt_pk_bf16(x[r], 0.f) & 0xffff);
    }
    f32x4 X[4];
    bf16x8 v01, v23;
    f32x4 Sc[4];
    f32x4 Oacc[4];
    if (!sideC) {
#pragma unroll
        for (int k = 0; k < 4; ++k)
#pragma unroll
            for (int rg = 0; rg < 4; ++rg) X[k][rg] = bf2f(*(LAS unsigned short*)(lds + L_ABF + (16 * k + 4 * fq + rg) * 144 + (16 * ct + fr) * 2));
    } else {
        s16x4_ tv[4], tp[4], tk[4][4];
        const unsigned tv8 = trb8 + 32 * ct, tv4 = trb4 + 32 * ct;
        L1M_TR(tv[0], tv8, L_VBF); L1M_TR(tv[1], tv8, L_VBF + 4 * 144); L1M_TR(tv[2], tv8, L_VBF + 32 * 144); L1M_TR(tv[3], tv8, L_VBF + 36 * 144);
#pragma unroll
        for (int blk = 0; blk < 4; ++blk) L1M_TR(tp[blk], tv4, L_VBF + 16 * blk * 144);
#pragma unroll
        for (int jt = 0; jt < 4; ++jt)
#pragma unroll
            for (int blk = 0; blk < 4; ++blk) L1M_TR(tk[jt][blk], trb4, L_KBF + 32 * jt + 16 * blk * 144);
        L1M_TRWAIT();
        const bf16x8 bv[2] = {l1m_join(tv[0], tv[1]), l1m_join(tv[2], tv[3])};
#pragma unroll
        for (int k = 0; k < 4; ++k) { f32x4 acc = zero4;
#pragma unroll
            for (int ks = 0; ks < 2; ++ks) if (32 * ks <= 16 * k + 15) acc = L1M_MFMA(fragb(lds + L_ML, 16 * k + fr, 32 * ks + 8 * fq), bv[ks], acc);
            X[k] = acc; }
        v01 = l1m_join(tp[0], tp[1]); v23 = l1m_join(tp[2], tp[3]);
#pragma unroll
        for (int jt = 0; jt < 4; ++jt) { f32x4 acc = zero4;
            acc = L1M_MFMA(l1m_join(tk[jt][0], tk[jt][1]), v01, acc); acc = L1M_MFMA(l1m_join(tk[jt][2], tk[jt][3]), v23, acc);
            Sc[jt] = acc; }
#pragma unroll
        for (int tt = 0; tt < 4; ++tt) { f32x4 acc = zero4;
            acc = L1M_MFMA(fragt2(lds + L_RK, 16 * tt + fr, 4 * fq, 16 + 4 * fq), v01, acc);
            if (tt >= 2) acc = L1M_MFMA(fragt2(lds + L_RK, 16 * tt + fr, 32 + 4 * fq, 48 + 4 * fq), v23, acc);
            Oacc[tt] = acc; }
    }
    __syncthreads();
    X[0] = L1M_MFMA(l1m_half(lds + L_DINV + ((0 + fr) * 16 + 4 * fq) * 2), l1m_pack1(X[0]), zero4);
    X[1] = L1M_MFMA(l1m_half(lds + L_NL + (16 + fr) * 144 + (4 * fq) * 2), l1m_pack1(X[0]), X[1]);
    X[1] = L1M_MFMA(l1m_half(lds + L_DINV + ((16 + fr) * 16 + 4 * fq) * 2), l1m_pack1(X[1]), zero4);
    const bf16x8 b01 = l1m_pack2(X[0], X[1]);
    X[2] = L1M_MFMA(fragt2(lds + L_NL, 32 + fr, 4 * fq, 16 + 4 * fq), b01, X[2]);
    X[2] = L1M_MFMA(l1m_half(lds + L_DINV + ((32 + fr) * 16 + 4 * fq) * 2), l1m_pack1(X[2]), zero4);
    X[3] = L1M_MFMA(fragt2(lds + L_NL, 48 + fr, 4 * fq, 16 + 4 * fq), b01, X[3]);
    X[3] = L1M_MFMA(l1m_half(lds + L_NL + (48 + fr) * 144 + (32 + 4 * fq) * 2), l1m_pack1(X[2]), X[3]);
    X[3] = L1M_MFMA(l1m_half(lds + L_DINV + ((48 + fr) * 16 + 4 * fq) * 2), l1m_pack1(X[3]), zero4);
    const bf16x8 b23 = l1m_pack2(X[2], X[3]);
#pragma unroll
    for (int tt = 0; tt < 4; ++tt) {
        f32x4 acc = zero4;
        if (!sideC) {
#pragma unroll
            for (int rg = 0; rg < 4; ++rg) acc[rg] = bf2f(*(LAS unsigned short*)(lds + L_RBF + (16 * tt + 4 * fq + rg) * 144 + (16 * ct + fr) * 2)); }
        else acc = Oacc[tt];
        acc = L1M_MFMA(fragt2(lds + L_RB, 16 * tt + fr, 4 * fq, 16 + 4 * fq), b01, acc);
        if (tt >= 2) acc = L1M_MFMA(fragt2(lds + L_RB, 16 * tt + fr, 32 + 4 * fq, 48 + 4 * fq), b23, acc);
        l1m_store_c(lds + (sideC ? L_XO : L_XR), 144, 16 * tt, 16 * ct + fr, fq, acc);
    }
    s16x4_ tb[4][4];
#pragma unroll
    for (int jt = 0; jt < 4; ++jt)
#pragma unroll
        for (int blk = 0; blk < 4; ++blk) L1M_TR(tb[jt][blk], trb4, L_BBF + 32 * jt + 16 * blk * 144);
    L1M_TRWAIT();
#pragma unroll
    for (int jt = 0; jt < 4; ++jt) {
        f32x4 acc = sideC ? Sc[jt] : zero4;
        acc = L1M_MFMA(l1m_join(tb[jt][0], tb[jt][1]), b01, acc);
        acc = L1M_MFMA(l1m_join(tb[jt][2], tb[jt][3]), b23, acc);
        if (!sideC && jt == ct) {
#pragma unroll
            for (int rg = 0; rg < 4; ++rg) acc[rg] += (4 * fq + rg == fr) ? 1.f : 0.f; }
        const f32x4 gl = *(LAS f32x4*)(lds + T_GL + (16 * jt + 4 * fq) * 4);
        acc *= gl;
        Sc[jt] = acc;
        if (!sideC) l1m_store_c(lds + L_PCT, 144, 16 * jt, 16 * ct + fr, fq, acc);
        else { pg8::u32x2 w; w.x = pg8::cvt_pk_bf16(acc[0], acc[1]); w.y = pg8::cvt_pk_bf16(acc[2], acc[3]); *(pg8::u32x2*)(rec + 8192 + ((16 * ct + fr) * 64 + 16 * jt + 4 * fq) * 2) = w; }
    }
    __syncthreads();
    {
        bf16x8 sh[2], sl[2];
        l1m_hilo2(ST[0], ST[1], sh[0], sl[0]); l1m_hilo2(ST[2], ST[3], sh[1], sl[1]);
#pragma unroll
        for (int jt = 0; jt < 4; ++jt) {
            f32x4 acc = sideC ? Sc[jt] : zero4;
#pragma unroll
            for (int s2 = 0; s2 < 2; ++s2) { const bf16x8 ap = fragt2(lds + L_PCT, 16 * jt + fr, 32 * s2 + 4 * fq, 32 * s2 + 16 + 4 * fq);
                acc = L1M_MFMA(ap, sh[s2], acc); acc = L1M_MFMA(ap, sl[s2], acc); }
            Sc[jt] = acc;
        }
#pragma unroll
        for (int jt = 0; jt < 4; ++jt) ST[jt] = Sc[jt];
    }
#pragma unroll
    for (int i = 0; i < 2; ++i) { const int e = tid + 512 * i, row = e >> 4, c16 = e & 15; *(v4u*)(up + (size_t)row * 128 + c16 * 8) = *(LAS v4u*)(lds + (c16 < 8 ? L_XO : L_XR) + row * 144 + (c16 & 7) * 16); }
    { const int row = tid >> 3, c16 = tid & 7; *(v4u*)(rec + row * 128 + c16 * 16) = *(LAS v4u*)(lds + L_PCT + row * 144 + c16 * 16); }
}
__device__ __forceinline__ void l1m_unit(const Args& a, LAS unsigned char* lds, int h, int s, int tid) {
    const bf16* P = (const bf16*)(a.ws + WS_P);
    const int lane = tid & 63, wave = __builtin_amdgcn_readfirstlane(tid >> 6), fr0 = lane & 15, fq0 = lane >> 4;
    f32x4 ST[4];
#pragma unroll
    for (int jt = 0; jt < 4; ++jt)
#pragma unroll
        for (int rg = 0; rg < 4; ++rg) ST[jt][rg] = (wave < 4 && jt == (wave & 3) && 4 * fq0 + rg == fr0) ? 1.f : 0.f;
    PrepRegs R; LoraFrags LF; lora_frags_load<true>(a, h, tid, LF);
    prep_consts_fill(a, lds, h, tid);
    __syncthreads();
    { const int mb = s * SEGLEN; auto src0 = [&](int slot) -> SlotSrc { const int m = mb + slot; SlotSrc r; r.cur = P + (size_t)m * PPITCH; r.prevb = m > 0 ? r.cur - PPITCH : nullptr; r.prevf = nullptr; return r; };
      prep_issue<true>(h, src0, tid, R); }
    for (int blk = 0; blk < NBLK; ++blk) {
        const int m0 = s * SEGLEN + blk * BLK;
        auto srcfn = [&](int slot) -> SlotSrc { const int m = m0 + slot; SlotSrc r; r.cur = P + (size_t)m * PPITCH; r.prevb = m > 0 ? r.cur - PPITCH : nullptr; r.prevf = nullptr; return r; };
        int tidv = tid; asm volatile("" : "+v"(tidv));
        prep_block<true, false, 64, true, true, true, true>(a, lds, h, srcfn, tidv, R, a.ws + WS_TL + ((size_t)h * (TP / BLK) + (m0 >> 6)) * TL_REC, LF);
        if (blk + 1 < NBLK) { const int m1 = m0 + BLK; auto src1 = [&](int slot) -> SlotSrc { const int m = m1 + slot; SlotSrc r; r.cur = P + (size_t)m * PPITCH; r.prevb = r.cur - PPITCH; r.prevf = nullptr; return r; };
            prep_issue<true>(h, src1, tidv, R); }
        l1m_block(lds, tidv, ST, (bf16*)a.out + ((size_t)h * TP + m0) * 128, a.ws + WS_TL + ((size_t)h * (TP / BLK) + (m0 >> 6)) * TL_REC);
    }
    __syncthreads();
    float* seg = (float*)(a.ws + WS_SEG) + ((size_t)(s * NH + h) * 2) * 4096;
#pragma unroll
    for (int jt = 0; jt < 4; ++jt) {
        if (wave >= 4) *(f32x4*)(seg + (size_t)(16 * (wave & 3) + fr0) * 64 + 16 * jt + 4 * fq0) = ST[jt];
        else {
            pg8::u32x2 wh, wl; wh.x = pg8::cvt_pk_bf16(ST[jt][0], ST[jt][1]); wh.y = pg8::cvt_pk_bf16(ST[jt][2], ST[jt][3]);
            wl.x = pg8::cvt_pk_bf16(ST[jt][0] - bflo(wh.x), ST[jt][1] - bfhi(wh.x)); wl.y = pg8::cvt_pk_bf16(ST[jt][2] - bflo(wh.y), ST[jt][3] - bfhi(wh.y));
            unsigned char* pmt = (unsigned char*)(seg + 4096) + ((16 * (wave & 3) + fr0) * 64 + 16 * jt + 4 * fq0) * 2;
            *(pg8::u32x2*)pmt = wh; *(pg8::u32x2*)(pmt + 8192) = wl; }
    }
}
struct L3Pre { v4u tl[5]; v4u up[2]; float bon, gl; };
__device__ __forceinline__ void l3m_issue(const Args& a, int h, int m0, int tid, L3Pre& R) {
    const unsigned char* rec = a.ws + WS_TL + ((size_t)h * (TP / BLK) + (m0 >> 6)) * TL_REC;
    const int go = (tid >> 3) * 128 + (tid & 7) * 16;
#pragma unroll
    for (int q = 0; q < 5; ++q) R.tl[q] = *(const v4u*)(rec + 8192 * q + go);
    const bf16* up = (const bf16*)a.out + ((size_t)h * TP + m0) * 128;
#pragma unroll
    for (int i = 0; i < 2; ++i) R.up[i] = *(const v4u*)(up + 8 * (tid + 512 * i));
    R.bon = 0.f; R.gl = 0.f;
    if (tid < 64) { R.bon = *(const float*)(rec + 40960 + tid * 4); R.gl = *(const float*)(rec + 41216 + tid * 4); }
}
__device__ __forceinline__ void l3m_unit(const Args& a, LAS unsigned char* lds, int h, int s, int tid) {
    const int lane = tid & 63, wave = __builtin_amdgcn_readfirstlane(tid >> 6), fr0 = lane & 15, fq0 = lane >> 4;
    const int cg = tid & 15, rg = tid >> 4;
    L3Pre R; l3m_issue(a, h, s * SEGLEN, tid, R);
    f32x4 S[2] = {{0.f, 0.f, 0.f, 0.f}, {0.f, 0.f, 0.f, 0.f}};
    const float* segb = (const float*)(a.ws + WS_SEG);
    for (int sp = 0; sp < s; ++sp) {
        const float* sl = segb + ((size_t)(sp * NH + h) * 2) * 4096; const float* pm = sl + 4096;
        f32x4 acc[2];
#pragma unroll
        for (int r = 0; r < 2; ++r) acc[r] = *(const f32x4*)(sl + (size_t)(2 * rg + r) * 64 + 4 * cg);
        if (sp > 0) {
#pragma unroll
            for (int r = 0; r < 2; ++r) *(LAS f32x4*)(lds + SL_OFF + ((2 * rg + r) * SLP + 4 * cg) * 4) = S[r];
#pragma unroll
            for (int i = 0; i < 2; ++i) { const int e = (tid + 512 * i) * 4; *(LAS f32x4*)(lds + PM_OFF + e * 4) = *(const f32x4*)(pm + e); }
            __syncthreads();
#pragma unroll 4
            for (int l4 = 0; l4 < 16; ++l4) {
                const f32x4 s0 = *(LAS f32x4*)(lds + SL_OFF + ((2 * rg) * SLP + 4 * l4) * 4), s1 = *(LAS f32x4*)(lds + SL_OFF + ((2 * rg + 1) * SLP + 4 * l4) * 4);
#pragma unroll
                for (int j = 0; j < 4; ++j) { const f32x4 p = *(LAS f32x4*)(lds + PM_OFF + ((4 * l4 + j) * 64 + 4 * cg) * 4); acc[0] += p * s0[j]; acc[1] += p * s1[j]; }
            }
            __syncthreads();
        }
        S[0] = acc[0]; S[1] = acc[1];
    }
#pragma unroll
    for (int r = 0; r < 2; ++r) {
        *(LAS f32x4*)(lds + M_SST + ((2 * rg + r) * 64 + 4 * cg) * 4) = S[r];
        *(LAS f32x4*)(lds + M_S0F + ((2 * rg + r) * 64 + 4 * cg) * 4) = S[r];
        pg8::u32x2 w; w.x = pg8::cvt_pk_bf16(S[r].x, S[r].y); w.y = pg8::cvt_pk_bf16(S[r].z, S[r].w);
        *(LAS pg8::u32x2*)(lds + M_S0 + ((2 * rg + r) * 64 + 4 * cg) * 2) = w;
    }
    __syncthreads();
    const int ita = wave & 3, tpa = wave >> 2;
    const int tt = wave >> 1, ih = wave & 1;
    f32x4 Sacc[2];
#pragma unroll
    for (int x = 0; x < 2; ++x)
#pragma unroll
        for (int rg4 = 0; rg4 < 4; ++rg4) Sacc[x][rg4] = *(LAS float*)(lds + M_SST + ((16 * tt + 4 * fq0 + rg4) * 64 + 16 * (2 * ih + x) + fr0) * 4);
    __syncthreads();
    for (int blk = 0; blk < NBLK; ++blk) {
        const int m0 = s * SEGLEN + blk * BLK;
        int fr = fr0, fq = fq0; asm volatile("" : "+v"(fr), "+v"(fq));
        {
            const int slot = tid >> 3, part = tid & 7;
#pragma unroll
            for (int q = 0; q < 5; ++q) *(LAS v4u*)(lds + 9216 * q + slot * M_PB + part * 16) = R.tl[q];
#pragma unroll
            for (int q = 1; q < 4; ++q) {
                LAS unsigned short* tp = (LAS unsigned short*)(lds + (q == 1 ? M_BT : q == 2 ? M_KT : M_VT) + (8 * part) * M_PB + ((slot + 8 * part) & 63) * 2);
                const v4u w = R.tl[q];
                tp[0 * (M_PB / 2)] = (unsigned short)(w.x & 0xffff); tp[1 * (M_PB / 2)] = (unsigned short)(w.x >> 16);
                tp[2 * (M_PB / 2)] = (unsigned short)(w.y & 0xffff); tp[3 * (M_PB / 2)] = (unsigned short)(w.y >> 16);
                tp[4 * (M_PB / 2)] = (unsigned short)(w.z & 0xffff); tp[5 * (M_PB / 2)] = (unsigned short)(w.z >> 16);
                tp[6 * (M_PB / 2)] = (unsigned short)(w.w & 0xffff); tp[7 * (M_PB / 2)] = (unsigned short)(w.w >> 16);
            }
#pragma unroll
            for (int i = 0; i < 2; ++i) { const int e = tid + 512 * i, sl2 = e >> 4, c = e & 15; *(LAS v4u*)(lds + (c < 8 ? M_ULOC : M_PSEQ) + sl2 * M_PB + (c & 7) * 16) = R.up[i]; }
            if (tid < 64) { *(LAS float*)(lds + M_BONUS + tid * 4) = R.bon; *(LAS float*)(lds + M_GL + tid * 4) = R.gl; }
        }
        __syncthreads();
        if (blk + 1 < NBLK) l3m_issue(a, h, m0 + BLK, tid, R);
        bf16x8 sbh[2], sbl[2];
#pragma unroll
        for (int ks = 0; ks < 2; ++ks) frag_row_hilo(lds + M_S0F, 16 * ita + fr, 32 * ks + 8 * fq, sbh[ks], sbl[ks]);
#pragma unroll
        for (int x = 0; x < 2; ++x) {
            const int ta = 2 * tpa + x;
            f32x4 acc;
#pragma unroll
            for (int rg4 = 0; rg4 < 4; ++rg4) acc[rg4] = bf2f(*(LAS unsigned short*)(lds + M_ULOC + (16 * ta + 4 * fq + rg4) * M_PB + (16 * ita + fr) * 2));
#pragma unroll
            for (int ks = 0; ks < 2; ++ks) {
                const bf16x8 ap = fragb(lds + M_PSEQ, 16 * ta + fr, 32 * ks + 8 * fq);
                acc = __builtin_amdgcn_mfma_f32_16x16x32_bf16(ap, sbh[ks], acc, 0, 0, 0);
                acc = __builtin_amdgcn_mfma_f32_16x16x32_bf16(ap, sbl[ks], acc, 0, 0, 0);
            }
            { pg8::u32x2 w; w.x = pk2(acc[0], acc[1]); w.y = pk2(acc[2], acc[3]); *(LAS pg8::u32x2*)(lds + M_UT + (16 * ita + fr) * M_PB + (16 * ta + 4 * fq) * 2) = w; }
        }
        __syncthreads();
        bf16x8 rbf[2];
#pragma unroll
        for (int ks = 0; ks < 2; ++ks) rbf[ks] = fragb(lds + M_RB, 16 * tt + fr, 32 * ks + 8 * fq);
        float pb[4][4], pk[4][4];
#pragma unroll
        for (int st = 0; st < 4; ++st) {
            f32x4 accb = {0.f, 0.f, 0.f, 0.f}, acck = {0.f, 0.f, 0.f, 0.f};
            if (st <= tt) {
#pragma unroll
                for (int ks = 0; ks < 2; ++ks) {
                    accb = __builtin_amdgcn_mfma_f32_16x16x32_bf16(fragb(lds + M_BB, 16 * st + fr, 32 * ks + 8 * fq), rbf[ks], accb, 0, 0, 0);
                    acck = __builtin_amdgcn_mfma_f32_16x16x32_bf16(fragb(lds + M_KB, 16 * st + fr, 32 * ks + 8 * fq), rbf[ks], acck, 0, 0, 0);
                }
            }
#pragma unroll
            for (int rg4 = 0; rg4 < 4; ++rg4) { const bool ok = (16 * st + 4 * fq + rg4) <= (16 * tt + fr); pb[st][rg4] = ok ? accb[rg4] : 0.f; pk[st][rg4] = ok ? acck[rg4] : 0.f; }
        }
#pragma unroll
        for (int x = 0; x < 2; ++x) {
            const int it = 2 * ih + x;
            f32x4 acc = {0.f, 0.f, 0.f, 0.f};
#pragma unroll
            for (int p2 = 0; p2 < 2; ++p2) {
                if (2 * p2 <= tt) {
                    union { bf16x8 v; unsigned u[4]; } afb, afk;
                    afb.u[0] = pg8::cvt_pk_bf16(pb[2 * p2][0], pb[2 * p2][1]); afb.u[1] = pg8::cvt_pk_bf16(pb[2 * p2][2], pb[2 * p2][3]); afb.u[2] = pg8::cvt_pk_bf16(pb[2 * p2 + 1][0], pb[2 * p2 + 1][1]); afb.u[3] = pg8::cvt_pk_bf16(pb[2 * p2 + 1][2], pb[2 * p2 + 1][3]);
                    afk.u[0] = pg8::cvt_pk_bf16(pk[2 * p2][0], pk[2 * p2][1]); afk.u[1] = pg8::cvt_pk_bf16(pk[2 * p2][2], pk[2 * p2][3]); afk.u[2] = pg8::cvt_pk_bf16(pk[2 * p2 + 1][0], pk[2 * p2 + 1][1]); afk.u[3] = pg8::cvt_pk_bf16(pk[2 * p2 + 1][2], pk[2 * p2 + 1][3]);
                    acc = __builtin_amdgcn_mfma_f32_16x16x32_bf16(afb.v, fragt2(lds + M_UT, 16 * it + fr, 32 * p2 + 4 * fq, 32 * p2 + 16 + 4 * fq), acc, 0, 0, 0);
                    acc = __builtin_amdgcn_mfma_f32_16x16x32_bf16(afk.v, fragt2s(lds + M_VT, 16 * it + fr, 32 * p2 + 4 * fq, 32 * p2 + 16 + 4 * fq), acc, 0, 0, 0);
                }
            }
#pragma unroll
            for (int ks = 0; ks < 2; ++ks) acc = __builtin_amdgcn_mfma_f32_16x16x32_bf16(rbf[ks], *(LAS bf16x8*)(lds + M_S0 + ((16 * it + fr) * 64 + 32 * ks + 8 * fq) * 2), acc, 0, 0, 0);
#pragma unroll
            for (int rg4 = 0; rg4 < 4; ++rg4) *(LAS float*)(lds + M_OUT + (16 * tt + 4 * fq + rg4) * 256 + (16 * it + fr) * 4) = acc[rg4];
        }
        {
            bf16x8 au[2], av[2];
#pragma unroll
            for (int ks = 0; ks < 2; ++ks) { au[ks] = fragb(lds + M_UT, 16 * tt + fr, 32 * ks + 8 * fq); av[ks] = fragbs(lds + M_VT, 16 * tt + fr, 32 * ks + 8 * fq); }
#pragma unroll
            for (int x = 0; x < 2; ++x) { const int tj = 2 * ih + x;
#pragma unroll
                for (int ks = 0; ks < 2; ++ks) {
                    Sacc[x] = __builtin_amdgcn_mfma_f32_16x16x32_bf16(au[ks], fragbs(lds + M_BT, 16 * tj + fr, 32 * ks + 8 * fq), Sacc[x], 0, 0, 0);
                    Sacc[x] = __builtin_amdgcn_mfma_f32_16x16x32_bf16(av[ks], fragbs(lds + M_KT, 16 * tj + fr, 32 * ks + 8 * fq), Sacc[x], 0, 0, 0);
                }
            }
        }
        __syncthreads();
#pragma unroll
        for (int x = 0; x < 2; ++x) { const int tj = 2 * ih + x; const float gl = *(LAS float*)(lds + M_GL + (16 * tj + fr) * 4);
            Sacc[x] *= gl;
#pragma unroll
            for (int rg4 = 0; rg4 < 4; ++rg4) { *(LAS unsigned short*)(lds + M_S0 + ((16 * tt + 4 * fq + rg4) * 64 + 16 * tj + fr) * 2) = (unsigned short)f2bf(Sacc[x][rg4]);
                *(LAS float*)(lds + M_S0F + ((16 * tt + 4 * fq + rg4) * 64 + 16 * tj + fr) * 4) = Sacc[x][rg4]; }
        }
        {
            const int slot = tid >> 3, part = tid & 7, c8 = h * HD + part * 8;
            float o[8], v[8], g[8], lw[8], lb[8];
            ld8l(lds, M_OUT + slot * 256 + part * 32, o); ld8f(a.in[I_LNW] + c8, lw); ld8f(a.in[I_LNB] + c8, lb);
            { const v4u wv = *(LAS v4u*)(lds + M_VB + slot * M_PB + part * 16), wg = *(LAS v4u*)(lds + M_GB + slot * M_PB + part * 16);
              v[0] = bflo(wv.x); v[1] = bfhi(wv.x); v[2] = bflo(wv.y); v[3] = bfhi(wv.y); v[4] = bflo(wv.z); v[5] = bfhi(wv.z); v[6] = bflo(wv.w); v[7] = bfhi(wv.w);
              g[0] = bflo(wg.x); g[1] = bfhi(wg.x); g[2] = bflo(wg.y); g[3] = bfhi(wg.y); g[4] = bflo(wg.z); g[5] = bfhi(wg.z); g[6] = bflo(wg.w); g[7] = bfhi(wg.w); }
            float sm = 0.f;
#pragma unroll
            for (int j = 0; j < 8; ++j) sm += o[j];
            const float mean = allreduce8(sm) * (1.f / 64.f);
            float q = 0.f;
#pragma unroll
            for (int j = 0; j < 8; ++j) { o[j] -= mean; q += o[j] * o[j]; }
            const float rstd = 1.0f / sqrtf(allreduce8(q) * (1.f / 64.f) + GN_EPS);
            const float bonus = *(LAS float*)(lds + M_BONUS + slot * 4);
            v4u w; float res[8];
#pragma unroll
            for (int j = 0; j < 8; ++j) res[j] = (o[j] * rstd * lw[j] + lb[j] + bonus * v[j]) * g[j];
            w.x = pk2(res[0], res[1]); w.y = pk2(res[2], res[3]); w.z = pk2(res[4], res[5]); w.w = pk2(res[6], res[7]);
            *(v4u*)((bf16*)(a.ws + WS_MIX) + (size_t)(m0 + slot) * DM + c8) = w;
        }
        __syncthreads();
    }
    if (s == SEGS - 1) {
#pragma unroll
        for (int x = 0; x < 2; ++x)
#pragma unroll
            for (int rg4 = 0; rg4 < 4; ++rg4) a.out[O_PST + ((size_t)h * HD + 16 * tt + 4 * fq0 + rg4) * HD + 16 * (2 * ih + x) + fr0] = Sacc[x][rg4];
    }
}

constexpr int S_VB = 0, S_GB = 9216, S_OR = 18432, S_ORP = 272, S_PCT = 35840, S_BUF = 45056, S_OUT = 90112, S_S0F = 106496, S_S0B = 18432, S_BON = 143360, S_LN = 143872;
struct L3sPre { v4u pct, v, g, orr[2]; pg8::u32x2 sc[2]; float bon; };
__device__ __forceinline__ void l3s_issue(const Args& a, int h, int m0, int tid, L3sPre& R) {
    const unsigned char* rec = a.ws + WS_TL + ((size_t)h * (TP / BLK) + (m0 >> 6)) * TL_REC;
    const int go = (tid >> 3) * 128 + (tid & 7) * 16;
    R.pct = *(const v4u*)(rec + go); R.v = *(const v4u*)(rec + 24576 + go); R.g = *(const v4u*)(rec + 32768 + go);
    const bf16* up = (const bf16*)a.out + ((size_t)h * TP + m0) * 128;
#pragma unroll
    for (int i = 0; i < 2; ++i) R.orr[i] = *(const v4u*)(up + 8 * (tid + 512 * i));
    const int lane = tid & 63, wave = tid >> 6, fr = lane & 15, fq = lane >> 4, it = wave & 3, jh = wave >> 2;
#pragma unroll
    for (int x = 0; x < 2; ++x) R.sc[x] = *(const pg8::u32x2*)(rec + 8192 + ((16 * it + fr) * 64 + 16 * (2 * jh + x) + 4 * fq) * 2);
    R.bon = 0.f; if (tid < 64) R.bon = *(const float*)(rec + 40960 + tid * 4);
}
__device__ __forceinline__ void l3s_unit(const Args& a, LAS unsigned char* lds, int h, int s, int tid) {
    const int lane = tid & 63, wave = __builtin_amdgcn_readfirstlane(tid >> 6), fr0 = lane & 15, fq0 = lane >> 4;
    L3sPre R; l3s_issue(a, h, s * SEGLEN, tid, R);
    if (tid < 128) *(LAS float*)(lds + S_LN + tid * 4) = a.in[tid < 64 ? I_LNW : I_LNB][h * HD + (tid & 63)];
    const int itc = wave & 3, jh = wave >> 2;
    const float* segb = (const float*)(a.ws + WS_SEG);
    {
        const int e0 = tid * 4, e1 = (tid + 512) * 4;
        int cb = (s > 0 ? s - 1 : 0) & 1;
        {
            f32x4 v0 = {0.f, 0.f, 0.f, 0.f}, v1 = {0.f, 0.f, 0.f, 0.f};
            if (s > 0) { const float* sl = segb + ((size_t)(0 * NH + h) * 2) * 4096; v0 = *(const f32x4*)(sl + e0); v1 = *(const f32x4*)(sl + e1); }
#pragma unroll
            for (int i = 0; i < 2; ++i) { const f32x4 v = i ? v1 : v0; const int e = i ? e1 : e0, row = e >> 6, col = e & 63;
                pg8::u32x2 wh, wl; wh.x = pg8::cvt_pk_bf16(v[0], v[1]); wh.y = pg8::cvt_pk_bf16(v[2], v[3]);
                wl.x = pg8::cvt_pk_bf16(v[0] - bflo(wh.x), v[1] - bfhi(wh.x)); wl.y = pg8::cvt_pk_bf16(v[2] - bflo(wh.y), v[3] - bfhi(wh.y));
                *(LAS pg8::u32x2*)(lds + S_S0F + cb * S_S0B + row * M_PB + col * 2) = wh; *(LAS pg8::u32x2*)(lds + S_S0F + cb * S_S0B + 9216 + row * M_PB + col * 2) = wl; }
        }
        v4u pmh, pml; f32x4 sl2[2];
        const int prow = tid >> 3, ppc = tid & 7;
        auto chain_load = [&](int sp) { const float* sl = segb + ((size_t)(sp * NH + h) * 2) * 4096; const unsigned char* pmt = (const unsigned char*)(sl + 4096);
            pmh = *(const v4u*)(pmt + prow * 128 + ppc * 16); pml = *(const v4u*)(pmt + 8192 + prow * 128 + ppc * 16);
#pragma unroll
            for (int x = 0; x < 2; ++x) sl2[x] = *(const f32x4*)(sl + (size_t)(16 * itc + fr0) * 64 + 16 * (2 * jh + x) + 4 * fq0); };
        if (s > 1) chain_load(1);
        const unsigned trl = (unsigned)(size_t)lds + (8 * fq0 + (fr0 >> 2)) * M_PB + (fr0 & 3) * 8 + 32 * (2 * jh);
        for (int sp = 1; sp < s; ++sp) {
            LAS unsigned char* pmb = lds + (sp & 1) * 18432;
            *(LAS v4u*)(pmb + prow * M_PB + ppc * 16) = pmh; *(LAS v4u*)(pmb + 9216 + prow * M_PB + ppc * 16) = pml;
            f32x4 acc[2] = {sl2[0], sl2[1]};
            __syncthreads();
            if (sp + 1 < s) chain_load(sp + 1);
            LAS unsigned char* s0c = lds + S_S0F + cb * S_S0B; LAS unsigned char* s0n = lds + S_S0F + (cb ^ 1) * S_S0B;
            bf16x8 bh[2], bl[2];
#pragma unroll
            for (int ks = 0; ks < 2; ++ks) { bh[ks] = fragb(s0c, 16 * itc + fr0, 32 * ks + 8 * fq0); bl[ks] = fragb(s0c + 9216, 16 * itc + fr0, 32 * ks + 8 * fq0); }
            const unsigned trb = trl + (sp & 1) * 18432;
            s16x4_ th[2][2][2], tlo[2][2][2];
#pragma unroll
            for (int x = 0; x < 2; ++x)
#pragma unroll
                for (int ks = 0; ks < 2; ++ks)
#pragma unroll
                    for (int hf = 0; hf < 2; ++hf) { L1M_TR(th[x][ks][hf], trb, (32 * ks + 4 * hf) * 144 + 32 * x); L1M_TR(tlo[x][ks][hf], trb, 9216 + (32 * ks + 4 * hf) * 144 + 32 * x); }
            L1M_TRWAIT();
#pragma unroll
            for (int x = 0; x < 2; ++x) {
#pragma unroll
                for (int ks = 0; ks < 2; ++ks) { const bf16x8 ah = l1m_join(th[x][ks][0], th[x][ks][1]), al = l1m_join(tlo[x][ks][0], tlo[x][ks][1]);
                    acc[x] = __builtin_amdgcn_mfma_f32_16x16x32_bf16(ah, bh[ks], acc[x], 0, 0, 0); acc[x] = __builtin_amdgcn_mfma_f32_16x16x32_bf16(ah, bl[ks], acc[x], 0, 0, 0); acc[x] = __builtin_amdgcn_mfma_f32_16x16x32_bf16(al, bh[ks], acc[x], 0, 0, 0); }
                pg8::u32x2 wh, wl; wh.x = pg8::cvt_pk_bf16(acc[x][0], acc[x][1]); wh.y = pg8::cvt_pk_bf16(acc[x][2], acc[x][3]);
                wl.x = pg8::cvt_pk_bf16(acc[x][0] - bflo(wh.x), acc[x][1] - bfhi(wh.x)); wl.y = pg8::cvt_pk_bf16(acc[x][2] - bflo(wh.y), acc[x][3] - bfhi(wh.y));
                *(LAS pg8::u32x2*)(s0n + (16 * itc + fr0) * M_PB + (16 * (2 * jh + x) + 4 * fq0) * 2) = wh; *(LAS pg8::u32x2*)(s0n + 9216 + (16 * itc + fr0) * M_PB + (16 * (2 * jh + x) + 4 * fq0) * 2) = wl;
            }
            cb ^= 1;
        }
        __syncthreads();
    }
    const int tt = wave >> 1, ih = wave & 1;
    for (int blk = 0; blk < NBLK; ++blk) {
        const int m0 = s * SEGLEN + blk * BLK;
        int fr = fr0, fq = fq0; asm volatile("" : "+v"(fr), "+v"(fq));
        LAS unsigned char* tb = lds + (blk & 1) * S_BUF;
        LAS unsigned char* s0c = lds + S_S0F + (blk & 1) * S_S0B; LAS unsigned char* s0n = lds + S_S0F + ((blk + 1) & 1) * S_S0B;
        {
            const int slot = tid >> 3, part = tid & 7;
            *(LAS v4u*)(tb + S_VB + slot * M_PB + part * 16) = R.v; *(LAS v4u*)(tb + S_GB + slot * M_PB + part * 16) = R.g; *(LAS v4u*)(tb + S_PCT + slot * M_PB + part * 16) = R.pct;
#pragma unroll
            for (int i = 0; i < 2; ++i) { const int e = tid + 512 * i; *(LAS v4u*)(tb + S_OR + (e >> 4) * S_ORP + (e & 15) * 16) = R.orr[i]; }
            if (tid < 64) *(LAS float*)(lds + S_BON + (blk & 1) * 256 + tid * 4) = R.bon;
        }
        const f32x4 sc0 = {bflo(R.sc[0].x), bfhi(R.sc[0].x), bflo(R.sc[0].y), bfhi(R.sc[0].y)}, sc1 = {bflo(R.sc[1].x), bfhi(R.sc[1].x), bflo(R.sc[1].y), bfhi(R.sc[1].y)};
        __syncthreads();
        if (blk + 1 < NBLK) l3s_issue(a, h, m0 + BLK, tid, R);
        {
            bf16x8 ar[2];
#pragma unroll
            for (int ks = 0; ks < 2; ++ks) ar[ks] = *(LAS bf16x8*)(tb + S_OR + (16 * tt + fr) * S_ORP + (64 + 32 * ks + 8 * fq) * 2);
#pragma unroll
            for (int x = 0; x < 2; ++x) {
                const int it = 2 * ih + x;
                f32x4 acc;
#pragma unroll
                for (int rg4 = 0; rg4 < 4; ++rg4) acc[rg4] = bf2f(*(LAS unsigned short*)(tb + S_OR + (16 * tt + 4 * fq + rg4) * S_ORP + (16 * it + fr) * 2));
#pragma unroll
                for (int ks = 0; ks < 2; ++ks) { const bf16x8 bh = fragb(s0c, 16 * it + fr, 32 * ks + 8 * fq), bl = fragb(s0c + 9216, 16 * it + fr, 32 * ks + 8 * fq);
                    acc = __builtin_amdgcn_mfma_f32_16x16x32_bf16(ar[ks], bh, acc, 0, 0, 0); acc = __builtin_amdgcn_mfma_f32_16x16x32_bf16(ar[ks], bl, acc, 0, 0, 0); }
#pragma unroll
                for (int rg4 = 0; rg4 < 4; ++rg4) *(LAS float*)(lds + S_OUT + (16 * tt + 4 * fq + rg4) * 256 + (16 * it + fr) * 4) = acc[rg4];
            }
        }
        {
            bf16x8 bh[2], bl[2];
#pragma unroll
            for (int ks = 0; ks < 2; ++ks) { bh[ks] = fragb(s0c, 16 * itc + fr, 32 * ks + 8 * fq); bl[ks] = fragb(s0c + 9216, 16 * itc + fr, 32 * ks + 8 * fq); }
#pragma unroll
            for (int x = 0; x < 2; ++x) {
                const int jt = 2 * jh + x;
                f32x4 acc = x == 0 ? sc0 : sc1;
#pragma unroll
                for (int ks = 0; ks < 2; ++ks) { const bf16x8 ap = fragb(tb + S_PCT, 16 * jt + fr, 32 * ks + 8 * fq);
                    acc = __builtin_amdgcn_mfma_f32_16x16x32_bf16(ap, bh[ks], acc, 0, 0, 0); acc = __builtin_amdgcn_mfma_f32_16x16x32_bf16(ap, bl[ks], acc, 0, 0, 0); }
                {
                    pg8::u32x2 wh, wl; wh.x = pg8::cvt_pk_bf16(acc[0], acc[1]); wh.y = pg8::cvt_pk_bf16(acc[2], acc[3]);
                    wl.x = pg8::cvt_pk_bf16(acc[0] - bflo(wh.x), acc[1] - bfhi(wh.x)); wl.y = pg8::cvt_pk_bf16(acc[2] - bflo(wh.y), acc[3] - bfhi(wh.y));
                    *(LAS pg8::u32x2*)(s0n + (16 * itc + fr) * M_PB + (16 * jt + 4 * fq) * 2) = wh; *(LAS pg8::u32x2*)(s0n + 9216 + (16 * itc + fr) * M_PB + (16 * jt + 4 * fq) * 2) = wl; }
                if (s == SEGS - 1 && blk == NBLK - 1) *(f32x4*)(a.out + O_PST + (size_t)h * HD * HD + (16 * itc + fr) * 64 + 16 * jt + 4 * fq) = acc;
            }
        }
        __syncthreads();
        {
            const int slot = tid >> 3, part = tid & 7, c8 = h * HD + part * 8;
            float o[8], v[8], g[8], lw[8], lb[8];
            ld8l(lds, S_OUT + slot * 256 + part * 32, o); ld8l(lds, S_LN + part * 32, lw); ld8l(lds, S_LN + 256 + part * 32, lb);
            { const v4u wv = *(LAS v4u*)(tb + S_VB + slot * M_PB + part * 16), wg = *(LAS v4u*)(tb + S_GB + slot * M_PB + part * 16);
              v[0] = bflo(wv.x); v[1] = bfhi(wv.x); v[2] = bflo(wv.y); v[3] = bfhi(wv.y); v[4] = bflo(wv.z); v[5] = bfhi(wv.z); v[6] = bflo(wv.w); v[7] = bfhi(wv.w);
              g[0] = bflo(wg.x); g[1] = bfhi(wg.x); g[2] = bflo(wg.y); g[3] = bfhi(wg.y); g[4] = bflo(wg.z); g[5] = bfhi(wg.z); g[6] = bflo(wg.w); g[7] = bfhi(wg.w); }
            float sm = 0.f;
#pragma unroll
            for (int j = 0; j < 8; ++j) sm += o[j];
            const float mean = allreduce8(sm) * (1.f / 64.f);
            float q = 0.f;
#pragma unroll
            for (int j = 0; j < 8; ++j) { o[j] -= mean; q += o[j] * o[j]; }
            const float rstd = 1.0f / sqrtf(allreduce8(q) * (1.f / 64.f) + GN_EPS);
            const float bonus = *(LAS float*)(lds + S_BON + (blk & 1) * 256 + slot * 4);
            v4u w; float res[8];
#pragma unroll
            for (int j = 0; j < 8; ++j) res[j] = (o[j] * rstd * lw[j] + lb[j] + bonus * v[j]) * g[j];
            w.x = pk2(res[0], res[1]); w.y = pk2(res[2], res[3]); w.z = pk2(res[4], res[5]); w.w = pk2(res[6], res[7]);
            *(v4u*)((bf16*)(a.ws + WS_MIX) + (size_t)(m0 + slot) * DM + c8) = w;
        }
    }
    __syncthreads();
}

__device__ __forceinline__ void sample_unit(const Args& a, LAS unsigned char* lds, int h, int bg, int tid) {
    const bf16* P = (const bf16*)(a.ws + WS_P);
    const int cg = tid & 15, rg = tid >> 4;
    auto srcfn = [&](int slot) -> SlotSrc { const int b = bg * 16 + (slot >> 2), t = slot & 3; const int m = TP + b * TS + t; SlotSrc r; r.cur = P + (size_t)m * PPITCH;
        r.prevb = t > 0 ? r.cur - PPITCH : nullptr; r.prevf = t > 0 ? nullptr : a.in[I_SHIFT] + (size_t)b * RCOLS; return r; };
    { PrepRegs R0; LoraFrags LF0; prep_block<true, true, 4, false, false, false, false>(a, lds, h, srcfn, tid, R0, nullptr, LF0); }
    constexpr int NBI = 4;
    f32x4 Sn[NBI][2];
    auto sload = [&](int b0) {
#pragma unroll
        for (int q = 0; q < NBI; ++q) { const float* sp = a.in[I_STATE] + (((size_t)(b0 + q) * NH + h) * HD) * HD;
#pragma unroll
            for (int r = 0; r < 2; ++r) Sn[q][r] = *(const f32x4*)(sp + (size_t)(2 * rg + r) * HD + 4 * cg); } };
    sload(bg * 16);
    const int coff = cg * 16;
    for (int bl = 0; bl < 16; bl += NBI) {
        const int b = bg * 16 + bl;
        f2 SX[NBI][2][2];
#pragma unroll
        for (int q = 0; q < NBI; ++q) { SX[q][0][0] = Sn[q][0].xy; SX[q][0][1] = Sn[q][0].zw; SX[q][1][0] = Sn[q][1].xy; SX[q][1][1] = Sn[q][1].zw; }
        if (bl + NBI < 16) sload(b + NBI);
#pragma unroll
        for (int tt = 0; tt < 4; ++tt) {
            L3Ops O[NBI];
#pragma unroll
            for (int q = 0; q < NBI; ++q) l3_load(lds, 4 * (bl + q) + tt, coff, rg, O[q]);
#pragma unroll
            for (int q = 0; q < NBI; ++q) l3_compute<4>(lds, SX[q], O[q], 4 * (bl + q) + tt, cg, rg, coff);
        }
#pragma unroll
        for (int q = 0; q < NBI; ++q) { float* so = a.out + O_SST + (((size_t)(b + q) * NH + h) * HD) * HD;
#pragma unroll
            for (int r = 0; r < 2; ++r) *(f32x4*)(so + (size_t)(2 * rg + r) * HD + 4 * cg) = (f32x4){SX[q][r][0].x, SX[q][r][0].y, SX[q][r][1].x, SX[q][r][1].y}; }
    }
    __syncthreads();
    post_block(a, lds, h, [&](int slot) -> long { return TP + (bg * 16 + (slot >> 2)) * TS + (slot & 3); }, tid);
    __syncthreads();
}
}

namespace at {
constexpr int KTPB = 144;
constexpr int P_KEYS = 208, P_VTPB = 432;
constexpr int P_KT = 0, P_VT = P_KT + P_KEYS * KTPB, P_END = P_VT + 64 * P_VTPB;
constexpr int S_KEYS = 160, S_VTPB = 336;
constexpr int S_KT = 0, S_VT = S_KEYS * KTPB, S_STRIDE = S_VT + 64 * S_VTPB;
static_assert(P_END <= 131072 && 2 * S_STRIDE <= 131072, "attention LDS map");
typedef short s16x4 __attribute__((ext_vector_type(4)));

__device__ __forceinline__ void attn_wave16(LAS unsigned char* kt, LAS unsigned char* vt, int vtpb, int kt0, const bf16x8 (&qf)[2], int qrel, float slope, float sink, int kmin, f32x4 (&o)[4], int lane) {
    const int fr = lane & 15, fq = lane >> 4;
    float p[10][4];
    float mx = -INFINITY;
#pragma unroll
    for (int tl = 0; tl < 9; ++tl) {
        f32x4 acc = {0.f, 0.f, 0.f, 0.f};
#pragma unroll
        for (int ks = 0; ks < 2; ++ks) {
            const bf16x8 kf = *(LAS bf16x8*)(kt + ((kt0 + tl) * 16 + fr) * KTPB + (32 * ks + 8 * fq) * 2);
            acc = __builtin_amdgcn_mfma_f32_16x16x32_bf16(kf, qf[ks], acc, 0, 0, 0);
        }
#pragma unroll
        for (int rg = 0; rg < 4; ++rg) {
            const int kidx = (kt0 + tl) * 16 + 4 * fq + rg, dist = qrel - kidx;
            bool ok = kidx >= kmin;
            if (tl == 0 || tl == 8) ok = ok && dist >= 0 && dist < WIN;
            const float s = ok ? acc[rg] * 0.125f - slope * (float)dist : -INFINITY;
            p[tl][rg] = s; mx = fmaxf(mx, s);
        }
    }
#pragma unroll
    for (int rg = 0; rg < 4; ++rg) p[9][rg] = -INFINITY;
    mx = fmaxf(mx, __shfl_xor(mx, 16)); mx = fmaxf(mx, __shfl_xor(mx, 32));
    mx = fmaxf(mx, sink);
    float sum = 0.f;
#pragma unroll
    for (int tl = 0; tl < 10; ++tl)
#pragma unroll
        for (int rg = 0; rg < 4; ++rg) { const float e = __expf(p[tl][rg] - mx); p[tl][rg] = e; sum += e; }
    sum += __shfl_xor(sum, 16); sum += __shfl_xor(sum, 32);
    const float inv = 1.0f / (sum + __expf(sink - mx));
#pragma unroll
    for (int dt = 0; dt < 4; ++dt) o[dt] = (f32x4){0.f, 0.f, 0.f, 0.f};
#pragma unroll
    for (int pr = 0; pr < 5; ++pr) {
        union { bf16x8 v; unsigned u[4]; } af;
        af.u[0] = pk2(p[2 * pr][0] * inv, p[2 * pr][1] * inv); af.u[1] = pk2(p[2 * pr][2] * inv, p[2 * pr][3] * inv);
        af.u[2] = pk2(p[2 * pr + 1][0] * inv, p[2 * pr + 1][1] * inv); af.u[3] = pk2(p[2 * pr + 1][2] * inv, p[2 * pr + 1][3] * inv);
#pragma unroll
        for (int dt = 0; dt < 4; ++dt) {
            LAS unsigned char* vp = vt + (16 * dt + fr) * vtpb + ((kt0 + 2 * pr) * 16 + 4 * fq) * 2;
            union { bf16x8 v; s16x4 h[2]; } bfv;
            bfv.h[0] = *(LAS s16x4*)vp; bfv.h[1] = *(LAS s16x4*)(vp + 32);
            o[dt] = __builtin_amdgcn_mfma_f32_16x16x32_bf16(af.v, bfv.v, o[dt], 0, 0, 0);
        }
    }
}

struct KVRegs { v4u k[4], v[4]; };
constexpr int P_OST = P_END;
static_assert(P_OST + 8 * 4096 <= 131072, "attention LDS map (O stage)");
__device__ __forceinline__ void kv_issue(const Args& a, int qb, int kvh, int tid, KVRegs& R) {
    const bf16* P = (const bf16*)(a.ws + WS_P);
    const int tok0 = qb * 64 - 128;
#pragma unroll
    for (int i = 0; i < 4; ++i) {
        const int idx = tid + 512 * i, row = idx >> 3, ch = idx & 7, tok = tok0 + row;
        R.k[i] = (v4u){0u, 0u, 0u, 0u}; R.v[i] = (v4u){0u, 0u, 0u, 0u};
        if (idx < P_KEYS * 8 && tok >= 0 && row < 192) { const bf16* pr = P + (size_t)tok * PPITCH + kvh * HD + 8 * ch; R.k[i] = *(const v4u*)(pr + C_SK); R.v[i] = *(const v4u*)(pr + C_SV); }
    }
}
__device__ __forceinline__ void prompt_unit(const Args& a, LAS unsigned char* lds, int qb, int kvh, int tid, KVRegs& R, int nqb, int nkvh) {
    const bf16* P = (const bf16*)(a.ws + WS_P);
    bf16* MIX = (bf16*)(a.ws + WS_MIX);
    const int lane = tid & 63, wave = __builtin_amdgcn_readfirstlane(tid >> 6), fr = lane & 15, fq = lane >> 4;
    const int q0 = qb * 64, tok0 = q0 - 128;
#pragma unroll
    for (int i = 0; i < 4; ++i) {
        const int idx = tid + 512 * i;
        if (idx < P_KEYS * 8) {
            const int row = idx >> 3, ch = idx & 7;
            const v4u kv = R.k[i], vv = R.v[i];
            *(LAS v4u*)(lds + P_KT + row * KTPB + ch * 16) = kv;
            LAS unsigned short* vt = (LAS unsigned short*)(lds + P_VT + (8 * ch) * P_VTPB + row * 2);
            vt[0 * (P_VTPB / 2)] = (unsigned short)(vv.x & 0xffff); vt[1 * (P_VTPB / 2)] = (unsigned short)(vv.x >> 16);
            vt[2 * (P_VTPB / 2)] = (unsigned short)(vv.y & 0xffff); vt[3 * (P_VTPB / 2)] = (unsigned short)(vv.y >> 16);
            vt[4 * (P_VTPB / 2)] = (unsigned short)(vv.z & 0xffff); vt[5 * (P_VTPB / 2)] = (unsigned short)(vv.z >> 16);
            vt[6 * (P_VTPB / 2)] = (unsigned short)(vv.w & 0xffff); vt[7 * (P_VTPB / 2)] = (unsigned short)(vv.w >> 16);
        }
    }
    const int g = wave >> 1, half = wave & 1, h = kvh * 4 + g;
    bf16x8 qf[2][2];
#pragma unroll
    for (int i = 0; i < 2; ++i)
#pragma unroll
        for (int ks = 0; ks < 2; ++ks) qf[i][ks] = *(const bf16x8*)(P + (size_t)(q0 + 32 * half + 16 * i + fr) * PPITCH + C_Q + h * HD + 32 * ks + 8 * fq);
    __syncthreads();
    if (nqb >= 0) kv_issue(a, nqb, nkvh, tid, R);
    const float slope = exp2f(-0.5f * (float)(h + 1)), sink = a.in[I_SINK][h];
    const int kmin = tok0 < 0 ? -tok0 : 0;
    LAS unsigned char* ost = lds + P_OST + wave * 4096;
#pragma unroll 1
    for (int i = 0; i < 2; ++i) {
        const int ql = 32 * half + 16 * i, qa = q0 + ql;
        f32x4 o[4];
        if (i == 0) attn_wave16(lds + P_KT, lds + P_VT, P_VTPB, ql >> 4, qf[0], ql + 128 + fr, slope, sink, kmin, o, lane);
        else attn_wave16(lds + P_KT, lds + P_VT, P_VTPB, ql >> 4, qf[1], ql + 128 + fr, slope, sink, kmin, o, lane);
#pragma unroll
        for (int dt = 0; dt < 4; ++dt)
#pragma unroll
            for (int rg = 0; rg < 4; ++rg) *(LAS unsigned short*)(ost + (4 * fq + rg) * 128 + (16 * dt + fr) * 2) = (unsigned short)f2bf(o[dt][rg]);
        asm volatile("s_waitcnt lgkmcnt(0)" ::: "memory");
#pragma unroll
        for (int c2 = 0; c2 < 2; ++c2) { const int row = lane >> 2, c = (lane & 3) + 4 * c2;
            const v4u w = *(LAS v4u*)(ost + row * 128 + c * 16);
            *(v4u*)(MIX + (size_t)(qa + row) * DM + CW + h * HD + 8 * c) = w; }
        asm volatile("s_waitcnt lgkmcnt(0)" ::: "memory");
    }
    __syncthreads();
}

__device__ __forceinline__ void sample_unit(const Args& a, LAS unsigned char* lds, int b, int kp, int tid) {
    const bf16* P = (const bf16*)(a.ws + WS_P);
    bf16* MIX = (bf16*)(a.ws + WS_MIX);
    const int lane = tid & 63, wave = __builtin_amdgcn_readfirstlane(tid >> 6), fr = lane & 15, fq = lane >> 4;
    struct SRow { f32x4 k0, k1, v0, v1; };
    auto sload = [&](int i, SRow& r) {
        const int idx = tid + 512 * i;
        const int e = idx / (S_KEYS * 8), rem = idx - e * (S_KEYS * 8), row = rem >> 3, ch = rem & 7, kvh = 2 * kp + e;
        r.k0 = (f32x4){0.f, 0.f, 0.f, 0.f}; r.k1 = r.k0; r.v0 = r.k0; r.v1 = r.k0;
        if (row < WIN) {
            const size_t src = (((size_t)b * WIN + row) * KVH + kvh) * HD + 8 * ch;
            r.k0 = *(const f32x4*)(a.in[I_CK] + src); r.k1 = *(const f32x4*)(a.in[I_CK] + src + 4); r.v0 = *(const f32x4*)(a.in[I_CV] + src); r.v1 = *(const f32x4*)(a.in[I_CV] + src + 4);
        } else if (row < WIN + TS) {
            const bf16* pr = P + (size_t)(TP + b * TS + row - WIN) * PPITCH + kvh * HD + 8 * ch;
            float kf[8], vf[8]; rw::ld8bf(pr + C_SK, kf); rw::ld8bf(pr + C_SV, vf);
            r.k0 = (f32x4){kf[0], kf[1], kf[2], kf[3]}; r.k1 = (f32x4){kf[4], kf[5], kf[6], kf[7]}; r.v0 = (f32x4){vf[0], vf[1], vf[2], vf[3]}; r.v1 = (f32x4){vf[4], vf[5], vf[6], vf[7]};
        }
    };
    auto sstore = [&](int i, const SRow& r) {
        const int idx = tid + 512 * i;
        const int e = idx / (S_KEYS * 8), rem = idx - e * (S_KEYS * 8), row = rem >> 3, ch = rem & 7, kvh = 2 * kp + e;
        if (row >= TS && row < WIN + TS) {
            const size_t dst = (((size_t)b * WIN + row - TS) * KVH + kvh) * HD + 8 * ch;
            *(f32x4*)(a.out + O_SCK + dst) = r.k0; *(f32x4*)(a.out + O_SCK + dst + 4) = r.k1;
            *(f32x4*)(a.out + O_SCV + dst) = r.v0; *(f32x4*)(a.out + O_SCV + dst + 4) = r.v1;
        }
        LAS unsigned char* base = lds + e * S_STRIDE;
        v4u kw; kw.x = pk2(r.k0[0], r.k0[1]); kw.y = pk2(r.k0[2], r.k0[3]); kw.z = pk2(r.k1[0], r.k1[1]); kw.w = pk2(r.k1[2], r.k1[3]);
        *(LAS v4u*)(base + S_KT + row * KTPB + ch * 16) = kw;
        LAS unsigned short* vt = (LAS unsigned short*)(base + S_VT + (8 * ch) * S_VTPB + row * 2);
        const unsigned w0 = pk2(r.v0[0], r.v0[1]), w1 = pk2(r.v0[2], r.v0[3]), w2 = pk2(r.v1[0], r.v1[1]), w3 = pk2(r.v1[2], r.v1[3]);
        vt[0 * (S_VTPB / 2)] = (unsigned short)(w0 & 0xffff); vt[1 * (S_VTPB / 2)] = (unsigned short)(w0 >> 16); vt[2 * (S_VTPB / 2)] = (unsigned short)(w1 & 0xffff); vt[3 * (S_VTPB / 2)] = (unsigned short)(w1 >> 16);
        vt[4 * (S_VTPB / 2)] = (unsigned short)(w2 & 0xffff); vt[5 * (S_VTPB / 2)] = (unsigned short)(w2 >> 16); vt[6 * (S_VTPB / 2)] = (unsigned short)(w3 & 0xffff); vt[7 * (S_VTPB / 2)] = (unsigned short)(w3 >> 16);
    };
    {
        SRow ra, rb;
        sload(0, ra);
#pragma unroll 1
        for (int i = 0; i < 4; i += 2) { sload(i + 1, rb); sstore(i, ra); sload(i + 2, ra); sstore(i + 1, rb); }
        sstore(4, ra);
    }
    __syncthreads();
    if (wave < 2) {
        const int kvh = 2 * kp + wave, g = fr >> 2, t = fr & 3, h = kvh * 4 + g, m = TP + b * TS + t;
        const float slope = exp2f(-0.5f * (float)(h + 1)), sink = a.in[I_SINK][h];
        bf16x8 qf[2];
#pragma unroll
        for (int ks = 0; ks < 2; ++ks) qf[ks] = *(const bf16x8*)(P + (size_t)m * PPITCH + C_Q + h * HD + 32 * ks + 8 * fq);
        f32x4 o[4];
        LAS unsigned char* base = lds + wave * S_STRIDE;
        attn_wave16(base + S_KT, base + S_VT, S_VTPB, 0, qf, t + WIN, slope, sink, 0, o, lane);
#pragma unroll
        for (int dt = 0; dt < 4; ++dt)
#pragma unroll
            for (int rg = 0; rg < 4; ++rg) { const int r = 4 * fq + rg, hh = kvh * 4 + (r >> 2), mm = TP + b * TS + (r & 3);
                MIX[(size_t)mm * DM + CW + hh * HD + 16 * dt + fr] = (bf16)f2bf(o[dt][rg]); }
    }
    __syncthreads();
}

__device__ __forceinline__ void copies(const Args& a, size_t gt, size_t gs) {
    const bf16* P = (const bf16*)(a.ws + WS_P);
    for (size_t i = gt; i < RCOLS; i += gs) a.out[O_PSH + i] = bf2f(P[(size_t)(TP - 1) * PPITCH + i]);
    for (size_t i = gt; i < (size_t)NB * RCOLS; i += gs) { const int b = i / RCOLS, cc = i % RCOLS; a.out[O_SSH + i] = bf2f(P[(size_t)(TP + b * TS + TS - 1) * PPITCH + cc]); }
    for (size_t i = gt; i < (size_t)WIN * KVW; i += gs) { const int w = i / KVW, cc = i % KVW; const size_t row = (size_t)(TP - WIN + w) * PPITCH;
        a.out[O_PCK + i] = bf2f(P[row + C_SK + cc]); a.out[O_PCV + i] = bf2f(P[row + C_SV + cc]); }
}
}
enum { PH_PRO = 0, PH_GIN = 1, PH_L1 = 2, PH_L3 = 3, PH_GOUT = 4, PH_GGU = 5, PH_GDN = 6, PH_FIN = 7, PH_N = 8 };
struct OneUnit {
    int pm, pn;
    __device__ __forceinline__ bool next(int i, pg8::Unit& u) const { if (i) return false; u.pm = pm; u.pn = pn; u.ks = 0; return true; }
    __device__ __forceinline__ void a_ready(const pg8::Unit&) const {}
    __device__ __forceinline__ void done(const pg8::Unit&) const {}
};
struct FlagOrder {
    pg8::StaticOrder so; unsigned* flag; unsigned* tmo; unsigned want; int pm_from;
    __device__ __forceinline__ bool next(int i, pg8::Unit& u) const { return so.next(i, u); }
    __device__ __forceinline__ void a_ready(const pg8::Unit& u) const {
        if (u.pm >= pm_from) {
            unsigned sp = 0u;
            while (xb_ld(flag) < want) { __builtin_amdgcn_s_sleep(1); if ((++sp & 255u) == 0u) { if (xb_ld(tmo)) break; if (sp > XB_SPIN_CAP) { atomicAdd(tmo, 1u); break; } } }
            __builtin_amdgcn_fence(__ATOMIC_ACQUIRE, "agent");
        }
    }
    __device__ __forceinline__ void done(const pg8::Unit&) const {}
};
constexpr int OUT_TAIL_UNITS = 2 * (DM / pg8::BM);
static_assert(M - TP == 2 * pg8::BM, "out-projection tail: two sample-row panels");
__global__ void __launch_bounds__(NWAVES * 64, 2) mk_fwd(Args args) {
    extern __shared__ __attribute__((aligned(16))) unsigned char lds_raw[];
    LAS unsigned char* lds = (LAS unsigned char*)lds_raw;
    volatile LAS unsigned* MISC = (volatile LAS unsigned*)(lds + MISC_OFF);
    const int tid = threadIdx.x, lane = tid & 63, wave = __builtin_amdgcn_readfirstlane(tid >> 6);
    const int G = gridDim.x; const int bx = blockIdx.x; const int vcu = (G % 8 == 0) ? (bx % 8) * (G / 8) + bx / 8 : bx;
    if (tid < 64) ((LAS unsigned*)(lds + MISC_OFF))[tid] = 0u;
    __syncthreads();
    unsigned char* ws = args.ws;
    XcdBarrier bar = xcd_barrier_post((unsigned*)(ws + WS_CTL) + CW_BAR, MISC + 8);
    const int lo = args.ph_lo, hi = args.ph_hi;
#define IN(k) (lo <= (k) && (k) < hi)
#define BOTH(k) (IN(k) && IN((k) + 1))
    if (IN(PH_PRO)) { for (int rep = 0; rep < REP_PRO; ++rep) p0_prologue(args, lds, vcu, G, wave, lane); if (BOTH(PH_PRO)) xcd_barrier(bar); }
    if (IN(PH_GIN)) {
        pg8::Gemm g{(const bf16*)(ws + WS_XN), (const bf16*)(ws + WS_WIN), M, PPITCH, DM, DM}; pg8::StaticOrder S; S.init(M, PPITCH, G, bx);
        pg8::EpiP E{(bf16*)(ws + WS_P), PPITCH};
        for (int rep = 0; rep < REP_GIN; ++rep) pg8::gemm_phase<pg8::EpiP, pg8::StaticOrder, true, true>(lds, g, S, E);
#if LATE_WEIGHTS
        { const int nfull = S.nwg % G;
          if (nfull && bx >= nfull) convert_late_weights(args, lds, (bx - nfull) * NWAVES + wave, (G - nfull) * NWAVES, wave, lane, 0);
          else if (!nfull) convert_late_weights(args, lds, bx * NWAVES + wave, G * NWAVES, wave, lane, 0); }
#endif
        if (BOTH(PH_GIN)) xcd_barrier(bar);
    }
    if (IN(PH_L1)) {
      for (int rep = 0; rep < REP_L1; ++rep) {
        for (int r2 = 0; r2 < REP_L1A; ++r2)
        for (int u = bx; u < 256; u += G) { const int h = u & 15, s = u >> 4; rw::l1m_unit(args, lds, h, s, tid);
        }
        for (int r3 = 0; r3 < REP_L1B; ++r3)
        { at::KVRegs KR; if (bx < 1024) at::kv_issue(args, bx >> 2, bx & 3, tid, KR);
          for (int u = bx; u < 1024; u += G) { const int un = u + G; at::prompt_unit(args, lds, u >> 2, u & 3, tid, KR, un < 1024 ? (un >> 2) : -1, un & 3); } }
        if (G < 256) for (int u = bx; u < 256; u += G) at::sample_unit(args, lds, u >> 1, u & 1, tid);
        at::copies(args, (size_t)bx * 512 + tid, (size_t)G * 512);
      }
        if (BOTH(PH_L1)) xcd_barrier(bar);
    }
    if (IN(PH_L3)) {
      for (int rep = 0; rep < REP_L3; ++rep) {
        for (int r2 = 0; r2 < REP_L3A; ++r2)
        for (int u = bx; u < 256; u += G) { const int h = u & 15, s = u >> 4; rw::l3s_unit(args, lds, h, s, tid); }
        for (int r2 = 0; r2 < REP_L3B; ++r2)
        for (int u = bx; u < 128; u += G) { const int h = u & 15, bg = u >> 4; rw::sample_unit(args, lds, h, bg, tid); }
        for (int r3 = 0; r3 < REP_L1C; ++r3)
        if (rep == 0 && G >= 256 && bx >= 128) for (int u = bx - 128; u < 256; u += G - 128) at::sample_unit(args, lds, u >> 1, u & 1, tid);
      }
        if (BOTH(PH_L3)) xcd_barrier(bar);
    }
    const pg8::Gemm g_out{(const bf16*)(ws + WS_MIX), (const bf16*)(ws + WS_WOUT), M, DM, DM, DM};
    const pg8::EpiOut E_out{args.in[I_XP], args.in[I_XS], TP, (bf16*)(ws + WS_XN), (float*)(ws + WS_SS1), DM};
    if (IN(PH_GOUT)) {
        pg8::StaticOrder S; S.init(TP, DM, G, bx);
        pg8::gemm_phase<pg8::EpiOut, pg8::StaticOrder, true, true>(lds, g_out, S, E_out);
        if (BOTH(PH_GOUT)) xcd_barrier(bar);
    }
    if (IN(PH_GGU)) {
        pg8::Gemm g{(const bf16*)(ws + WS_XN), (const bf16*)(ws + WS_WGU), M, 2 * DFF, DM, DM};
        FlagOrder S; S.so.init(M, 2 * DFF, G, bx); S.flag = (unsigned*)(ws + WS_CTL) + CW_OUTTAIL; S.want = OUT_TAIL_UNITS; S.pm_from = TP / pg8::BM; S.tmo = (unsigned*)(ws + WS_CTL) + CW_BAR + XB_TMO;
        const int nfull = S.so.nwg % G, t0 = (nfull + OUT_TAIL_UNITS <= G) ? nfull : 0;
        for (int t = bx - t0; t >= 0 && t < OUT_TAIL_UNITS; t += G) {
            OneUnit S1; S1.pm = TP / pg8::BM + (t & 1); S1.pn = t >> 1;
            pg8::gemm_phase<pg8::EpiOut, OneUnit, true, true>(lds, g_out, S1, E_out);
            asm volatile("s_waitcnt vmcnt(0)" ::: "memory");
            __syncthreads();
            if (tid == 0) { __builtin_amdgcn_fence(__ATOMIC_RELEASE, "agent"); asm volatile("s_waitcnt vmcnt(0)" ::: "memory"); (void)xb_add(S.flag, 1u); }
        }
        pg8::EpiGU E{(bf16*)(ws + WS_H), DFF, (const float*)(ws + WS_SS1), 1.f / DM, RMS_EPS};
        for (int rep = 0; rep < REP_GGU; ++rep) pg8::gemm_phase<pg8::EpiGU, FlagOrder, true, true>(lds, g, S, E);
#if LATE_WEIGHTS
        { const int c0 = t0 + OUT_TAIL_UNITS;
          if (nfull && bx >= c0) convert_late_weights(args, lds, (bx - c0) * NWAVES + wave, (G - c0) * NWAVES, wave, lane, 1);
          else if (!nfull || c0 >= G) convert_late_weights(args, lds, bx * NWAVES + wave, G * NWAVES, wave, lane, 1); }
#endif
        if (BOTH(PH_GGU)) xcd_barrier(bar);
    }
    if (IN(PH_GDN)) {
        {
            pg8::Gemm g{(const bf16*)(ws + WS_H), (const bf16*)(ws + WS_WDN), M, DM, DFF, DFF}; pg8::StaticOrder S; S.init(M, DM, G, bx); S.lim = GDN_FULL;
            pg8::EpiDown E{(bf16*)(ws + WS_XN), DM};
            pg8::gemm_phase<pg8::EpiDown, pg8::StaticOrder, true, true>(lds, g, S, E);
        }
        {
            pg8::Gemm g{(const bf16*)(ws + WS_H), (const bf16*)(ws + WS_WDN), M, DM, DFF / GDN_NSL, DFF}; pg8::SplitOrder S; S.so.init(M, DM, G, bx); S.base = GDN_FULL; S.nsl = GDN_NSL;
            pg8::EpiSlab E{(float*)(ws + WS_SLAB), nullptr, GDN_FULL, GDN_NSL, DM / 256, M / 256, (M / 256) * (DM / 256)};
            pg8::gemm_phase<pg8::EpiSlab, pg8::SplitOrder, true, true>(lds, g, S, E);
        }
        if (BOTH(PH_GDN)) xcd_barrier(bar);
    }
    if (IN(PH_FIN)) { for (int rep = 0; rep < REP_STA; ++rep) final_norm(args, vcu, G, wave, lane); }
#undef IN
#undef BOTH
}

extern "C" void kernel_launch(void* const* d_in, const int* in_sizes, int n_in, void* d_out, int out_size, void* d_ws, size_t ws_size, hipStream_t stream) {
    static int grid = 0;
    if (grid == 0) {
        if (n_in != 26 || (size_t)out_size != O_END || ws_size < WS_END) { fprintf(stderr, "kernel_launch: unexpected shapes: n_in %d out %d ws %zu\n", n_in, out_size, ws_size); grid = -1; return; }
        int dev = 0, cus = 0, per_cu = 0;
        if (hipGetDevice(&dev) != hipSuccess || hipDeviceGetAttribute(&cus, hipDeviceAttributeMultiprocessorCount, dev) != hipSuccess) { grid = -1; return; }
        if (hipFuncSetAttribute((const void*)mk_fwd, hipFuncAttributeMaxDynamicSharedMemorySize, LDS_BYTES) != hipSuccess) { grid = -1; return; }
        if (hipOccupancyMaxActiveBlocksPerMultiprocessor(&per_cu, (const void*)mk_fwd, NWAVES * 64, LDS_BYTES) != hipSuccess || per_cu < 1) { fprintf(stderr, "kernel_launch: occupancy query says %d\n", per_cu); per_cu = 1; }
        (void)hipGetLastError();
        grid = cus;
    }
    if (grid < 0) return;
    (void)hipMemsetAsync((char*)d_ws + WS_CTL, 0, CTL_ZERO_BYTES, stream);
    Args a{};
    for (int i = 0; i < 26; ++i) a.in[i] = (const float*)d_in[i];
    a.out = (float*)d_out; a.ws = (unsigned char*)d_ws;
#if MK_ONE_LAUNCH
    a.ph_lo = 0; a.ph_hi = PH_N;
    hipLaunchKernelGGL(mk_fwd, dim3(grid), dim3(NWAVES * 64), LDS_BYTES, stream, a);
#else
    a.ph_lo = PH_PRO; a.ph_hi = PH_GIN + 1;
    hipLaunchKernelGGL(mk_fwd, dim3(grid), dim3(NWAVES * 64), LDS_BYTES, stream, a);
    (void)hipMemsetAsync((char*)d_ws + WS_CTL, 0, CTL_ZERO_BYTES, stream);
    a.ph_lo = PH_L1; a.ph_hi = PH_N;
    hipLaunchKernelGGL(mk_fwd, dim3(grid), dim3(NWAVES * 64), LDS_BYTES, stream, a);
#endif
}
```
